# Optimizing an MI355X kernel written in HIP

```python
import math
import jax
import jax.numpy as jnp
from jax import lax
import numpy as np

D_MODEL = 1024
BATCH = 8
SEQ = 2048
DEPTH = 2

N_EVEN = (DEPTH + 1) // 2
N_ODD = DEPTH // 2
NORM_EPS = 1e-5

SSD_HEADS = 16
SSD_HEAD_DIM = 64
SSD_INNER = SSD_HEADS * SSD_HEAD_DIM
SSD_GROUPS = 2
SSD_STATE = 128
SSD_CONV = 4
SSD_CHUNK = 128
SSD_CONV_DIM = SSD_INNER + 2 * SSD_GROUPS * SSD_STATE
DT_MIN = 1e-3
DT_MAX = 1e-1

MOBA_HEADS = 8
MOBA_HEAD_DIM = 128
MOBA_INNER = MOBA_HEADS * MOBA_HEAD_DIM
MOBA_BLOCK = 256
MOBA_TOPK = 3
MOBA_QCHUNK = 32

Z_END = SSD_INNER
XBC_END = Z_END + SSD_CONV_DIM
DT_END = XBC_END + SSD_HEADS
Q_END = DT_END + MOBA_INNER
K_END = Q_END + MOBA_INNER
V_END = K_END + MOBA_INNER
EVEN_IN = V_END + MOBA_INNER
EVEN_MIX = SSD_INNER + MOBA_INNER

DIL_HEADS = 16
DIL_HEAD_DIM = 128
DIL_INNER = DIL_HEADS * DIL_HEAD_DIM
DIL_PATTERNS = ((128, 1), (512, 4), (2048, 16))
DIL_QBLOCK = 128
ODD_IN = 4 * DIL_INNER

kernel_name = 'hybrid_ssd_moba_dilated'


def rmsnorm(x, g):
    xf = x.astype(jnp.float32)
    y = xf * lax.rsqrt(jnp.mean(xf * xf, axis=-1, keepdims=True) + NORM_EPS)
    return (y * g.astype(jnp.float32)).astype(x.dtype)


def causal_dwconv(u, w, b):
    c = u.shape[-1]
    y = lax.conv_general_dilated(u, w[:, None, :].astype(u.dtype), window_strides=(1,),
                                 padding=[(w.shape[0] - 1, 0)],
                                 dimension_numbers=('NWC', 'WIO', 'NWC'),
                                 feature_group_count=c)
    return y + b.astype(u.dtype)


def ssd_chunked(x, dt, a, bmat, cmat, d_skip):
    f32 = jnp.float32
    bsz, s, h, p = x.shape
    g, n = bmat.shape[2], bmat.shape[3]
    l = SSD_CHUNK
    nc = s // l
    xf = x.astype(f32)
    dtf = dt.astype(f32)
    bh = jnp.repeat(bmat.astype(f32), h // g, axis=2).reshape(bsz, nc, l, h, n)
    ch = jnp.repeat(cmat.astype(f32), h // g, axis=2).reshape(bsz, nc, l, h, n)
    xc = (xf * dtf[..., None]).reshape(bsz, nc, l, h, p)
    ac = (dtf * a.astype(f32)).reshape(bsz, nc, l, h).transpose(0, 3, 1, 2)
    a_cum = jnp.cumsum(ac, axis=-1)
    seg = a_cum[..., :, None] - a_cum[..., None, :]
    causal = jnp.tril(jnp.ones((l, l), dtype=bool))
    lmat = jnp.exp(jnp.where(causal, seg, -jnp.inf))
    scores = jnp.einsum('bclhn,bcshn->bhcls', ch, bh)
    y_diag = jnp.einsum('bhcls,bcshp->bclhp', scores * lmat, xc)
    decay_states = jnp.exp(a_cum[..., -1:] - a_cum)
    states = jnp.einsum('bclhn,bhcl,bclhp->bchpn', bh, decay_states, xc)
    chunk_decay = jnp.exp(a_cum[..., -1])

    def step(carry, inp):
        st, dec = inp
        return carry * dec[..., None, None] + st, carry

    init = jnp.zeros((bsz, h, p, n), f32)
    _, prev = lax.scan(step, init, (states.transpose(1, 0, 2, 3, 4), chunk_decay.transpose(2, 0, 1)))
    prev = prev.transpose(1, 0, 2, 3, 4)
    y_off = jnp.einsum('bclhn,bchpn,bhcl->bclhp', ch, prev, jnp.exp(a_cum))
    y = (y_diag + y_off).reshape(bsz, s, h, p) + xf * d_skip.astype(f32)[:, None]
    return y.astype(x.dtype)


def gated_group_rmsnorm(y, z, g):
    bsz, s, _ = y.shape
    u = (y * jax.nn.silu(z)).astype(jnp.float32).reshape(bsz, s, SSD_GROUPS, -1)
    u = u * lax.rsqrt(jnp.mean(u * u, axis=-1, keepdims=True) + NORM_EPS)
    return (u.reshape(bsz, s, -1) * g.astype(jnp.float32)).astype(y.dtype)


def moba_attention(q, k, v):
    f32 = jnp.float32
    bsz, h, s, d = q.shape
    blk = MOBA_BLOCK
    nb = -(-s // blk)
    pad = nb * blk - s
    kb = jnp.pad(k, ((0, 0), (0, 0), (0, pad), (0, 0))).reshape(bsz, h, nb, blk, d)
    vb = jnp.pad(v, ((0, 0), (0, 0), (0, pad), (0, 0))).reshape(bsz, h, nb, blk, d)
    scale = d ** -0.5
    kmean = jnp.mean(kb.astype(f32), axis=3)
    gate = jnp.einsum('bhsd,bhnd->bhsn', q.astype(f32), kmean)
    qblk = jnp.arange(s) // blk
    past = jnp.arange(nb)[None, :] < qblk[:, None]
    gate = jnp.where(past, gate, -jnp.inf)
    k_sel = max(1, min(MOBA_TOPK, nb - 1))
    _, sel = lax.top_k(gate, k_sel)
    valid = sel < qblk[:, None]
    qc = MOBA_QCHUNK
    nq = s // qc
    qs = q.reshape(bsz, h, nq, qc, d).transpose(2, 0, 1, 3, 4)
    sels = sel.reshape(bsz, h, nq, qc, k_sel).transpose(2, 0, 1, 3, 4)
    valids = valid.reshape(bsz, h, nq, qc, k_sel).transpose(2, 0, 1, 3, 4)
    poss = jnp.arange(s, dtype=jnp.int32).reshape(nq, qc)
    bi = jnp.arange(bsz)[:, None, None, None]
    hi = jnp.arange(h)[None, :, None, None]
    nsel = k_sel * blk

    def one_chunk(args):
        qq, sc, vc, pos = args
        own = pos[0] // blk
        k_own = lax.dynamic_index_in_dim(kb, own, axis=2, keepdims=False)
        v_own = lax.dynamic_index_in_dim(vb, own, axis=2, keepdims=False)
        k_g = kb[bi, hi, sc]
        v_g = vb[bi, hi, sc]
        s_sel = jnp.einsum('bhqd,bhqjkd->bhqjk', qq, k_g).astype(f32) * scale
        s_sel = jnp.where(vc[..., None], s_sel, -jnp.inf)
        key_pos = own * blk + jnp.arange(blk)
        s_own = jnp.einsum('bhqd,bhkd->bhqk', qq, k_own).astype(f32) * scale
        s_own = jnp.where(key_pos[None, :] <= pos[:, None], s_own, -jnp.inf)
        logits = jnp.concatenate([s_sel.reshape(bsz, h, qc, nsel), s_own], axis=-1)
        pr = jax.nn.softmax(logits, axis=-1)
        p_sel = pr[..., :nsel].reshape(bsz, h, qc, k_sel, blk).astype(v.dtype)
        p_own = pr[..., nsel:].astype(v.dtype)
        return (jnp.einsum('bhqjk,bhqjkd->bhqd', p_sel, v_g)
                + jnp.einsum('bhqk,bhkd->bhqd', p_own, v_own))

    out = lax.map(one_chunk, (qs, sels, valids, poss))
    return out.transpose(1, 0, 3, 2, 4).reshape(bsz, s, h * d)


def dilated_attention(q, k, v):
    f32 = jnp.float32
    bsz, h, s, d = q.shape
    qb_len = DIL_QBLOCK
    scale = d ** -0.5
    outs, lses = [], []
    for window, r in DIL_PATTERNS:
        span = window // r
        L = -(-s // r)
        Lp = -(-L // qb_len) * qb_len
        nblk = Lp // qb_len

        def to_phase(t):
            t = jnp.pad(t, ((0, 0), (0, 0), (0, L * r - s), (0, 0)))
            t = t.reshape(bsz, h, L, r, d).transpose(0, 1, 3, 2, 4)
            t = jnp.pad(t, ((0, 0), (0, 0), (0, 0), (0, Lp - L), (0, 0)))
            return t.reshape(bsz, h, r, nblk, qb_len, d)

        def with_prev(t):
            prev = jnp.pad(t, ((0, 0), (0, 0), (0, 0), (1, 0), (0, 0), (0, 0)))[:, :, :, :-1]
            return jnp.concatenate([prev, t], axis=4)

        qp = to_phase(q)
        kw = with_prev(to_phase(k))
        vw = with_prev(to_phase(v))
        logits = jnp.einsum('bhrnqd,bhrnkd->bhrnqk', qp, kw).astype(f32) * scale
        qi = jnp.arange(qb_len)[:, None]
        kj = jnp.arange(2 * qb_len)[None, :]
        m = qi + qb_len - kj
        bidx = jnp.arange(nblk)[:, None, None]
        ok = (m >= 0) & (m <= span) & (bidx * qb_len + kj - qb_len >= 0)
        logits = jnp.where(ok, logits, -jnp.inf)
        lse = jax.nn.logsumexp(logits, axis=-1)
        pr = jnp.exp(logits - lse[..., None]).astype(v.dtype)
        o = jnp.einsum('bhrnqk,bhrnkd->bhrnqd', pr, vw)
        o = o.reshape(bsz, h, r, Lp, d)[:, :, :, :L].transpose(0, 1, 3, 2, 4)
        o = o.reshape(bsz, h, L * r, d)[:, :, :s]
        lse = lse.reshape(bsz, h, r, Lp)[..., :L].transpose(0, 1, 3, 2).reshape(bsz, h, L * r)[..., :s]
        outs.append(o)
        lses.append(lse)
    wts = jax.nn.softmax(jnp.stack(lses, axis=0), axis=0)
    out = jnp.einsum('pbhs,pbhsd->bhsd', wts, jnp.stack(outs, axis=0).astype(f32))
    return out.astype(q.dtype)


def even_mixer(hn, w_in, conv_w, conv_b, dt_bias, a_log, d_skip, ssd_norm, w_out):
    bsz, s, _ = hn.shape
    proj = hn @ w_in
    z, xbc, dt_raw, q, k, v, gate = jnp.split(proj, [Z_END, XBC_END, DT_END, Q_END, K_END, V_END], axis=-1)
    xbc = jax.nn.silu(causal_dwconv(xbc, conv_w, conv_b))
    xs, bm, cm = jnp.split(xbc, [SSD_INNER, SSD_INNER + SSD_GROUPS * SSD_STATE], axis=-1)
    xs = xs.reshape(bsz, s, SSD_HEADS, SSD_HEAD_DIM)
    bm = bm.reshape(bsz, s, SSD_GROUPS, SSD_STATE)
    cm = cm.reshape(bsz, s, SSD_GROUPS, SSD_STATE)
    dt = jax.nn.softplus((dt_raw + dt_bias).astype(jnp.float32))
    a = -jnp.exp(a_log.astype(jnp.float32))
    y = ssd_chunked(xs, dt, a, bm, cm, d_skip).reshape(bsz, s, SSD_INNER)
    y_ssd = gated_group_rmsnorm(y, z, ssd_norm)
    def heads(t):
        return t.reshape(bsz, s, MOBA_HEADS, MOBA_HEAD_DIM).transpose(0, 2, 1, 3)
    o = moba_attention(heads(q), heads(k), heads(v))
    y_moba = o * jax.nn.silu(gate)
    return jnp.concatenate([y_ssd, y_moba], axis=-1) @ w_out


def odd_mixer(hn, w_in, w_out):
    bsz, s, _ = hn.shape
    proj = hn @ w_in
    q, k, v, gate = jnp.split(proj, [DIL_INNER, 2 * DIL_INNER, 3 * DIL_INNER], axis=-1)
    def heads(t):
        return t.reshape(bsz, s, DIL_HEADS, DIL_HEAD_DIM).transpose(0, 2, 1, 3)
    o = dilated_attention(heads(q), heads(k), heads(v))
    o = o.transpose(0, 2, 1, 3).reshape(bsz, s, DIL_INNER)
    return (o * jax.nn.silu(gate)) @ w_out


def setup_inputs(seed: int = 0) -> dict:
    key = jax.random.key(seed)
    ks = jax.random.split(key, 16)
    f32 = jnp.float32

    def nrm(k, shape, scale):
        return jax.random.normal(k, shape, f32) * scale

    x = nrm(ks[0], (BATCH, SEQ, D_MODEL), 1.0)
    even_norm = 1.0 + nrm(ks[1], (N_EVEN, D_MODEL), 0.02)
    even_w_in = nrm(ks[2], (N_EVEN, D_MODEL, EVEN_IN), D_MODEL ** -0.5)
    ssd_conv_w = nrm(ks[3], (N_EVEN, SSD_CONV, SSD_CONV_DIM), SSD_CONV ** -0.5)
    ssd_conv_b = nrm(ks[4], (N_EVEN, SSD_CONV_DIM), 0.02)
    dt0 = jnp.exp(jax.random.uniform(ks[5], (N_EVEN, SSD_HEADS), f32, math.log(DT_MIN), math.log(DT_MAX)))
    ssd_dt_bias = dt0 + jnp.log(-jnp.expm1(-dt0))
    ssd_a_log = jnp.log(jax.random.uniform(ks[6], (N_EVEN, SSD_HEADS), f32, 1.0, 16.0))
    ssd_d = 1.0 + nrm(ks[7], (N_EVEN, SSD_HEADS), 0.02)
    ssd_norm = 1.0 + nrm(ks[8], (N_EVEN, SSD_INNER), 0.02)
    even_w_out = nrm(ks[9], (N_EVEN, EVEN_MIX, D_MODEL), EVEN_MIX ** -0.5)
    odd_norm = 1.0 + nrm(ks[10], (N_ODD, D_MODEL), 0.02)
    odd_w_in = nrm(ks[11], (N_ODD, D_MODEL, ODD_IN), D_MODEL ** -0.5)
    odd_w_out = nrm(ks[12], (N_ODD, DIL_INNER, D_MODEL), DIL_INNER ** -0.5)
    final_norm = 1.0 + nrm(ks[13], (D_MODEL,), 0.02)
    return {'x': x, 'even_norm': even_norm, 'even_w_in': even_w_in, 'ssd_conv_w': ssd_conv_w,
            'ssd_conv_b': ssd_conv_b, 'ssd_dt_bias': ssd_dt_bias, 'ssd_a_log': ssd_a_log,
            'ssd_d': ssd_d, 'ssd_norm': ssd_norm, 'even_w_out': even_w_out,
            'odd_norm': odd_norm, 'odd_w_in': odd_w_in, 'odd_w_out': odd_w_out,
            'final_norm': final_norm}


def reference(x, even_norm, even_w_in, ssd_conv_w, ssd_conv_b, ssd_dt_bias, ssd_a_log, ssd_d,
              ssd_norm, even_w_out, odd_norm, odd_w_in, odd_w_out, final_norm):
    for layer in range(DEPTH):
        i = layer // 2
        if layer % 2 == 0:
            hn = rmsnorm(x, even_norm[i])
            x = x + even_mixer(hn, even_w_in[i], ssd_conv_w[i], ssd_conv_b[i], ssd_dt_bias[i],
                               ssd_a_log[i], ssd_d[i], ssd_norm[i], even_w_out[i])
        else:
            hn = rmsnorm(x, odd_norm[i])
            x = x + odd_mixer(hn, odd_w_in[i], odd_w_out[i])
    return rmsnorm(x, final_norm)
```

```cpp
#include <hip/hip_runtime.h>
#include <hip/hip_cooperative_groups.h>
#include <cstdio>
#include <cstdint>
namespace cg = cooperative_groups;

#define LAS __attribute__((address_space(3)))
typedef unsigned short bf16_t;
typedef short bf16x8 __attribute__((ext_vector_type(8)));
typedef float f32x4 __attribute__((ext_vector_type(4)));
typedef float f32x2 __attribute__((ext_vector_type(2)));
typedef unsigned u32x4 __attribute__((ext_vector_type(4)));
typedef unsigned u32x2 __attribute__((ext_vector_type(2)));

constexpr int BATCH = 8, SEQ = 2048, DM = 1024, MTOK = BATCH * SEQ;
constexpr int EVEN_IN = 6672;
constexpr int N0 = 6656;
constexpr float NORM_EPS = 1e-5f;
constexpr float QSCALE = 0.08838834764831845f * 1.4426950408889634f;
#ifndef PHASE_MASK
#define PHASE_MASK 0x1ff
#endif
constexpr int NTHREADS = 512;
constexpr int LDS_BYTES = 155648;
constexpr int RING_BYTES = 131072;

constexpr size_t MiB = 1u << 20;
constexpr size_t WS_CTL = 0;
constexpr size_t WS_RSTD0 = 64 * 1024;
constexpr size_t WS_KPART = 512 * 1024;
constexpr size_t WS_DT = 1 * MiB;
constexpr size_t WS_SSQ = 2 * MiB;
constexpr size_t WS_RSQ1 = 3 * MiB;
constexpr size_t WS_RSQ2 = 4 * MiB;
constexpr size_t WS_W1T = 5 * MiB;
constexpr size_t WS_WO1T = 21 * MiB;
constexpr size_t WS_W0T = 25 * MiB;
constexpr size_t WS_WO0T = 38 * MiB;
constexpr size_t WS_Y0 = 42 * MiB;
constexpr size_t WS_XBC = 106 * MiB;
constexpr size_t WS_Q0 = 154 * MiB;
constexpr size_t WS_K0 = 186 * MiB;
constexpr size_t WS_V0 = 218 * MiB;
constexpr size_t WS_X1B = 224 * MiB;
constexpr size_t WS_QO1 = 25 * MiB;
constexpr size_t WS_K1 = 89 * MiB;
constexpr size_t WS_V1 = 153 * MiB;
constexpr size_t WS_END = 256 * MiB;

struct Params {
    const float* x; const float* even_norm; const float* w_in0; const float* conv_w; const float* conv_b; const float* dt_bias; const float* a_log;
    const float* d_skip; const float* ssd_norm; const float* w_out0; const float* odd_norm; const float* w_in1; const float* w_out1; const float* final_norm;
    float* out; unsigned char* ws;
};

__device__ __forceinline__ unsigned f2bf(float f) { unsigned u = __builtin_bit_cast(unsigned, f); return (u + 0x7fffu + ((u >> 16) & 1u)) >> 16; }
__device__ __forceinline__ unsigned pk2(float lo, float hi) { return f2bf(lo) | (f2bf(hi) << 16); }
__device__ __forceinline__ float bf_lo(unsigned w) { return __builtin_bit_cast(float, w << 16); }
__device__ __forceinline__ float bf_hi(unsigned w) { return __builtin_bit_cast(float, w & 0xffff0000u); }
__device__ __forceinline__ float bf2f(bf16_t h) { return __builtin_bit_cast(float, (unsigned)h << 16); }
__device__ __forceinline__ float silu_f(float v) { return v / (1.0f + __expf(-v)); }
__device__ __forceinline__ float wave_sum(float v) {
#pragma unroll
    for (int o = 1; o < 64; o <<= 1) v += __shfl_xor(v, o);
    return v;
}

namespace pg8 {
constexpr int BM = 256, BK = 64, HALF = 128, HTB = HALF * BK * 2, NXCD = 8, WGM = 8;
__host__ __device__ __forceinline__ int lds_byte(int r, int c) { const int st = (r >> 4) * 2 + (c >> 5), rr = r & 15, cc = c & 31, ob = rr * 64 + cc * 2; return st * 1024 + (ob ^ (((ob >> 9) & 1) << 5)); }
__host__ __device__ __forceinline__ void stage_rc(int b, int& R, int& C) { const int st = b / 1024, sb = b % 1024, swz = sb ^ (((sb >> 9) & 1) << 5); R = (st >> 1) * 16 + swz / 64; C = (st & 1) * 32 + (swz % 64) / 2; }
__host__ __device__ __forceinline__ int perm32(int rho) { const int n = rho >> 4, i = rho & 15; return 8 * (i >> 2) + 4 * n + (i & 3); }

struct Unit { int pm, pn; };
struct Gemm { const bf16_t* A; const bf16_t* Bt; int M, N, K; };

struct StaticOrder {
    int nM, nN, nwg, G, c;
    __device__ void init(int M, int N, int G_, int c_) { nM = M / BM; nN = N / BM; nwg = nM * nN; G = G_; c = c_; }
    __device__ bool next(int i, Unit& u) const {
        const long L = (long)i * G + c; if (L >= nwg) return false;
        int wgid = (int)L; { const int q = nwg / NXCD, r = nwg % NXCD, xcd = wgid % NXCD, off = wgid / NXCD; wgid = (xcd < r ? xcd * (q + 1) : r * (q + 1) + (xcd - r) * q) + off; }
        const int nig = WGM * nN, gid = wgid / nig, fm = gid * WGM, gsz = (nM - fm) < WGM ? (nM - fm) : WGM;
        u.pm = fm + ((wgid % nig) % gsz); u.pn = (wgid % nig) / gsz; return true;
    }
};
struct NoHook {
    __device__ __forceinline__ void begin(const Unit&, LAS unsigned char*) const {}
    __device__ __forceinline__ void at(f32x4 (&)[2][2][4][2], int, int, int, LAS unsigned char*) const {}
};

template <class Epi, class Sched, class Hook>
__device__ __forceinline__ void gemm_phase(LAS unsigned char* lds, const Gemm g, const Sched& S, const Epi& E, const Hook& H) {
    const int tid = threadIdx.x, wid = __builtin_amdgcn_readfirstlane(tid >> 6), lane = tid & 63, wr = wid >> 2, wc = wid & 3, fr = lane & 15, fq = lane >> 4;
    const int K = g.K, nt = K / BK;
    unsigned voffA[2], voffB[2];
#pragma unroll
    for (int i = 0; i < 2; ++i) { int R, C; stage_rc(tid * 16 + i * 8192, R, C); const int Rb = Epi::PERM ? ((R & ~31) + perm32(R & 31)) : R;
        voffA[i] = (unsigned)(R * K + C) * 2u; voffB[i] = (unsigned)(Rb * K + C) * 2u; }
    const size_t kstep = (size_t)(BK * 2);
    const size_t hstep = (size_t)HALF * K * 2;
    const size_t tstep = 2 * hstep;
    const unsigned ldsw = (unsigned)wid * 1024u;
    const int aoff = lds_byte(wr * 64 + fr, fq * 8), boff = lds_byte(wc * 32 + fr, fq * 8);
#define PG8_SA(b, h) (((b) * 2 + (h)) * HTB)
#define PG8_SB(b, h) ((4 + (b) * 2 + (h)) * HTB)
#define PG8_STAGE(bufoff, gbase, voff) do { _Pragma("unroll") for (int _i = 0; _i < 2; ++_i) \
        __builtin_amdgcn_global_load_lds((const unsigned*)((const char*)(gbase) + (voff)[_i]), (LAS unsigned*)(lds + (bufoff) + ldsw + _i * 8192), 16, 0, 0); } while (0)
#define PG8_LDA(dst, b, h) do { _Pragma("unroll") for (int m = 0; m < 4; ++m) _Pragma("unroll") for (int k = 0; k < 2; ++k) dst[m][k] = *(const LAS bf16x8*)(lds + PG8_SA(b, h) + aoff + m * 2048 + k * 1024); } while (0)
#define PG8_LDB(dst, b, h) do { _Pragma("unroll") for (int n = 0; n < 2; ++n) _Pragma("unroll") for (int k = 0; k < 2; ++k) dst[n][k] = *(const LAS bf16x8*)(lds + PG8_SB(b, h) + boff + n * 2048 + k * 1024); } while (0)
#define PG8_MMA(ai, bj, At, Bt) do { __builtin_amdgcn_s_setprio(1); _Pragma("unroll") for (int m = 0; m < 4; ++m) _Pragma("unroll") for (int n = 0; n < 2; ++n) _Pragma("unroll") for (int k = 0; k < 2; ++k) \
        acc[ai][bj][m][n] = __builtin_amdgcn_mfma_f32_16x16x32_bf16(Bt[n][k], At[m][k], acc[ai][bj][m][n], 0, 0, 0); __builtin_amdgcn_s_setprio(0); } while (0)
#define PG8_WAIT_V(n) asm volatile("s_waitcnt vmcnt(" #n ")" ::: "memory")
#define PG8_WAIT_L(n) asm volatile("s_waitcnt lgkmcnt(" #n ")" ::: "memory")
#define PG8_BAR __builtin_amdgcn_s_barrier()
#define PG8_SCHED __builtin_amdgcn_sched_barrier(0)
    Unit cur, nxt; int ui = 0;
    if (!S.next(0, cur)) return;
    f32x4 acc[2][2][4][2];
#pragma unroll
    for (int a = 0; a < 2; ++a)
#pragma unroll
        for (int b = 0; b < 2; ++b)
#pragma unroll
            for (int m = 0; m < 4; ++m)
#pragma unroll
                for (int n = 0; n < 2; ++n) acc[a][b][m][n] = (f32x4){0.f, 0.f, 0.f, 0.f};
    bf16x8 At[4][2], B0[2][2], B1[2][2];
    const char* cA = (const char*)g.A + (size_t)cur.pm * tstep; const char* cB = (const char*)g.Bt + (size_t)cur.pn * tstep;
    H.begin(cur, lds);
    PG8_STAGE(PG8_SB(0, 0), cB, voffB); PG8_STAGE(PG8_SA(0, 0), cA, voffA); PG8_STAGE(PG8_SB(0, 1), cB + hstep, voffB); PG8_STAGE(PG8_SA(0, 1), cA + hstep, voffA);
    if (wr == 1) PG8_BAR;
    PG8_WAIT_V(4); PG8_BAR;
    PG8_STAGE(PG8_SB(1, 0), cB + kstep, voffB); PG8_STAGE(PG8_SA(1, 0), cA + kstep, voffA); PG8_STAGE(PG8_SB(1, 1), cB + hstep + kstep, voffB);
    PG8_WAIT_V(6); PG8_BAR;
    for (;;) {
        const bool has_next = S.next(ui + 1, nxt);
        const char* nA = has_next ? (const char*)g.A + (size_t)nxt.pm * tstep : cA; const char* nB = has_next ? (const char*)g.Bt + (size_t)nxt.pn * tstep : cB;
        for (int t = 0; t < nt; t += 2) {
            const bool last = (t == nt - 2);
            const char* a1 = cA + (size_t)(t + 1) * kstep;
            const char* a2 = last ? nA : cA + (size_t)(t + 2) * kstep; const char* b2 = last ? nB : cB + (size_t)(t + 2) * kstep;
            const char* a3 = a2 + kstep; const char* b3 = b2 + kstep;
            H.at(acc, t, wr, fr, lds);
            PG8_LDB(B0, 0, 0); PG8_SCHED; PG8_LDA(At, 0, 0); PG8_STAGE(PG8_SA(1, 1), a1 + hstep, voffA);
            PG8_WAIT_L(8); PG8_BAR; PG8_WAIT_L(0); PG8_MMA(0, 0, At, B0); PG8_BAR; PG8_SCHED;
            PG8_LDB(B1, 0, 1); PG8_STAGE(PG8_SB(0, 0), b2, voffB);
            PG8_BAR; PG8_WAIT_L(0); PG8_MMA(0, 1, At, B1); PG8_BAR;
            PG8_LDA(At, 0, 1); PG8_STAGE(PG8_SA(0, 0), a2, voffA);
            PG8_BAR; PG8_WAIT_L(0); PG8_MMA(1, 0, At, B0); PG8_BAR; PG8_SCHED;
            PG8_STAGE(PG8_SB(0, 1), b2 + hstep, voffB);
            PG8_WAIT_V(6); PG8_BAR; PG8_MMA(1, 1, At, B1); PG8_BAR;
            PG8_LDB(B0, 1, 0); PG8_SCHED; PG8_LDA(At, 1, 0); PG8_STAGE(PG8_SA(0, 1), a2 + hstep, voffA);
            PG8_WAIT_L(8); PG8_BAR; PG8_WAIT_L(0); PG8_MMA(0, 0, At, B0); PG8_BAR; PG8_SCHED;
            PG8_LDB(B1, 1, 1); PG8_STAGE(PG8_SB(1, 0), b3, voffB);
            PG8_BAR; PG8_WAIT_L(0); PG8_MMA(0, 1, At, B1); PG8_BAR;
            PG8_LDA(At, 1, 1); PG8_STAGE(PG8_SA(1, 0), a3, voffA);
            PG8_BAR; PG8_WAIT_L(0); PG8_MMA(1, 0, At, B0); PG8_BAR; PG8_SCHED;
            PG8_STAGE(PG8_SB(1, 1), b3 + hstep, voffB);
            PG8_WAIT_V(6); PG8_BAR; PG8_MMA(1, 1, At, B1); PG8_BAR;
        }
        E(acc, cur, wr, wc, fr, fq);
        if (!has_next) break;
#pragma unroll
        for (int a = 0; a < 2; ++a)
#pragma unroll
            for (int b = 0; b < 2; ++b)
#pragma unroll
                for (int m = 0; m < 4; ++m)
#pragma unroll
                    for (int n = 0; n < 2; ++n) acc[a][b][m][n] = (f32x4){0.f, 0.f, 0.f, 0.f};
        cur = nxt; cA = nA; cB = nB; ++ui;
        H.begin(cur, lds);
    }
    PG8_WAIT_V(0);
    if (wr == 0) PG8_BAR;
    PG8_BAR;
#undef PG8_SA
#undef PG8_SB
#undef PG8_STAGE
#undef PG8_LDA
#undef PG8_LDB
#undef PG8_MMA
#undef PG8_WAIT_V
#undef PG8_WAIT_L
#undef PG8_BAR
#undef PG8_SCHED
}
}

struct EpiIn0 {
    static constexpr bool PERM = true;
    bf16_t *Y0, *XBC, *Q0, *K0, *V0; const float* rstd; float* kpart;
    __device__ __forceinline__ void operator()(const f32x4 (&acc)[2][2][4][2], const pg8::Unit& u, int wr, int wc, int fr, int fq) const {
        const int pn = u.pn; bf16_t* base; int ld, colt, mode;
        if (pn < 8) { base = Y0; ld = 2048; colt = pn * 256; mode = 1; }
        else if (pn < 14) { base = XBC; ld = 1536; colt = (pn - 8) * 256; mode = 0; }
        else if (pn < 18) { base = Q0; ld = 1024; colt = (pn - 14) * 256; mode = 2; }
        else if (pn < 22) { base = K0; ld = 1024; colt = (pn - 18) * 256; mode = 3; }
        else { base = V0; ld = 1024; colt = (pn - 22) * 256; mode = 0; }
        const int row0 = u.pm * 256 + wr * 64 + fr, col0 = colt + wc * 32 + 8 * fq;
        float cs[2][8];
#pragma unroll
        for (int bj = 0; bj < 2; ++bj)
#pragma unroll
            for (int e = 0; e < 8; ++e) cs[bj][e] = 0.f;
#pragma unroll
        for (int ai = 0; ai < 2; ++ai)
#pragma unroll
            for (int m = 0; m < 4; ++m) {
                const int row = row0 + ai * 128 + m * 16; const float rs = rstd[row]; bf16_t* rowp = base + (size_t)row * ld + col0;
#pragma unroll
                for (int bj = 0; bj < 2; ++bj) {
                    float v[8];
#pragma unroll
                    for (int e = 0; e < 4; ++e) { v[e] = acc[ai][bj][m][0][e] * rs; v[4 + e] = acc[ai][bj][m][1][e] * rs; }
                    if (mode == 1) {
#pragma unroll
                        for (int e = 0; e < 8; ++e) v[e] = silu_f(v[e]);
                    } else if (mode == 2) {
#pragma unroll
                        for (int e = 0; e < 8; ++e) v[e] *= QSCALE;
                    } else if (mode == 3) {
#pragma unroll
                        for (int e = 0; e < 8; ++e) cs[bj][e] += v[e];
                    }
                    u32x4 w; w.x = pk2(v[0], v[1]); w.y = pk2(v[2], v[3]); w.z = pk2(v[4], v[5]); w.w = pk2(v[6], v[7]);
                    *(u32x4*)(rowp + bj * 128) = w;
                }
            }
        if (mode == 3) {
#pragma unroll
            for (int bj = 0; bj < 2; ++bj)
#pragma unroll
                for (int e = 0; e < 8; ++e) { float s = cs[bj][e]; s += __shfl_xor(s, 1); s += __shfl_xor(s, 2); s += __shfl_xor(s, 4); s += __shfl_xor(s, 8); cs[bj][e] = s; }
            if (fr == 0) {
                float* kp = kpart + ((size_t)u.pm * 2 + wr) * 1024 + col0;
#pragma unroll
                for (int bj = 0; bj < 2; ++bj) { *(f32x4*)(kp + bj * 128) = (f32x4){cs[bj][0], cs[bj][1], cs[bj][2], cs[bj][3]}; *(f32x4*)(kp + bj * 128 + 4) = (f32x4){cs[bj][4], cs[bj][5], cs[bj][6], cs[bj][7]}; }
            }
        }
    }
};
struct EpiRes {
    static constexpr bool PERM = false;
    const float* xi; float* xo; bf16_t* xb; float* rsq;
    __device__ __forceinline__ void operator()(const f32x4 (&acc)[2][2][4][2], const pg8::Unit& u, int wr, int wc, int fr, int fq) const {
        const int col0 = u.pn * 256 + wc * 32 + 4 * fq;
#pragma unroll
        for (int ai = 0; ai < 2; ++ai)
#pragma unroll
            for (int m = 0; m < 4; ++m) {
                const int row = u.pm * 256 + ai * 128 + wr * 64 + m * 16 + fr; const size_t off = (size_t)row * DM + col0; float ss = 0.f;
#pragma unroll
                for (int bj = 0; bj < 2; ++bj)
#pragma unroll
                    for (int n = 0; n < 2; ++n) {
                        const f32x4 b = *(const f32x4*)(xi + off + bj * 128 + n * 16); const f32x4 o = b + acc[ai][bj][m][n];
                        *(f32x4*)(xo + off + bj * 128 + n * 16) = o; ss += (o[0] * o[0] + o[1] * o[1]) + (o[2] * o[2] + o[3] * o[3]);
                        if (xb) { u32x2 w; w.x = pk2(o[0], o[1]); w.y = pk2(o[2], o[3]); *(u32x2*)(xb + off + bj * 128 + n * 16) = w; }
                    }
                ss += __shfl_xor(ss, 16); ss += __shfl_xor(ss, 32);
                if (fq == 0) rsq[(size_t)row * 16 + u.pn * 4 + wc] = ss;
            }
    }
};
__device__ __forceinline__ float rstd_from16(const float* p) {
    const f32x4 a = *(const f32x4*)p, b = *(const f32x4*)(p + 4), c = *(const f32x4*)(p + 8), d = *(const f32x4*)(p + 12);
    const float s = ((a[0] + a[1]) + (a[2] + a[3])) + ((b[0] + b[1]) + (b[2] + b[3])) + ((c[0] + c[1]) + (c[2] + c[3])) + ((d[0] + d[1]) + (d[2] + d[3]));
    return 1.0f / sqrtf(s * (1.0f / 1024.0f) + NORM_EPS);
}
struct EpiQkv1 {
    static constexpr bool PERM = true;
    bf16_t* O; size_t split_stride; const float* rsq;
    __device__ __forceinline__ void operator()(const f32x4 (&acc)[2][2][4][2], const pg8::Unit& u, int wr, int wc, int fr, int fq) const {
        const int t = u.pn >> 3; bf16_t* base = O + (size_t)t * split_stride; const int colt = (u.pn & 7) * 256; const float sc = (t == 0) ? QSCALE : 1.0f;
        const int row0 = u.pm * 256 + wr * 64 + fr, col0 = colt + wc * 32 + 8 * fq;
#pragma unroll
        for (int ai = 0; ai < 2; ++ai)
#pragma unroll
            for (int m = 0; m < 4; ++m) {
                const int row = row0 + ai * 128 + m * 16; const float rs = rstd_from16(rsq + (size_t)row * 16) * sc; bf16_t* rowp = base + (size_t)row * 2048 + col0;
#pragma unroll
                for (int bj = 0; bj < 2; ++bj) { const f32x4 v0 = acc[ai][bj][m][0] * rs, v1 = acc[ai][bj][m][1] * rs;
                    u32x4 w; w.x = pk2(v0[0], v0[1]); w.y = pk2(v0[2], v0[3]); w.z = pk2(v1[0], v1[1]); w.w = pk2(v1[2], v1[3]); *(u32x4*)(rowp + bj * 128) = w; }
            }
    }
};
struct EpiGate1 {
    static constexpr bool PERM = true;
    bf16_t* O; const float* rsq;
    __device__ __forceinline__ void operator()(const f32x4 (&acc)[2][2][4][2], const pg8::Unit& u, int wr, int wc, int fr, int fq) const {
        const int row0 = u.pm * 256 + wr * 64 + fr, col0 = u.pn * 256 + wc * 32 + 8 * fq;
#pragma unroll
        for (int ai = 0; ai < 2; ++ai)
#pragma unroll
            for (int m = 0; m < 4; ++m) {
                const int row = row0 + ai * 128 + m * 16; const float rs = rstd_from16(rsq + (size_t)row * 16); bf16_t* rowp = O + (size_t)row * 2048 + col0;
#pragma unroll
                for (int bj = 0; bj < 2; ++bj) { const f32x4 v0 = acc[ai][bj][m][0] * rs, v1 = acc[ai][bj][m][1] * rs; const u32x4 o = *(const u32x4*)(rowp + bj * 128);
                    u32x4 w; w.x = pk2(bf_lo(o.x) * silu_f(v0[0]), bf_hi(o.x) * silu_f(v0[1])); w.y = pk2(bf_lo(o.y) * silu_f(v0[2]), bf_hi(o.y) * silu_f(v0[3]));
                    w.z = pk2(bf_lo(o.z) * silu_f(v1[0]), bf_hi(o.z) * silu_f(v1[1])); w.w = pk2(bf_lo(o.w) * silu_f(v1[2]), bf_hi(o.w) * silu_f(v1[3])); *(u32x4*)(rowp + bj * 128) = w; }
            }
    }
};
struct HookSsdNorm {
    const float* ssq;
    __device__ __forceinline__ void begin(const pg8::Unit& u, LAS unsigned char* lds) const {
        LAS float* T = (LAS float*)(lds + RING_BYTES);
        const int t = threadIdx.x;
        if (t < 256) { const float* p = ssq + (size_t)(u.pm * 256 + t) * 16; const f32x4 a = *(const f32x4*)p, b = *(const f32x4*)(p + 4), c = *(const f32x4*)(p + 8), d = *(const f32x4*)(p + 12);
            const float g0 = ((a[0] + a[1]) + (a[2] + a[3])) + ((b[0] + b[1]) + (b[2] + b[3])), g1 = ((c[0] + c[1]) + (c[2] + c[3])) + ((d[0] + d[1]) + (d[2] + d[3]));
            const float r0 = 1.0f / sqrtf(g0 * (1.0f / 512.0f) + NORM_EPS), r1 = 1.0f / sqrtf(g1 * (1.0f / 512.0f) + NORM_EPS);
            T[2 * t] = r0 / r1; T[2 * t + 1] = r1; }
    }
    __device__ __forceinline__ void at(f32x4 (&acc)[2][2][4][2], int t, int wr, int fr, LAS unsigned char* lds) const {
        if (t == 8 || t == 16) {
            const LAS float* T = (const LAS float*)(lds + RING_BYTES); const int sel = (t == 16);
#pragma unroll
            for (int ai = 0; ai < 2; ++ai)
#pragma unroll
                for (int m = 0; m < 4; ++m) { const float f = T[2 * (ai * 128 + wr * 64 + m * 16 + fr) + sel];
#pragma unroll
                    for (int bj = 0; bj < 2; ++bj)
#pragma unroll
                        for (int n = 0; n < 2; ++n) acc[ai][bj][m][n] = acc[ai][bj][m][n] * f; }
        }
    }
};

__device__ __forceinline__ void transpose_item(const float* W, int K, int Nsrc, int src_col0, bf16_t* WT, int dst_row0, const float* gain, int gain_n, LAS float* scr, int kb, int nb, int lane) {
    const int k0 = 64 * kb, n0 = 32 * nb;
#pragma unroll 8
    for (int i = 0; i < 32; ++i) { const int kk = 2 * i + (lane >> 5); const int k = k0 + kk; const float gsc = (gain && k < gain_n) ? gain[k] : 1.0f;
        scr[kk * 33 + (lane & 31)] = W[(size_t)k * Nsrc + src_col0 + n0 + (lane & 31)] * gsc; }
    asm volatile("s_waitcnt lgkmcnt(0)" ::: "memory");
    const int c = lane & 7;
#pragma unroll
    for (int j = 0; j < 4; ++j) { const int n = (lane >> 3) + 8 * j; const LAS float* s = scr + (8 * c) * 33 + n;
        u32x4 o; o.x = pk2(s[0 * 33], s[1 * 33]); o.y = pk2(s[2 * 33], s[3 * 33]); o.z = pk2(s[4 * 33], s[5 * 33]); o.w = pk2(s[6 * 33], s[7 * 33]);
        *(u32x4*)(WT + (size_t)(dst_row0 + n0 + n) * K + k0 + 8 * c) = o; }
    asm volatile("s_waitcnt lgkmcnt(0)" ::: "memory");
}
__device__ __forceinline__ float softplus_f(float v) { return v > 20.f ? v : log1pf(expf(v)); }

__device__ __forceinline__ void phase_prep(const Params& P, LAS unsigned char* lds, int G) {
    const int tid = threadIdx.x, lane = tid & 63, wave = tid >> 6;
    const int gw = blockIdx.x * 8 + wave, NGW = G * 8;
    unsigned char* ws = P.ws;
    if (blockIdx.x == 0 && tid < 64) ((unsigned*)(ws + WS_CTL))[tid] = 0u;
    {
        LAS float* scr = (LAS float*)(lds + wave * 16384);
        bf16_t* W0T = (bf16_t*)(ws + WS_W0T); bf16_t* WO0T = (bf16_t*)(ws + WS_WO0T); bf16_t* W1T = (bf16_t*)(ws + WS_W1T); bf16_t* WO1T = (bf16_t*)(ws + WS_WO1T);
        constexpr int I0 = 16 * 208, IO0 = 32 * 32, I1 = 16 * 256, IO1 = 32 * 32;
        for (int it = gw; it < I0 + IO0 + I1 + IO1; it += NGW) {
            int r = it;
            if (r < I0) { const int kb = r / 208, nb = r % 208; const int n0 = nb * 32;
                int src; if (n0 < 1024) src = n0; else if (n0 < 2048) src = n0 - 1024 + 5648; else if (n0 < 3584) src = n0 - 2048 + 1024; else src = n0 - 3584 + 2576;
                transpose_item(P.w_in0, 1024, EVEN_IN, src - n0, W0T, 0, P.even_norm, 1024, scr, kb, nb, lane); continue; }
            r -= I0;
            if (r < IO0) { transpose_item(P.w_out0, 2048, 1024, 0, WO0T, 0, P.ssd_norm, 1024, scr, r / 32, r % 32, lane); continue; }
            r -= IO0;
            if (r < I1) { transpose_item(P.w_in1, 1024, 8192, 0, W1T, 0, P.odd_norm, 1024, scr, r / 256, r % 256, lane); continue; }
            r -= I1;
            transpose_item(P.w_out1, 2048, 1024, 0, WO1T, 0, nullptr, 0, scr, r / 32, r % 32, lane);
        }
    }
    __syncthreads();
    {
        LAS float* Wd = (LAS float*)lds;
        for (int i = tid; i < 16 * 1024; i += NTHREADS) { const int k = i >> 4, h = i & 15; Wd[h * 1024 + k] = P.w_in0[(size_t)k * EVEN_IN + 2560 + h] * P.even_norm[k]; }
        __syncthreads();
        bf16_t* xb = (bf16_t*)P.out; float* rstd0 = (float*)(ws + WS_RSTD0); float* dt = (float*)(ws + WS_DT);
        for (int m = gw; m < MTOK; m += NGW) {
            const f32x4* xr = (const f32x4*)(P.x + (size_t)m * DM) + lane;
            f32x4 v[4]; float s = 0.f;
#pragma unroll
            for (int j = 0; j < 4; ++j) { v[j] = xr[64 * j]; s += (v[j][0] * v[j][0] + v[j][1] * v[j][1]) + (v[j][2] * v[j][2] + v[j][3] * v[j][3]); }
            const float rs = 1.0f / sqrtf(wave_sum(s) * (1.0f / DM) + NORM_EPS);
            unsigned long long* o8 = (unsigned long long*)(xb + (size_t)m * DM) + lane;
#pragma unroll
            for (int j = 0; j < 4; ++j) o8[64 * j] = (unsigned long long)pk2(v[j][0], v[j][1]) | ((unsigned long long)pk2(v[j][2], v[j][3]) << 32);
            float mine = 0.f;
#pragma unroll 1
            for (int h = 0; h < 16; ++h) { float a = 0.f;
#pragma unroll
                for (int j = 0; j < 4; ++j) { const f32x4 w = *(const LAS f32x4*)(Wd + h * 1024 + 256 * j + 4 * lane); a += (v[j][0] * w[0] + v[j][1] * w[1]) + (v[j][2] * w[2] + v[j][3] * w[3]); }
                a = wave_sum(a); if (lane == h) mine = a; }
            if (lane == 0) rstd0[m] = rs;
            if (lane < 16) dt[(size_t)m * 16 + lane] = softplus_f(mine * rs + P.dt_bias[lane]);
        }
    }
}

__device__ __forceinline__ void ssd_item(const Params& P, LAS unsigned char* lds, int b, int h) {
    constexpr int TT = 64;
    const int tid = threadIdx.x;
    unsigned char* ws = P.ws;
    const bf16_t* XBC = (const bf16_t*)(ws + WS_XBC); bf16_t* Y0 = (bf16_t*)(ws + WS_Y0); const float* dt = (const float*)(ws + WS_DT); float* ssq = (float*)(ws + WS_SSQ);
    LAS float* xc = (LAS float*)lds;
    LAS float* Bc = xc + TT * 64;
    LAS float* Cc = Bc + TT * 128;
    LAS float* zs = Cc + TT * 128;
    LAS float* uo = zs + TT * 64;
    LAS float* dtv = uo + TT * 64;
    LAS float* dec = dtv + TT;
    const int g = h >> 3;
    const float a = -expf(P.a_log[h]), Dh = P.d_skip[h];
    const int p = tid >> 3, ng = tid & 7;
    float st[16];
#pragma unroll
    for (int i = 0; i < 16; ++i) st[i] = 0.f;
    int ch = 0; float cw0 = 0.f, cw1 = 0.f, cw2 = 0.f, cw3 = 0.f, cb = 0.f;
    if (tid < 320) { ch = tid < 64 ? h * 64 + tid : (tid < 192 ? 1024 + g * 128 + (tid - 64) : 1280 + g * 128 + (tid - 192));
        cw0 = P.conv_w[ch]; cw1 = P.conv_w[1536 + ch]; cw2 = P.conv_w[2 * 1536 + ch]; cw3 = P.conv_w[3 * 1536 + ch]; cb = P.conv_b[ch]; }
    for (int t0 = 0; t0 < SEQ; t0 += TT) {
        const size_t tok0 = (size_t)b * SEQ + t0;
        if (tid < 320) {
            float w0 = 0.f, w1 = 0.f, w2 = 0.f;
            if (t0 > 0) { w0 = bf2f(XBC[(tok0 - 3) * 1536 + ch]); w1 = bf2f(XBC[(tok0 - 2) * 1536 + ch]); w2 = bf2f(XBC[(tok0 - 1) * 1536 + ch]); }
            LAS float* dst = tid < 64 ? xc + tid : (tid < 192 ? Bc + (tid - 64) : Cc + (tid - 192)); const int dstride = tid < 64 ? 64 : 128;
            for (int tt = 0; tt < TT; ++tt) { const float w3 = bf2f(XBC[(tok0 + tt) * 1536 + ch]);
                const float v = cb + cw0 * w0 + cw1 * w1 + cw2 * w2 + cw3 * w3; dst[tt * dstride] = silu_f(v); w0 = w1; w1 = w2; w2 = w3; }
        } else if (tid < 320 + TT) { const int tt = tid - 320; const float d = dt[(tok0 + tt) * 16 + h]; dtv[tt] = d; dec[tt] = expf(d * a); }
        for (int i = tid; i < TT * 64; i += NTHREADS) { const int tt = i >> 6, pp = i & 63; zs[i] = bf2f(Y0[(tok0 + tt) * 2048 + h * 64 + pp]); }
        __syncthreads();
        for (int tt = 0; tt < TT; ++tt) {
            const float xv = xc[tt * 64 + p], xdt = xv * dtv[tt], dc = dec[tt];
            const LAS float* Bp = Bc + tt * 128 + 16 * ng; const LAS float* Cp = Cc + tt * 128 + 16 * ng;
            float yp = 0.f;
#pragma unroll
            for (int i = 0; i < 16; ++i) { st[i] = st[i] * dc + xdt * Bp[i]; yp += st[i] * Cp[i]; }
            yp += __shfl_xor(yp, 1); yp += __shfl_xor(yp, 2); yp += __shfl_xor(yp, 4);
            if (ng == 0) uo[tt * 64 + p] = (yp + Dh * xv) * zs[tt * 64 + p];
        }
        __syncthreads();
        { const int tt = tid >> 3, part = tid & 7; const LAS float* up = uo + tt * 64 + part * 8; float v[8]; float ss = 0.f;
#pragma unroll
            for (int e = 0; e < 8; ++e) { v[e] = up[e]; ss += v[e] * v[e]; }
            u32x4 w; w.x = pk2(v[0], v[1]); w.y = pk2(v[2], v[3]); w.z = pk2(v[4], v[5]); w.w = pk2(v[6], v[7]);
            *(u32x4*)(Y0 + (tok0 + tt) * 2048 + h * 64 + part * 8) = w;
            ss += __shfl_xor(ss, 1); ss += __shfl_xor(ss, 2); ss += __shfl_xor(ss, 4);
            if (part == 0) ssq[(tok0 + tt) * 16 + h] = ss; }
        __syncthreads();
    }
}

struct KeysDilated {
    __device__ __forceinline__ int nkeys(int) const { return 387; }
    __device__ __forceinline__ int keypos(int qpos, int idx) const { const int pt = idx / 129, j = idx - pt * 129; return qpos - (j << (2 * pt)); }
};
struct KeysMoba {
    const LAS int* sel;
    int q0;
    __device__ __forceinline__ int nkeys(int qpos) const { return sel[(qpos - q0) * 4] * 256 + (qpos & 255) + 1; }
    __device__ __forceinline__ int keypos(int qpos, int idx) const { const LAS int* s = sel + (qpos - q0) * 4; const int ns = s[0];
        if (idx < ns * 256) return s[1 + (idx >> 8)] * 256 + (idx & 255);
        return (qpos & ~255) + (idx - ns * 256); }
};
template <class KS>
__device__ __forceinline__ void attn_simple_core(const KS& ks, LAS float* qs, LAS float* Ssc, const bf16_t* Kp, const bf16_t* Vp, int ld, int q0, float (&o)[8], float& lsum) {
    const int tid = threadIdx.x, qi = tid >> 4, part = tid & 15;
    const int qpos = q0 + qi, nk = ks.nkeys(qpos);
    LAS float* Sr = Ssc + qi * 1024; const LAS float* qr = qs + qi * 128;
    float mx = -3.0e38f;
    for (int idx = part; idx < nk; idx += 16) {
        const int pos = ks.keypos(qpos, idx); float s = -__builtin_inff();
        if (pos >= 0) { const u32x4* kr = (const u32x4*)(Kp + (size_t)pos * ld); float a = 0.f;
#pragma unroll
            for (int c = 0; c < 16; ++c) { const u32x4 w = kr[c]; const f32x4 q0v = *(const LAS f32x4*)(qr + 8 * c), q1v = *(const LAS f32x4*)(qr + 8 * c + 4);
                a += (bf_lo(w.x) * q0v[0] + bf_hi(w.x) * q0v[1]) + (bf_lo(w.y) * q0v[2] + bf_hi(w.y) * q0v[3]) + (bf_lo(w.z) * q1v[0] + bf_hi(w.z) * q1v[1]) + (bf_lo(w.w) * q1v[2] + bf_hi(w.w) * q1v[3]); }
            s = a; }
        Sr[idx] = s; mx = fmaxf(mx, s);
    }
    mx = fmaxf(mx, __shfl_xor(mx, 1)); mx = fmaxf(mx, __shfl_xor(mx, 2)); mx = fmaxf(mx, __shfl_xor(mx, 4)); mx = fmaxf(mx, __shfl_xor(mx, 8));
    float l = 0.f;
    for (int idx = part; idx < nk; idx += 16) { const float pv = exp2f(Sr[idx] - mx); Sr[idx] = pv; l += pv; }
    l += __shfl_xor(l, 1); l += __shfl_xor(l, 2); l += __shfl_xor(l, 4); l += __shfl_xor(l, 8);
    lsum = l;
    asm volatile("s_waitcnt lgkmcnt(0)" ::: "memory");
    __syncthreads();
#pragma unroll
    for (int e = 0; e < 8; ++e) o[e] = 0.f;
    for (int idx = 0; idx < nk; ++idx) {
        const float pv = Sr[idx];
        if (pv != 0.f) { const int pos = ks.keypos(qpos, idx); const u32x4 w = *(const u32x4*)(Vp + (size_t)pos * ld + 8 * part);
            o[0] += pv * bf_lo(w.x); o[1] += pv * bf_hi(w.x); o[2] += pv * bf_lo(w.y); o[3] += pv * bf_hi(w.y); o[4] += pv * bf_lo(w.z); o[5] += pv * bf_hi(w.z); o[6] += pv * bf_lo(w.w); o[7] += pv * bf_hi(w.w); }
    }
}
__device__ __forceinline__ void load_q_tile(LAS float* qs, const bf16_t* Qp, int ld) {
    const int tid = threadIdx.x, r = tid >> 4, c = tid & 15;
    const u32x4 w = *(const u32x4*)(Qp + (size_t)r * ld + 8 * c); LAS float* d = qs + r * 128 + 8 * c;
    d[0] = bf_lo(w.x); d[1] = bf_hi(w.x); d[2] = bf_lo(w.y); d[3] = bf_hi(w.y); d[4] = bf_lo(w.z); d[5] = bf_hi(w.z); d[6] = bf_lo(w.w); d[7] = bf_hi(w.w);
}
__device__ __forceinline__ void moba_item(const Params& P, LAS unsigned char* lds, int b, int h, int qt) {
    unsigned char* ws = P.ws; const int tid = threadIdx.x;
    LAS float* Ssc = (LAS float*)lds; LAS float* qs = (LAS float*)(lds + 131072); LAS float* gts = (LAS float*)(lds + 131072 + 16384); LAS int* sel = (LAS int*)(lds + 131072 + 16384 + 1024);
    const bf16_t* Q0 = (const bf16_t*)(ws + WS_Q0) + (size_t)b * SEQ * 1024 + h * 128; const bf16_t* K0 = (const bf16_t*)(ws + WS_K0) + (size_t)b * SEQ * 1024 + h * 128;
    const bf16_t* V0 = (const bf16_t*)(ws + WS_V0) + (size_t)b * SEQ * 1024 + h * 128; bf16_t* Y0 = (bf16_t*)(ws + WS_Y0) + (size_t)b * SEQ * 2048 + 1024 + h * 128;
    const float* kpart = (const float*)(ws + WS_KPART);
    const int q0 = qt * 32, qb = q0 >> 8;
    __syncthreads();
    load_q_tile(qs, Q0 + (size_t)q0 * 1024, 1024);
    __syncthreads();
    { const int qi = tid >> 4, n = tid & 15;
        if (n < qb) { const float* k0p = kpart + ((size_t)(b * 8 + n) * 2) * 1024 + h * 128; const float* k1p = k0p + 1024; float a = 0.f;
            for (int d = 0; d < 128; ++d) a += qs[qi * 128 + d] * (k0p[d] + k1p[d]);
            gts[qi * 8 + n] = a; } }
    __syncthreads();
    if (tid < 32) { const int ns = qb < 3 ? qb : 3; int s0 = -1, s1 = -1, s2 = -1; float g0 = -__builtin_inff(), g1 = g0, g2 = g0;
        for (int n = 0; n < qb; ++n) { const float gv = gts[tid * 8 + n];
            if (gv > g0) { g2 = g1; s2 = s1; g1 = g0; s1 = s0; g0 = gv; s0 = n; } else if (gv > g1) { g2 = g1; s2 = s1; g1 = gv; s1 = n; } else if (gv > g2) { g2 = gv; s2 = n; } }
        sel[tid * 4] = ns; sel[tid * 4 + 1] = s0 < 0 ? 0 : s0; sel[tid * 4 + 2] = s1 < 0 ? 0 : s1; sel[tid * 4 + 3] = s2 < 0 ? 0 : s2; }
    __syncthreads();
    KeysMoba ks{sel, q0}; float o[8]; float l;
    attn_simple_core(ks, qs, Ssc, K0, V0, 1024, q0, o, l);
    const int qi = tid >> 4, part = tid & 15; const float inv = 1.0f / l;
    bf16_t* yp = Y0 + (size_t)(q0 + qi) * 2048 + 8 * part; const u32x4 gw = *(const u32x4*)yp;
    u32x4 w; w.x = pk2(o[0] * inv * bf_lo(gw.x), o[1] * inv * bf_hi(gw.x)); w.y = pk2(o[2] * inv * bf_lo(gw.y), o[3] * inv * bf_hi(gw.y));
    w.z = pk2(o[4] * inv * bf_lo(gw.z), o[5] * inv * bf_hi(gw.z)); w.w = pk2(o[6] * inv * bf_lo(gw.w), o[7] * inv * bf_hi(gw.w));
    *(u32x4*)yp = w;
}
__device__ __forceinline__ void dilated_item(const Params& P, LAS unsigned char* lds, int b, int h, int qt) {
    unsigned char* ws = P.ws; const int tid = threadIdx.x;
    LAS float* Ssc = (LAS float*)lds; LAS float* qs = (LAS float*)(lds + 131072);
    bf16_t* Q1 = (bf16_t*)(ws + WS_QO1) + (size_t)b * SEQ * 2048 + h * 128; const bf16_t* K1 = (const bf16_t*)(ws + WS_K1) + (size_t)b * SEQ * 2048 + h * 128;
    const bf16_t* V1 = (const bf16_t*)(ws + WS_V1) + (size_t)b * SEQ * 2048 + h * 128;
    const int q0 = qt * 32;
    __syncthreads();
    load_q_tile(qs, Q1 + (size_t)q0 * 2048, 2048);
    __syncthreads();
    KeysDilated ks; float o[8]; float l;
    attn_simple_core(ks, qs, Ssc, K1, V1, 2048, q0, o, l);
    const int qi = tid >> 4, part = tid & 15; const float inv = 1.0f / l;
    u32x4 w; w.x = pk2(o[0] * inv, o[1] * inv); w.y = pk2(o[2] * inv, o[3] * inv); w.z = pk2(o[4] * inv, o[5] * inv); w.w = pk2(o[6] * inv, o[7] * inv);
    *(u32x4*)(Q1 + (size_t)(q0 + qi) * 2048 + 8 * part) = w;
}

__global__ void __launch_bounds__(NTHREADS, 2) fwd_megakernel(Params P) {
    extern __shared__ __attribute__((aligned(16))) unsigned char lds_raw[];
    LAS unsigned char* lds = (LAS unsigned char*)lds_raw;
    cg::grid_group grid = cg::this_grid();
    const int G = gridDim.x, tid = threadIdx.x;
    unsigned char* ws = P.ws;
    LAS int* misc = (LAS int*)(lds + LDS_BYTES - 64);

    if (PHASE_MASK & 1) phase_prep(P, lds, G);
    grid.sync();
    if (PHASE_MASK & 2) {
        pg8::Gemm g{(const bf16_t*)P.out, (const bf16_t*)(ws + WS_W0T), MTOK, N0, DM}; pg8::StaticOrder S; S.init(MTOK, N0, G, (int)blockIdx.x);
        EpiIn0 E{(bf16_t*)(ws + WS_Y0), (bf16_t*)(ws + WS_XBC), (bf16_t*)(ws + WS_Q0), (bf16_t*)(ws + WS_K0), (bf16_t*)(ws + WS_V0), (const float*)(ws + WS_RSTD0), (float*)(ws + WS_KPART)};
        pg8::gemm_phase(lds, g, S, E, pg8::NoHook{});
    }
    grid.sync();
    if (PHASE_MASK & 4) {
        unsigned* ctr = (unsigned*)(ws + WS_CTL);
        for (;;) {
            __syncthreads();
            if (tid == 0) misc[0] = (int)atomicAdd(ctr, 1u);
            __syncthreads();
            const int it = misc[0];
            if (it >= 128 + 4096) break;
            if (it < 128) ssd_item(P, lds, it >> 4, it & 15);
            else { const int r = it - 128; const int qt = 63 - (r >> 6), bh = r & 63; moba_item(P, lds, bh >> 3, bh & 7, qt); }
        }
    }
    grid.sync();
    if (PHASE_MASK & 8) {
        pg8::Gemm g{(const bf16_t*)(ws + WS_Y0), (const bf16_t*)(ws + WS_WO0T), MTOK, DM, 2048}; pg8::StaticOrder S; S.init(MTOK, DM, G, (int)blockIdx.x);
        EpiRes E{P.x, P.out, (bf16_t*)(ws + WS_X1B), (float*)(ws + WS_RSQ1)};
        HookSsdNorm H{(const float*)(ws + WS_SSQ)};
        pg8::gemm_phase(lds, g, S, E, H);
    }
    grid.sync();
    if (PHASE_MASK & 16) {
        pg8::Gemm g{(const bf16_t*)(ws + WS_X1B), (const bf16_t*)(ws + WS_W1T), MTOK, 6144, DM}; pg8::StaticOrder S; S.init(MTOK, 6144, G, (int)blockIdx.x);
        EpiQkv1 E{(bf16_t*)(ws + WS_QO1), (size_t)(WS_K1 - WS_QO1) / 2, (const float*)(ws + WS_RSQ1)};
        pg8::gemm_phase(lds, g, S, E, pg8::NoHook{});
    }
    grid.sync();
    if (PHASE_MASK & 32) for (int it = blockIdx.x; it < 8 * 16 * 64; it += G) { const int qt = it & 63, bh = it >> 6; dilated_item(P, lds, bh >> 4, bh & 15, qt); }
    grid.sync();
    if (PHASE_MASK & 64) {
        pg8::Gemm g{(const bf16_t*)(ws + WS_X1B), (const bf16_t*)(ws + WS_W1T) + (size_t)6144 * 1024, MTOK, 2048, DM}; pg8::StaticOrder S; S.init(MTOK, 2048, G, (int)blockIdx.x);
        EpiGate1 E{(bf16_t*)(ws + WS_QO1), (const float*)(ws + WS_RSQ1)};
        pg8::gemm_phase(lds, g, S, E, pg8::NoHook{});
    }
    grid.sync();
    if (PHASE_MASK & 128) {
        pg8::Gemm g{(const bf16_t*)(ws + WS_QO1), (const bf16_t*)(ws + WS_WO1T), MTOK, DM, 2048}; pg8::StaticOrder S; S.init(MTOK, DM, G, (int)blockIdx.x);
        EpiRes E{P.out, P.out, nullptr, (float*)(ws + WS_RSQ2)};
        pg8::gemm_phase(lds, g, S, E, pg8::NoHook{});
    }
    grid.sync();
    if (PHASE_MASK & 256) {
        const int lane = tid & 63, wave = tid >> 6; const float* rsq2 = (const float*)(ws + WS_RSQ2);
        for (int m = blockIdx.x * 8 + wave; m < MTOK; m += G * 8) {
            const float rs = rstd_from16(rsq2 + (size_t)m * 16);
            f32x4* xr = (f32x4*)(P.out + (size_t)m * DM) + lane; const f32x4* gr = (const f32x4*)P.final_norm + lane;
#pragma unroll
            for (int j = 0; j < 4; ++j) { const f32x4 v = xr[64 * j], gg = gr[64 * j]; xr[64 * j] = v * rs * gg; }
        }
    }
}

extern "C" void kernel_launch(void* const* d_in, const int* in_sizes, int n_in, void* d_out, int out_size, void* d_ws, size_t ws_size, hipStream_t stream) {
    static int grid_blocks = 0;
    if (grid_blocks == 0) {
        if (n_in != 14 || ws_size < WS_END) { fprintf(stderr, "kernel_launch: unexpected n_in %d / ws_size %zu\n", n_in, ws_size); grid_blocks = -1; return; }
        int dev = 0, cus = 0, per_cu = 0;
        hipGetDevice(&dev);
        hipDeviceGetAttribute(&cus, hipDeviceAttributeMultiprocessorCount, dev);
        hipFuncSetAttribute((const void*)fwd_megakernel, hipFuncAttributeMaxDynamicSharedMemorySize, LDS_BYTES);
        hipOccupancyMaxActiveBlocksPerMultiprocessor(&per_cu, (const void*)fwd_megakernel, NTHREADS, LDS_BYTES);
        if (per_cu < 1) { fprintf(stderr, "kernel_launch: occupancy query says %d blocks per CU\n", per_cu); per_cu = 1; }
        grid_blocks = cus * 1;
        (void)hipGetLastError();
    }
    if (grid_blocks < 0) return;
    Params p{};
    p.x = (const float*)d_in[0]; p.even_norm = (const float*)d_in[1]; p.w_in0 = (const float*)d_in[2]; p.conv_w = (const float*)d_in[3]; p.conv_b = (const float*)d_in[4];
    p.dt_bias = (const float*)d_in[5]; p.a_log = (const float*)d_in[6]; p.d_skip = (const float*)d_in[7]; p.ssd_norm = (const float*)d_in[8]; p.w_out0 = (const float*)d_in[9];
    p.odd_norm = (const float*)d_in[10]; p.w_in1 = (const float*)d_in[11]; p.w_out1 = (const float*)d_in[12]; p.final_norm = (const float*)d_in[13];
    p.out = (float*)d_out; p.ws = (unsigned char*)d_ws;
    void* args[] = {&p};
    hipError_t e = hipLaunchCooperativeKernel((const void*)fwd_megakernel, dim3(grid_blocks), dim3(NTHREADS), args, LDS_BYTES, stream);
    if (e != hipSuccess) fprintf(stderr, "cooperative launch failed: %s (grid %d)\n", hipGetErrorString(e), grid_blocks);
}
```

```cpp
#include <hip/hip_runtime.h>
#include <hip/hip_cooperative_groups.h>
#include <cstdio>
#include <cstdint>
namespace cg = cooperative_groups;

#define LAS __attribute__((address_space(3)))
typedef unsigned short bf16_t;
typedef short bf16x8 __attribute__((ext_vector_type(8)));
typedef float f32x4 __attribute__((ext_vector_type(4)));
typedef float f32x2 __attribute__((ext_vector_type(2)));
typedef unsigned u32x4 __attribute__((ext_vector_type(4)));
typedef unsigned u32x2 __attribute__((ext_vector_type(2)));

constexpr int BATCH = 8, SEQ = 2048, DM = 1024, MTOK = BATCH * SEQ;
constexpr int EVEN_IN = 6672;
constexpr int N0 = 6656;
constexpr float NORM_EPS = 1e-5f;
constexpr float QSCALE = 0.08838834764831845f * 1.4426950408889634f;
#ifndef PHASE_MASK
#define PHASE_MASK 0x1ff
#endif
#ifndef MOBA_MFMA
#define MOBA_MFMA 1
#endif
#ifndef DIL_MFMA
#define DIL_MFMA 1
#endif
constexpr int NTHREADS = 512;
constexpr int LDS_BYTES = 155648;
constexpr int RING_BYTES = 131072;

constexpr size_t MiB = 1u << 20;
constexpr size_t WS_CTL = 0;
constexpr size_t WS_RSTD0 = 64 * 1024;
constexpr size_t WS_KPART = 512 * 1024;
constexpr size_t WS_DT = 1 * MiB;
constexpr size_t WS_SSQ = 2 * MiB;
constexpr size_t WS_RSQ1 = 3 * MiB;
constexpr size_t WS_RSQ2 = 4 * MiB;
constexpr size_t WS_W1T = 5 * MiB;
constexpr size_t WS_WO1T = 21 * MiB;
constexpr size_t WS_W0T = 25 * MiB;
constexpr size_t WS_WO0T = 38 * MiB;
constexpr size_t WS_Y0 = 42 * MiB;
constexpr size_t WS_XBC = 106 * MiB;
constexpr size_t WS_Q0 = 154 * MiB;
constexpr size_t WS_K0 = 186 * MiB;
constexpr size_t WS_V0 = 218 * MiB;
constexpr size_t WS_X1B = 224 * MiB;
constexpr size_t WS_QO1 = 25 * MiB;
constexpr size_t WS_K1 = 89 * MiB;
constexpr size_t WS_V1 = 153 * MiB;
constexpr size_t WS_END = 256 * MiB;

struct Params {
    const float* x; const float* even_norm; const float* w_in0; const float* conv_w; const float* conv_b; const float* dt_bias; const float* a_log;
    const float* d_skip; const float* ssd_norm; const float* w_out0; const float* odd_norm; const float* w_in1; const float* w_out1; const float* final_norm;
    float* out; unsigned char* ws;
};

__device__ __forceinline__ unsigned f2bf(float f) { unsigned u = __builtin_bit_cast(unsigned, f); return (u + 0x7fffu + ((u >> 16) & 1u)) >> 16; }
__device__ __forceinline__ unsigned pk2(float lo, float hi) { return f2bf(lo) | (f2bf(hi) << 16); }
__device__ __forceinline__ float bf_lo(unsigned w) { return __builtin_bit_cast(float, w << 16); }
__device__ __forceinline__ float bf_hi(unsigned w) { return __builtin_bit_cast(float, w & 0xffff0000u); }
__device__ __forceinline__ float bf2f(bf16_t h) { return __builtin_bit_cast(float, (unsigned)h << 16); }
__device__ __forceinline__ float silu_f(float v) { return v / (1.0f + __expf(-v)); }
__device__ __forceinline__ float wave_sum(float v) {
#pragma unroll
    for (int o = 1; o < 64; o <<= 1) v += __shfl_xor(v, o);
    return v;
}

namespace pg8 {
constexpr int BM = 256, BK = 64, HALF = 128, HTB = HALF * BK * 2, NXCD = 8, WGM = 8;
__host__ __device__ __forceinline__ int lds_byte(int r, int c) { const int st = (r >> 4) * 2 + (c >> 5), rr = r & 15, cc = c & 31, ob = rr * 64 + cc * 2; return st * 1024 + (ob ^ (((ob >> 9) & 1) << 5)); }
__host__ __device__ __forceinline__ void stage_rc(int b, int& R, int& C) { const int st = b / 1024, sb = b % 1024, swz = sb ^ (((sb >> 9) & 1) << 5); R = (st >> 1) * 16 + swz / 64; C = (st & 1) * 32 + (swz % 64) / 2; }
__host__ __device__ __forceinline__ int perm32(int rho) { const int n = rho >> 4, i = rho & 15; return 8 * (i >> 2) + 4 * n + (i & 3); }

struct Unit { int pm, pn; };
struct Gemm { const bf16_t* A; const bf16_t* Bt; int M, N, K; };

struct StaticOrder {
    int nM, nN, nwg, G, c;
    __device__ void init(int M, int N, int G_, int c_) { nM = M / BM; nN = N / BM; nwg = nM * nN; G = G_; c = c_; }
    __device__ bool next(int i, Unit& u) const {
        const long L = (long)i * G + c; if (L >= nwg) return false;
        int wgid = (int)L; { const int q = nwg / NXCD, r = nwg % NXCD, xcd = wgid % NXCD, off = wgid / NXCD; wgid = (xcd < r ? xcd * (q + 1) : r * (q + 1) + (xcd - r) * q) + off; }
        const int nig = WGM * nN, gid = wgid / nig, fm = gid * WGM, gsz = (nM - fm) < WGM ? (nM - fm) : WGM;
        u.pm = fm + ((wgid % nig) % gsz); u.pn = (wgid % nig) / gsz; return true;
    }
};
struct NoHook {
    __device__ __forceinline__ void begin(const Unit&, LAS unsigned char*) const {}
    __device__ __forceinline__ void at(f32x4 (&)[2][2][4][2], int, int, int, LAS unsigned char*) const {}
};

template <class Epi, class Sched, class Hook>
__device__ __forceinline__ void gemm_phase(LAS unsigned char* lds, const Gemm g, const Sched& S, const Epi& E, const Hook& H) {
    const int tid = threadIdx.x, wid = __builtin_amdgcn_readfirstlane(tid >> 6), lane = tid & 63, wr = wid >> 2, wc = wid & 3, fr = lane & 15, fq = lane >> 4;
    const int K = g.K, nt = K / BK;
    unsigned voffA[2], voffB[2];
#pragma unroll
    for (int i = 0; i < 2; ++i) { int R, C; stage_rc(tid * 16 + i * 8192, R, C); const int Rb = Epi::PERM ? ((R & ~31) + perm32(R & 31)) : R;
        voffA[i] = (unsigned)(R * K + C) * 2u; voffB[i] = (unsigned)(Rb * K + C) * 2u; }
    const size_t kstep = (size_t)(BK * 2);
    const size_t hstep = (size_t)HALF * K * 2;
    const size_t tstep = 2 * hstep;
    const unsigned ldsw = (unsigned)wid * 1024u;
    const int aoff = lds_byte(wr * 64 + fr, fq * 8), boff = lds_byte(wc * 32 + fr, fq * 8);
#define PG8_SA(b, h) (((b) * 2 + (h)) * HTB)
#define PG8_SB(b, h) ((4 + (b) * 2 + (h)) * HTB)
#define PG8_STAGE(bufoff, gbase, voff) do { _Pragma("unroll") for (int _i = 0; _i < 2; ++_i) \
        __builtin_amdgcn_global_load_lds((const unsigned*)((const char*)(gbase) + (voff)[_i]), (LAS unsigned*)(lds + (bufoff) + ldsw + _i * 8192), 16, 0, 0); } while (0)
#define PG8_LDA(dst, b, h) do { _Pragma("unroll") for (int m = 0; m < 4; ++m) _Pragma("unroll") for (int k = 0; k < 2; ++k) dst[m][k] = *(const LAS bf16x8*)(lds + PG8_SA(b, h) + aoff + m * 2048 + k * 1024); } while (0)
#define PG8_LDB(dst, b, h) do { _Pragma("unroll") for (int n = 0; n < 2; ++n) _Pragma("unroll") for (int k = 0; k < 2; ++k) dst[n][k] = *(const LAS bf16x8*)(lds + PG8_SB(b, h) + boff + n * 2048 + k * 1024); } while (0)
#define PG8_MMA(ai, bj, At, Bt) do { __builtin_amdgcn_s_setprio(1); _Pragma("unroll") for (int m = 0; m < 4; ++m) _Pragma("unroll") for (int n = 0; n < 2; ++n) _Pragma("unroll") for (int k = 0; k < 2; ++k) \
        acc[ai][bj][m][n] = __builtin_amdgcn_mfma_f32_16x16x32_bf16(Bt[n][k], At[m][k], acc[ai][bj][m][n], 0, 0, 0); __builtin_amdgcn_s_setprio(0); } while (0)
#define PG8_WAIT_V(n) asm volatile("s_waitcnt vmcnt(" #n ")" ::: "memory")
#define PG8_WAIT_L(n) asm volatile("s_waitcnt lgkmcnt(" #n ")" ::: "memory")
#define PG8_BAR __builtin_amdgcn_s_barrier()
#define PG8_SCHED __builtin_amdgcn_sched_barrier(0)
    Unit cur, nxt; int ui = 0;
    if (!S.next(0, cur)) return;
    f32x4 acc[2][2][4][2];
#pragma unroll
    for (int a = 0; a < 2; ++a)
#pragma unroll
        for (int b = 0; b < 2; ++b)
#pragma unroll
            for (int m = 0; m < 4; ++m)
#pragma unroll
                for (int n = 0; n < 2; ++n) acc[a][b][m][n] = (f32x4){0.f, 0.f, 0.f, 0.f};
    bf16x8 At[4][2], B0[2][2], B1[2][2];
    const char* cA = (const char*)g.A + (size_t)cur.pm * tstep; const char* cB = (const char*)g.Bt + (size_t)cur.pn * tstep;
    H.begin(cur, lds);
    PG8_STAGE(PG8_SB(0, 0), cB, voffB); PG8_STAGE(PG8_SA(0, 0), cA, voffA); PG8_STAGE(PG8_SB(0, 1), cB + hstep, voffB); PG8_STAGE(PG8_SA(0, 1), cA + hstep, voffA);
    if (wr == 1) PG8_BAR;
    PG8_WAIT_V(4); PG8_BAR;
    PG8_STAGE(PG8_SB(1, 0), cB + kstep, voffB); PG8_STAGE(PG8_SA(1, 0), cA + kstep, voffA); PG8_STAGE(PG8_SB(1, 1), cB + hstep + kstep, voffB);
    PG8_WAIT_V(6); PG8_BAR;
    for (;;) {
        const bool has_next = S.next(ui + 1, nxt);
        const char* nA = has_next ? (const char*)g.A + (size_t)nxt.pm * tstep : cA; const char* nB = has_next ? (const char*)g.Bt + (size_t)nxt.pn * tstep : cB;
        for (int t = 0; t < nt; t += 2) {
            const bool last = (t == nt - 2);
            const char* a1 = cA + (size_t)(t + 1) * kstep;
            const char* a2 = last ? nA : cA + (size_t)(t + 2) * kstep; const char* b2 = last ? nB : cB + (size_t)(t + 2) * kstep;
            const char* a3 = a2 + kstep; const char* b3 = b2 + kstep;
            H.at(acc, t, wr, fr, lds);
            PG8_LDB(B0, 0, 0); PG8_SCHED; PG8_LDA(At, 0, 0); PG8_STAGE(PG8_SA(1, 1), a1 + hstep, voffA);
            PG8_WAIT_L(8); PG8_BAR; PG8_WAIT_L(0); PG8_MMA(0, 0, At, B0); PG8_BAR; PG8_SCHED;
            PG8_LDB(B1, 0, 1); PG8_STAGE(PG8_SB(0, 0), b2, voffB);
            PG8_BAR; PG8_WAIT_L(0); PG8_MMA(0, 1, At, B1); PG8_BAR;
            PG8_LDA(At, 0, 1); PG8_STAGE(PG8_SA(0, 0), a2, voffA);
            PG8_BAR; PG8_WAIT_L(0); PG8_MMA(1, 0, At, B0); PG8_BAR; PG8_SCHED;
            PG8_STAGE(PG8_SB(0, 1), b2 + hstep, voffB);
            PG8_WAIT_V(6); PG8_BAR; PG8_MMA(1, 1, At, B1); PG8_BAR;
            PG8_LDB(B0, 1, 0); PG8_SCHED; PG8_LDA(At, 1, 0); PG8_STAGE(PG8_SA(0, 1), a2 + hstep, voffA);
            PG8_WAIT_L(8); PG8_BAR; PG8_WAIT_L(0); PG8_MMA(0, 0, At, B0); PG8_BAR; PG8_SCHED;
            PG8_LDB(B1, 1, 1); PG8_STAGE(PG8_SB(1, 0), b3, voffB);
            PG8_BAR; PG8_WAIT_L(0); PG8_MMA(0, 1, At, B1); PG8_BAR;
            PG8_LDA(At, 1, 1); PG8_STAGE(PG8_SA(1, 0), a3, voffA);
            PG8_BAR; PG8_WAIT_L(0); PG8_MMA(1, 0, At, B0); PG8_BAR; PG8_SCHED;
            PG8_STAGE(PG8_SB(1, 1), b3 + hstep, voffB);
            PG8_WAIT_V(6); PG8_BAR; PG8_MMA(1, 1, At, B1); PG8_BAR;
        }
        E(acc, cur, wr, wc, fr, fq);
        if (!has_next) break;
#pragma unroll
        for (int a = 0; a < 2; ++a)
#pragma unroll
            for (int b = 0; b < 2; ++b)
#pragma unroll
                for (int m = 0; m < 4; ++m)
#pragma unroll
                    for (int n = 0; n < 2; ++n) acc[a][b][m][n] = (f32x4){0.f, 0.f, 0.f, 0.f};
        cur = nxt; cA = nA; cB = nB; ++ui;
        H.begin(cur, lds);
    }
    PG8_WAIT_V(0);
    if (wr == 0) PG8_BAR;
    PG8_BAR;
#undef PG8_SA
#undef PG8_SB
#undef PG8_STAGE
#undef PG8_LDA
#undef PG8_LDB
#undef PG8_MMA
#undef PG8_WAIT_V
#undef PG8_WAIT_L
#undef PG8_BAR
#undef PG8_SCHED
}
}

struct EpiIn0 {
    static constexpr bool PERM = true;
    bf16_t *Y0, *XBC, *Q0, *K0, *V0; const float* rstd; float* kpart;
    __device__ __forceinline__ void operator()(const f32x4 (&acc)[2][2][4][2], const pg8::Unit& u, int wr, int wc, int fr, int fq) const {
        const int pn = u.pn; bf16_t* base; int ld, colt, mode;
        if (pn < 8) { base = Y0; ld = 2048; colt = pn * 256; mode = 1; }
        else if (pn < 14) { base = XBC; ld = 1536; colt = (pn - 8) * 256; mode = 0; }
        else if (pn < 18) { base = Q0; ld = 1024; colt = (pn - 14) * 256; mode = 2; }
        else if (pn < 22) { base = K0; ld = 1024; colt = (pn - 18) * 256; mode = 3; }
        else { base = V0; ld = 1024; colt = (pn - 22) * 256; mode = 0; }
        const int row0 = u.pm * 256 + wr * 64 + fr, col0 = colt + wc * 32 + 8 * fq;
        float cs[2][8];
#pragma unroll
        for (int bj = 0; bj < 2; ++bj)
#pragma unroll
            for (int e = 0; e < 8; ++e) cs[bj][e] = 0.f;
#pragma unroll
        for (int ai = 0; ai < 2; ++ai)
#pragma unroll
            for (int m = 0; m < 4; ++m) {
                const int row = row0 + ai * 128 + m * 16; const float rs = rstd[row]; bf16_t* rowp = base + (size_t)row * ld + col0;
#pragma unroll
                for (int bj = 0; bj < 2; ++bj) {
                    float v[8];
#pragma unroll
                    for (int e = 0; e < 4; ++e) { v[e] = acc[ai][bj][m][0][e] * rs; v[4 + e] = acc[ai][bj][m][1][e] * rs; }
                    if (mode == 1) {
#pragma unroll
                        for (int e = 0; e < 8; ++e) v[e] = silu_f(v[e]);
                    } else if (mode == 2) {
#pragma unroll
                        for (int e = 0; e < 8; ++e) v[e] *= QSCALE;
                    } else if (mode == 3) {
#pragma unroll
                        for (int e = 0; e < 8; ++e) cs[bj][e] += v[e];
                    }
                    u32x4 w; w.x = pk2(v[0], v[1]); w.y = pk2(v[2], v[3]); w.z = pk2(v[4], v[5]); w.w = pk2(v[6], v[7]);
                    *(u32x4*)(rowp + bj * 128) = w;
                }
            }
        if (mode == 3) {
#pragma unroll
            for (int bj = 0; bj < 2; ++bj)
#pragma unroll
                for (int e = 0; e < 8; ++e) { float s = cs[bj][e]; s += __shfl_xor(s, 1); s += __shfl_xor(s, 2); s += __shfl_xor(s, 4); s += __shfl_xor(s, 8); cs[bj][e] = s; }
            if (fr == 0) {
                float* kp = kpart + ((size_t)u.pm * 2 + wr) * 1024 + col0;
#pragma unroll
                for (int bj = 0; bj < 2; ++bj) { *(f32x4*)(kp + bj * 128) = (f32x4){cs[bj][0], cs[bj][1], cs[bj][2], cs[bj][3]}; *(f32x4*)(kp + bj * 128 + 4) = (f32x4){cs[bj][4], cs[bj][5], cs[bj][6], cs[bj][7]}; }
            }
        }
    }
};
struct EpiRes {
    static constexpr bool PERM = false;
    const float* xi; float* xo; bf16_t* xb; float* rsq;
    __device__ __forceinline__ void operator()(const f32x4 (&acc)[2][2][4][2], const pg8::Unit& u, int wr, int wc, int fr, int fq) const {
        const int col0 = u.pn * 256 + wc * 32 + 4 * fq;
#pragma unroll
        for (int ai = 0; ai < 2; ++ai)
#pragma unroll
            for (int m = 0; m < 4; ++m) {
                const int row = u.pm * 256 + ai * 128 + wr * 64 + m * 16 + fr; const size_t off = (size_t)row * DM + col0; float ss = 0.f;
#pragma unroll
                for (int bj = 0; bj < 2; ++bj)
#pragma unroll
                    for (int n = 0; n < 2; ++n) {
                        const f32x4 b = *(const f32x4*)(xi + off + bj * 128 + n * 16); const f32x4 o = b + acc[ai][bj][m][n];
                        *(f32x4*)(xo + off + bj * 128 + n * 16) = o; ss += (o[0] * o[0] + o[1] * o[1]) + (o[2] * o[2] + o[3] * o[3]);
                        if (xb) { u32x2 w; w.x = pk2(o[0], o[1]); w.y = pk2(o[2], o[3]); *(u32x2*)(xb + off + bj * 128 + n * 16) = w; }
                    }
                ss += __shfl_xor(ss, 16); ss += __shfl_xor(ss, 32);
                if (fq == 0) rsq[(size_t)row * 16 + u.pn * 4 + wc] = ss;
            }
    }
};
__device__ __forceinline__ float rstd_from16(const float* p) {
    const f32x4 a = *(const f32x4*)p, b = *(const f32x4*)(p + 4), c = *(const f32x4*)(p + 8), d = *(const f32x4*)(p + 12);
    const float s = ((a[0] + a[1]) + (a[2] + a[3])) + ((b[0] + b[1]) + (b[2] + b[3])) + ((c[0] + c[1]) + (c[2] + c[3])) + ((d[0] + d[1]) + (d[2] + d[3]));
    return 1.0f / sqrtf(s * (1.0f / 1024.0f) + NORM_EPS);
}
struct EpiQkv1 {
    static constexpr bool PERM = true;
    bf16_t* O; size_t split_stride; const float* rsq;
    __device__ __forceinline__ void operator()(const f32x4 (&acc)[2][2][4][2], const pg8::Unit& u, int wr, int wc, int fr, int fq) const {
        const int t = u.pn >> 3; bf16_t* base = O + (size_t)t * split_stride; const int colt = (u.pn & 7) * 256; const float sc = (t == 0) ? QSCALE : 1.0f;
        const int row0 = u.pm * 256 + wr * 64 + fr, col0 = colt + wc * 32 + 8 * fq;
#pragma unroll
        for (int ai = 0; ai < 2; ++ai)
#pragma unroll
            for (int m = 0; m < 4; ++m) {
                const int row = row0 + ai * 128 + m * 16; const float rs = rstd_from16(rsq + (size_t)row * 16) * sc; bf16_t* rowp = base + (size_t)row * 2048 + col0;
#pragma unroll
                for (int bj = 0; bj < 2; ++bj) { const f32x4 v0 = acc[ai][bj][m][0] * rs, v1 = acc[ai][bj][m][1] * rs;
                    u32x4 w; w.x = pk2(v0[0], v0[1]); w.y = pk2(v0[2], v0[3]); w.z = pk2(v1[0], v1[1]); w.w = pk2(v1[2], v1[3]); *(u32x4*)(rowp + bj * 128) = w; }
            }
    }
};
struct EpiGate1 {
    static constexpr bool PERM = true;
    bf16_t* O; const float* rsq;
    __device__ __forceinline__ void operator()(const f32x4 (&acc)[2][2][4][2], const pg8::Unit& u, int wr, int wc, int fr, int fq) const {
        const int row0 = u.pm * 256 + wr * 64 + fr, col0 = u.pn * 256 + wc * 32 + 8 * fq;
#pragma unroll
        for (int ai = 0; ai < 2; ++ai)
#pragma unroll
            for (int m = 0; m < 4; ++m) {
                const int row = row0 + ai * 128 + m * 16; const float rs = rstd_from16(rsq + (size_t)row * 16); bf16_t* rowp = O + (size_t)row * 2048 + col0;
#pragma unroll
                for (int bj = 0; bj < 2; ++bj) { const f32x4 v0 = acc[ai][bj][m][0] * rs, v1 = acc[ai][bj][m][1] * rs; const u32x4 o = *(const u32x4*)(rowp + bj * 128);
                    u32x4 w; w.x = pk2(bf_lo(o.x) * silu_f(v0[0]), bf_hi(o.x) * silu_f(v0[1])); w.y = pk2(bf_lo(o.y) * silu_f(v0[2]), bf_hi(o.y) * silu_f(v0[3]));
                    w.z = pk2(bf_lo(o.z) * silu_f(v1[0]), bf_hi(o.z) * silu_f(v1[1])); w.w = pk2(bf_lo(o.w) * silu_f(v1[2]), bf_hi(o.w) * silu_f(v1[3])); *(u32x4*)(rowp + bj * 128) = w; }
            }
    }
};
struct HookSsdNorm {
    const float* ssq;
    __device__ __forceinline__ void begin(const pg8::Unit& u, LAS unsigned char* lds) const {
        LAS float* T = (LAS float*)(lds + RING_BYTES);
        const int t = threadIdx.x;
        if (t < 256) { const float* p = ssq + (size_t)(u.pm * 256 + t) * 16; const f32x4 a = *(const f32x4*)p, b = *(const f32x4*)(p + 4), c = *(const f32x4*)(p + 8), d = *(const f32x4*)(p + 12);
            const float g0 = ((a[0] + a[1]) + (a[2] + a[3])) + ((b[0] + b[1]) + (b[2] + b[3])), g1 = ((c[0] + c[1]) + (c[2] + c[3])) + ((d[0] + d[1]) + (d[2] + d[3]));
            const float r0 = 1.0f / sqrtf(g0 * (1.0f / 512.0f) + NORM_EPS), r1 = 1.0f / sqrtf(g1 * (1.0f / 512.0f) + NORM_EPS);
            T[2 * t] = r0 / r1; T[2 * t + 1] = r1; }
    }
    __device__ __forceinline__ void at(f32x4 (&acc)[2][2][4][2], int t, int wr, int fr, LAS unsigned char* lds) const {
        if (t == 8 || t == 16) {
            const LAS float* T = (const LAS float*)(lds + RING_BYTES); const int sel = (t == 16);
#pragma unroll
            for (int ai = 0; ai < 2; ++ai)
#pragma unroll
                for (int m = 0; m < 4; ++m) { const float f = T[2 * (ai * 128 + wr * 64 + m * 16 + fr) + sel];
#pragma unroll
                    for (int bj = 0; bj < 2; ++bj)
#pragma unroll
                        for (int n = 0; n < 2; ++n) acc[ai][bj][m][n] = acc[ai][bj][m][n] * f; }
        }
    }
};

__device__ __forceinline__ void transpose_item(const float* W, int K, int Nsrc, int src_col0, bf16_t* WT, int dst_row0, const float* gain, int gain_n, LAS float* scr, int kb, int nb, int lane) {
    const int k0 = 64 * kb, n0 = 32 * nb;
#pragma unroll 8
    for (int i = 0; i < 32; ++i) { const int kk = 2 * i + (lane >> 5); const int k = k0 + kk; const float gsc = (gain && k < gain_n) ? gain[k] : 1.0f;
        scr[kk * 33 + (lane & 31)] = W[(size_t)k * Nsrc + src_col0 + n0 + (lane & 31)] * gsc; }
    asm volatile("s_waitcnt lgkmcnt(0)" ::: "memory");
    const int c = lane & 7;
#pragma unroll
    for (int j = 0; j < 4; ++j) { const int n = (lane >> 3) + 8 * j; const LAS float* s = scr + (8 * c) * 33 + n;
        u32x4 o; o.x = pk2(s[0 * 33], s[1 * 33]); o.y = pk2(s[2 * 33], s[3 * 33]); o.z = pk2(s[4 * 33], s[5 * 33]); o.w = pk2(s[6 * 33], s[7 * 33]);
        *(u32x4*)(WT + (size_t)(dst_row0 + n0 + n) * K + k0 + 8 * c) = o; }
    asm volatile("s_waitcnt lgkmcnt(0)" ::: "memory");
}
__device__ __forceinline__ float softplus_f(float v) { return v > 20.f ? v : log1pf(expf(v)); }

__device__ __forceinline__ void phase_prep(const Params& P, LAS unsigned char* lds, int G) {
    const int tid = threadIdx.x, lane = tid & 63, wave = tid >> 6;
    const int gw = blockIdx.x * 8 + wave, NGW = G * 8;
    unsigned char* ws = P.ws;
    if (blockIdx.x == 0 && tid < 64) ((unsigned*)(ws + WS_CTL))[tid] = 0u;
    {
        LAS float* scr = (LAS float*)(lds + wave * 16384);
        bf16_t* W0T = (bf16_t*)(ws + WS_W0T); bf16_t* WO0T = (bf16_t*)(ws + WS_WO0T); bf16_t* W1T = (bf16_t*)(ws + WS_W1T); bf16_t* WO1T = (bf16_t*)(ws + WS_WO1T);
        constexpr int I0 = 16 * 208, IO0 = 32 * 32, I1 = 16 * 256, IO1 = 32 * 32;
        for (int it = gw; it < I0 + IO0 + I1 + IO1; it += NGW) {
            int r = it;
            if (r < I0) { const int kb = r / 208, nb = r % 208; const int n0 = nb * 32;
                int src; if (n0 < 1024) src = n0; else if (n0 < 2048) src = n0 - 1024 + 5648; else if (n0 < 3584) src = n0 - 2048 + 1024; else src = n0 - 3584 + 2576;
                transpose_item(P.w_in0, 1024, EVEN_IN, src - n0, W0T, 0, P.even_norm, 1024, scr, kb, nb, lane); continue; }
            r -= I0;
            if (r < IO0) { transpose_item(P.w_out0, 2048, 1024, 0, WO0T, 0, P.ssd_norm, 1024, scr, r / 32, r % 32, lane); continue; }
            r -= IO0;
            if (r < I1) { transpose_item(P.w_in1, 1024, 8192, 0, W1T, 0, P.odd_norm, 1024, scr, r / 256, r % 256, lane); continue; }
            r -= I1;
            transpose_item(P.w_out1, 2048, 1024, 0, WO1T, 0, nullptr, 0, scr, r / 32, r % 32, lane);
        }
    }
    __syncthreads();
    {
        LAS float* Wd = (LAS float*)lds;
        for (int i = tid; i < 16 * 1024; i += NTHREADS) { const int k = i >> 4, h = i & 15; Wd[h * 1024 + k] = P.w_in0[(size_t)k * EVEN_IN + 2560 + h] * P.even_norm[k]; }
        __syncthreads();
        bf16_t* xb = (bf16_t*)P.out; float* rstd0 = (float*)(ws + WS_RSTD0); float* dt = (float*)(ws + WS_DT);
        for (int m = gw; m < MTOK; m += NGW) {
            const f32x4* xr = (const f32x4*)(P.x + (size_t)m * DM) + lane;
            f32x4 v[4]; float s = 0.f;
#pragma unroll
            for (int j = 0; j < 4; ++j) { v[j] = xr[64 * j]; s += (v[j][0] * v[j][0] + v[j][1] * v[j][1]) + (v[j][2] * v[j][2] + v[j][3] * v[j][3]); }
            const float rs = 1.0f / sqrtf(wave_sum(s) * (1.0f / DM) + NORM_EPS);
            unsigned long long* o8 = (unsigned long long*)(xb + (size_t)m * DM) + lane;
#pragma unroll
            for (int j = 0; j < 4; ++j) o8[64 * j] = (unsigned long long)pk2(v[j][0], v[j][1]) | ((unsigned long long)pk2(v[j][2], v[j][3]) << 32);
            float mine = 0.f;
#pragma unroll 1
            for (int h = 0; h < 16; ++h) { float a = 0.f;
#pragma unroll
                for (int j = 0; j < 4; ++j) { const f32x4 w = *(const LAS f32x4*)(Wd + h * 1024 + 256 * j + 4 * lane); a += (v[j][0] * w[0] + v[j][1] * w[1]) + (v[j][2] * w[2] + v[j][3] * w[3]); }
                a = wave_sum(a); if (lane == h) mine = a; }
            if (lane == 0) rstd0[m] = rs;
            if (lane < 16) dt[(size_t)m * 16 + lane] = softplus_f(mine * rs + P.dt_bias[lane]);
        }
    }
}

__device__ __forceinline__ void ssd_item(const Params& P, LAS unsigned char* lds, int b, int h) {
    constexpr int TT = 64;
    const int tid = threadIdx.x;
    unsigned char* ws = P.ws;
    const bf16_t* XBC = (const bf16_t*)(ws + WS_XBC); bf16_t* Y0 = (bf16_t*)(ws + WS_Y0); const float* dt = (const float*)(ws + WS_DT); float* ssq = (float*)(ws + WS_SSQ);
    LAS float* xc = (LAS float*)lds;
    LAS float* Bc = xc + TT * 64;
    LAS float* Cc = Bc + TT * 128;
    LAS float* zs = Cc + TT * 128;
    LAS float* uo = zs + TT * 64;
    LAS float* dtv = uo + TT * 64;
    LAS float* dec = dtv + TT;
    const int g = h >> 3;
    const float a = -expf(P.a_log[h]), Dh = P.d_skip[h];
    const int p = tid >> 3, ng = tid & 7;
    float st[16];
#pragma unroll
    for (int i = 0; i < 16; ++i) st[i] = 0.f;
    int ch = 0; float cw0 = 0.f, cw1 = 0.f, cw2 = 0.f, cw3 = 0.f, cb = 0.f;
    if (tid < 320) { ch = tid < 64 ? h * 64 + tid : (tid < 192 ? 1024 + g * 128 + (tid - 64) : 1280 + g * 128 + (tid - 192));
        cw0 = P.conv_w[ch]; cw1 = P.conv_w[1536 + ch]; cw2 = P.conv_w[2 * 1536 + ch]; cw3 = P.conv_w[3 * 1536 + ch]; cb = P.conv_b[ch]; }
    for (int t0 = 0; t0 < SEQ; t0 += TT) {
        const size_t tok0 = (size_t)b * SEQ + t0;
        if (tid < 320) {
            float w0 = 0.f, w1 = 0.f, w2 = 0.f;
            if (t0 > 0) { w0 = bf2f(XBC[(tok0 - 3) * 1536 + ch]); w1 = bf2f(XBC[(tok0 - 2) * 1536 + ch]); w2 = bf2f(XBC[(tok0 - 1) * 1536 + ch]); }
            LAS float* dst = tid < 64 ? xc + tid : (tid < 192 ? Bc + (tid - 64) : Cc + (tid - 192)); const int dstride = tid < 64 ? 64 : 128;
            for (int tt = 0; tt < TT; ++tt) { const float w3 = bf2f(XBC[(tok0 + tt) * 1536 + ch]);
                const float v = cb + cw0 * w0 + cw1 * w1 + cw2 * w2 + cw3 * w3; dst[tt * dstride] = silu_f(v); w0 = w1; w1 = w2; w2 = w3; }
        } else if (tid < 320 + TT) { const int tt = tid - 320; const float d = dt[(tok0 + tt) * 16 + h]; dtv[tt] = d; dec[tt] = expf(d * a); }
        for (int i = tid; i < TT * 64; i += NTHREADS) { const int tt = i >> 6, pp = i & 63; zs[i] = bf2f(Y0[(tok0 + tt) * 2048 + h * 64 + pp]); }
        __syncthreads();
        for (int tt = 0; tt < TT; ++tt) {
            const float xv = xc[tt * 64 + p], xdt = xv * dtv[tt], dc = dec[tt];
            const LAS float* Bp = Bc + tt * 128 + 16 * ng; const LAS float* Cp = Cc + tt * 128 + 16 * ng;
            float yp = 0.f;
#pragma unroll
            for (int i = 0; i < 16; ++i) { st[i] = st[i] * dc + xdt * Bp[i]; yp += st[i] * Cp[i]; }
            yp += __shfl_xor(yp, 1); yp += __shfl_xor(yp, 2); yp += __shfl_xor(yp, 4);
            if (ng == 0) uo[tt * 64 + p] = (yp + Dh * xv) * zs[tt * 64 + p];
        }
        __syncthreads();
        { const int tt = tid >> 3, part = tid & 7; const LAS float* up = uo + tt * 64 + part * 8; float v[8]; float ss = 0.f;
#pragma unroll
            for (int e = 0; e < 8; ++e) { v[e] = up[e]; ss += v[e] * v[e]; }
            u32x4 w; w.x = pk2(v[0], v[1]); w.y = pk2(v[2], v[3]); w.z = pk2(v[4], v[5]); w.w = pk2(v[6], v[7]);
            *(u32x4*)(Y0 + (tok0 + tt) * 2048 + h * 64 + part * 8) = w;
            ss += __shfl_xor(ss, 1); ss += __shfl_xor(ss, 2); ss += __shfl_xor(ss, 4);
            if (part == 0) ssq[(tok0 + tt) * 16 + h] = ss; }
        __syncthreads();
    }
}

struct KeysDilated {
    __device__ __forceinline__ int nkeys(int) const { return 387; }
    __device__ __forceinline__ int keypos(int qpos, int idx) const { const int pt = idx / 129, j = idx - pt * 129; return qpos - (j << (2 * pt)); }
};
struct KeysMoba {
    const LAS int* sel;
    int q0;
    __device__ __forceinline__ int nkeys(int qpos) const { return sel[(qpos - q0) * 4] * 256 + (qpos & 255) + 1; }
    __device__ __forceinline__ int keypos(int qpos, int idx) const { const LAS int* s = sel + (qpos - q0) * 4; const int ns = s[0];
        if (idx < ns * 256) return s[1 + (idx >> 8)] * 256 + (idx & 255);
        return (qpos & ~255) + (idx - ns * 256); }
};
template <class KS>
__device__ __forceinline__ void attn_simple_core(const KS& ks, LAS float* qs, LAS float* Ssc, const bf16_t* Kp, const bf16_t* Vp, int ld, int q0, float (&o)[8], float& lsum) {
    const int tid = threadIdx.x, qi = tid >> 4, part = tid & 15;
    const int qpos = q0 + qi, nk = ks.nkeys(qpos);
    LAS float* Sr = Ssc + qi * 1024; const LAS float* qr = qs + qi * 128;
    float mx = -3.0e38f;
    for (int idx = part; idx < nk; idx += 16) {
        const int pos = ks.keypos(qpos, idx); float s = -__builtin_inff();
        if (pos >= 0) { const u32x4* kr = (const u32x4*)(Kp + (size_t)pos * ld); float a = 0.f;
#pragma unroll
            for (int c = 0; c < 16; ++c) { const u32x4 w = kr[c]; const f32x4 q0v = *(const LAS f32x4*)(qr + 8 * c), q1v = *(const LAS f32x4*)(qr + 8 * c + 4);
                a += (bf_lo(w.x) * q0v[0] + bf_hi(w.x) * q0v[1]) + (bf_lo(w.y) * q0v[2] + bf_hi(w.y) * q0v[3]) + (bf_lo(w.z) * q1v[0] + bf_hi(w.z) * q1v[1]) + (bf_lo(w.w) * q1v[2] + bf_hi(w.w) * q1v[3]); }
            s = a; }
        Sr[idx] = s; mx = fmaxf(mx, s);
    }
    mx = fmaxf(mx, __shfl_xor(mx, 1)); mx = fmaxf(mx, __shfl_xor(mx, 2)); mx = fmaxf(mx, __shfl_xor(mx, 4)); mx = fmaxf(mx, __shfl_xor(mx, 8));
    float l = 0.f;
    for (int idx = part; idx < nk; idx += 16) { const float pv = exp2f(Sr[idx] - mx); Sr[idx] = pv; l += pv; }
    l += __shfl_xor(l, 1); l += __shfl_xor(l, 2); l += __shfl_xor(l, 4); l += __shfl_xor(l, 8);
    lsum = l;
    asm volatile("s_waitcnt lgkmcnt(0)" ::: "memory");
    __syncthreads();
#pragma unroll
    for (int e = 0; e < 8; ++e) o[e] = 0.f;
    for (int idx = 0; idx < nk; ++idx) {
        const float pv = Sr[idx];
        if (pv != 0.f) { const int pos = ks.keypos(qpos, idx); const u32x4 w = *(const u32x4*)(Vp + (size_t)pos * ld + 8 * part);
            o[0] += pv * bf_lo(w.x); o[1] += pv * bf_hi(w.x); o[2] += pv * bf_lo(w.y); o[3] += pv * bf_hi(w.y); o[4] += pv * bf_lo(w.z); o[5] += pv * bf_hi(w.z); o[6] += pv * bf_lo(w.w); o[7] += pv * bf_hi(w.w); }
    }
}
__device__ __forceinline__ void load_q_tile(LAS float* qs, const bf16_t* Qp, int ld) {
    const int tid = threadIdx.x, r = tid >> 4, c = tid & 15;
    const u32x4 w = *(const u32x4*)(Qp + (size_t)r * ld + 8 * c); LAS float* d = qs + r * 128 + 8 * c;
    d[0] = bf_lo(w.x); d[1] = bf_hi(w.x); d[2] = bf_lo(w.y); d[3] = bf_hi(w.y); d[4] = bf_lo(w.z); d[5] = bf_hi(w.z); d[6] = bf_lo(w.w); d[7] = bf_hi(w.w);
}
__device__ __forceinline__ void moba_item(const Params& P, LAS unsigned char* lds, int b, int h, int qt) {
    unsigned char* ws = P.ws; const int tid = threadIdx.x;
    LAS float* Ssc = (LAS float*)lds; LAS float* qs = (LAS float*)(lds + 131072); LAS float* gts = (LAS float*)(lds + 131072 + 16384); LAS int* sel = (LAS int*)(lds + 131072 + 16384 + 1024);
    const bf16_t* Q0 = (const bf16_t*)(ws + WS_Q0) + (size_t)b * SEQ * 1024 + h * 128; const bf16_t* K0 = (const bf16_t*)(ws + WS_K0) + (size_t)b * SEQ * 1024 + h * 128;
    const bf16_t* V0 = (const bf16_t*)(ws + WS_V0) + (size_t)b * SEQ * 1024 + h * 128; bf16_t* Y0 = (bf16_t*)(ws + WS_Y0) + (size_t)b * SEQ * 2048 + 1024 + h * 128;
    const float* kpart = (const float*)(ws + WS_KPART);
    const int q0 = qt * 32, qb = q0 >> 8;
    __syncthreads();
    load_q_tile(qs, Q0 + (size_t)q0 * 1024, 1024);
    __syncthreads();
    { const int qi = tid >> 4, n = tid & 15;
        if (n < qb) { const float* k0p = kpart + ((size_t)(b * 8 + n) * 2) * 1024 + h * 128; const float* k1p = k0p + 1024; float a = 0.f;
            for (int d = 0; d < 128; ++d) a += qs[qi * 128 + d] * (k0p[d] + k1p[d]);
            gts[qi * 8 + n] = a; } }
    __syncthreads();
    if (tid < 32) { const int ns = qb < 3 ? qb : 3; int s0 = -1, s1 = -1, s2 = -1; float g0 = -__builtin_inff(), g1 = g0, g2 = g0;
        for (int n = 0; n < qb; ++n) { const float gv = gts[tid * 8 + n];
            if (gv > g0) { g2 = g1; s2 = s1; g1 = g0; s1 = s0; g0 = gv; s0 = n; } else if (gv > g1) { g2 = g1; s2 = s1; g1 = gv; s1 = n; } else if (gv > g2) { g2 = gv; s2 = n; } }
        sel[tid * 4] = ns; sel[tid * 4 + 1] = s0 < 0 ? 0 : s0; sel[tid * 4 + 2] = s1 < 0 ? 0 : s1; sel[tid * 4 + 3] = s2 < 0 ? 0 : s2; }
    __syncthreads();
    KeysMoba ks{sel, q0}; float o[8]; float l;
    attn_simple_core(ks, qs, Ssc, K0, V0, 1024, q0, o, l);
    const int qi = tid >> 4, part = tid & 15; const float inv = 1.0f / l;
    bf16_t* yp = Y0 + (size_t)(q0 + qi) * 2048 + 8 * part; const u32x4 gw = *(const u32x4*)yp;
    u32x4 w; w.x = pk2(o[0] * inv * bf_lo(gw.x), o[1] * inv * bf_hi(gw.x)); w.y = pk2(o[2] * inv * bf_lo(gw.y), o[3] * inv * bf_hi(gw.y));
    w.z = pk2(o[4] * inv * bf_lo(gw.z), o[5] * inv * bf_hi(gw.z)); w.w = pk2(o[6] * inv * bf_lo(gw.w), o[7] * inv * bf_hi(gw.w));
    *(u32x4*)yp = w;
}
__device__ __forceinline__ void dilated_item(const Params& P, LAS unsigned char* lds, int b, int h, int qt) {
    unsigned char* ws = P.ws; const int tid = threadIdx.x;
    LAS float* Ssc = (LAS float*)lds; LAS float* qs = (LAS float*)(lds + 131072);
    bf16_t* Q1 = (bf16_t*)(ws + WS_QO1) + (size_t)b * SEQ * 2048 + h * 128; const bf16_t* K1 = (const bf16_t*)(ws + WS_K1) + (size_t)b * SEQ * 2048 + h * 128;
    const bf16_t* V1 = (const bf16_t*)(ws + WS_V1) + (size_t)b * SEQ * 2048 + h * 128;
    const int q0 = qt * 32;
    __syncthreads();
    load_q_tile(qs, Q1 + (size_t)q0 * 2048, 2048);
    __syncthreads();
    KeysDilated ks; float o[8]; float l;
    attn_simple_core(ks, qs, Ssc, K1, V1, 2048, q0, o, l);
    const int qi = tid >> 4, part = tid & 15; const float inv = 1.0f / l;
    u32x4 w; w.x = pk2(o[0] * inv, o[1] * inv); w.y = pk2(o[2] * inv, o[3] * inv); w.z = pk2(o[4] * inv, o[5] * inv); w.w = pk2(o[6] * inv, o[7] * inv);
    *(u32x4*)(Q1 + (size_t)(q0 + qi) * 2048 + 8 * part) = w;
}

typedef short s16x4 __attribute__((ext_vector_type(4)));
constexpr int KSTR = 272, VSTR = 288;
#define MFMA16(a, b, c) __builtin_amdgcn_mfma_f32_16x16x32_bf16((a), (b), (c), 0, 0, 0)
struct WTile { bf16x8 qf[4]; f32x4 o[8]; float m, l; };
__device__ __forceinline__ void wt_reset(WTile& w) {
#pragma unroll
    for (int d = 0; d < 8; ++d) w.o[d] = (f32x4){0.f, 0.f, 0.f, 0.f};
    w.m = -1.0e30f; w.l = 0.f;
}
__device__ __forceinline__ void wt_load_q(WTile& w, const bf16_t* qrow, int lane) {
    const int g = lane >> 4;
#pragma unroll
    for (int ks = 0; ks < 4; ++ks) w.qf[ks] = *(const bf16x8*)(qrow + 32 * ks + 8 * g);
}
__device__ __forceinline__ void wt_qk_lds(const WTile& w, const LAS unsigned char* Kb, int lane, f32x4& s0, f32x4& s1) {
    const LAS unsigned char* p = Kb + (lane & 15) * KSTR + (lane >> 4) * 16;
    s0 = (f32x4){0.f, 0.f, 0.f, 0.f}; s1 = s0;
#pragma unroll
    for (int ks = 0; ks < 4; ++ks) { const bf16x8 a0 = *(const LAS bf16x8*)(p + ks * 64), a1 = *(const LAS bf16x8*)(p + 16 * KSTR + ks * 64);
        s0 = MFMA16(a0, w.qf[ks], s0); s1 = MFMA16(a1, w.qf[ks], s1); }
}
__device__ __forceinline__ void wt_softmax_pv(WTile& w, f32x4 s0, f32x4 s1, const LAS unsigned char* Vb, int lane) {
    float mx = fmaxf(fmaxf(fmaxf(s0[0], s0[1]), fmaxf(s0[2], s0[3])), fmaxf(fmaxf(s1[0], s1[1]), fmaxf(s1[2], s1[3])));
    mx = fmaxf(mx, __shfl_xor(mx, 16)); mx = fmaxf(mx, __shfl_xor(mx, 32));
    const float mn = fmaxf(w.m, mx), alpha = __builtin_amdgcn_exp2f(w.m - mn);
    w.m = mn;
    float p[8];
#pragma unroll
    for (int r = 0; r < 4; ++r) { p[r] = __builtin_amdgcn_exp2f(s0[r] - mn); p[4 + r] = __builtin_amdgcn_exp2f(s1[r] - mn); }
    w.l = w.l * alpha + (((p[0] + p[1]) + (p[2] + p[3])) + ((p[4] + p[5]) + (p[6] + p[7])));
    u32x4 pw; pw.x = pk2(p[0], p[1]); pw.y = pk2(p[2], p[3]); pw.z = pk2(p[4], p[5]); pw.w = pk2(p[6], p[7]);
    const bf16x8 pf = __builtin_bit_cast(bf16x8, pw);
    const int i = lane & 15, g = lane >> 4;
    const LAS unsigned char* vp = Vb + (4 * g + (i >> 2)) * VSTR + (i & 3) * 8;
#pragma unroll
    for (int dt = 0; dt < 8; ++dt) {
        const s16x4 lo = __builtin_amdgcn_ds_read_tr16_b64_v4i16((LAS s16x4*)(vp + dt * 32));
        const s16x4 hi = __builtin_amdgcn_ds_read_tr16_b64_v4i16((LAS s16x4*)(vp + 16 * VSTR + dt * 32));
        const bf16x8 vf = __builtin_shufflevector(lo, hi, 0, 1, 2, 3, 4, 5, 6, 7);
        w.o[dt] = MFMA16(vf, pf, w.o[dt] * alpha);
    }
}

constexpr int MB_KBUF = 0, MB_VBUF = 2 * 32 * KSTR, MB_MISC = MB_VBUF + 2 * 32 * VSTR;
__device__ __forceinline__ void moba_item_mfma(const Params& P, LAS unsigned char* lds, int b, int h, int qt) {
    unsigned char* ws = P.ws; const int tid = threadIdx.x, lane = tid & 63, wave = __builtin_amdgcn_readfirstlane(tid >> 6);
    const bf16_t* Q0 = (const bf16_t*)(ws + WS_Q0) + (size_t)b * SEQ * 1024 + h * 128; const bf16_t* K0 = (const bf16_t*)(ws + WS_K0) + (size_t)b * SEQ * 1024 + h * 128;
    const bf16_t* V0 = (const bf16_t*)(ws + WS_V0) + (size_t)b * SEQ * 1024 + h * 128; bf16_t* Y0 = (bf16_t*)(ws + WS_Y0) + (size_t)b * SEQ * 2048 + 1024 + h * 128;
    const float* kpart = (const float*)(ws + WS_KPART);
    LAS float* ksum = (LAS float*)(lds + MB_MISC);
    LAS float* gts = ksum + 8 * 128;
    LAS int* selm = (LAS int*)(gts + 128 * 8);
    LAS int* tiles = selm + 128;
    LAS int* bmask = tiles + 72;
    const int q0 = qt * 128, qb = q0 >> 8;
    __syncthreads();
    for (int i = tid; i < qb * 128; i += NTHREADS) { const int n = i >> 7, d = i & 127; const float* kp = kpart + ((size_t)(b * 8 + n) * 2) * 1024 + h * 128 + d; ksum[i] = kp[0] + kp[1024]; }
    if (tid == 0) bmask[0] = 0;
    __syncthreads();
    { const int q = tid >> 2, nn = tid & 3; const u32x4* qr = (const u32x4*)(Q0 + (size_t)(q0 + q) * 1024);
        float a0 = 0.f, a1 = 0.f; const LAS float* k0p = ksum + nn * 128; const LAS float* k1p = ksum + (nn + 4) * 128;
        const bool d0 = nn < qb, d1 = nn + 4 < qb;
        if (d0) {
#pragma unroll 4
            for (int c = 0; c < 16; ++c) { const u32x4 w = qr[c]; const float qv[8] = {bf_lo(w.x), bf_hi(w.x), bf_lo(w.y), bf_hi(w.y), bf_lo(w.z), bf_hi(w.z), bf_lo(w.w), bf_hi(w.w)};
#pragma unroll
                for (int e = 0; e < 8; ++e) { a0 += qv[e] * k0p[8 * c + e]; if (d1) a1 += qv[e] * k1p[8 * c + e]; } }
            gts[q * 8 + nn] = a0; if (d1) gts[q * 8 + nn + 4] = a1; }
    }
    __syncthreads();
    if (tid < 128) { int s0 = -1, s1 = -1, s2 = -1; float g0 = -__builtin_inff(), g1 = g0, g2 = g0;
        for (int n = 0; n < qb; ++n) { const float gv = gts[tid * 8 + n];
            if (gv > g0) { g2 = g1; s2 = s1; g1 = g0; s1 = s0; g0 = gv; s0 = n; } else if (gv > g1) { g2 = g1; s2 = s1; g1 = gv; s1 = n; } else if (gv > g2) { g2 = gv; s2 = n; } }
        int mk = 0; if (s0 >= 0) mk |= 1 << s0; if (s1 >= 0) mk |= 1 << s1; if (s2 >= 0) mk |= 1 << s2;
        selm[tid] = mk; atomicOr((int*)bmask, mk); }
    __syncthreads();
    if (tid == 0) { const int bm = bmask[0]; int c = 0;
        for (int n = 0; n < qb; ++n) if ((bm >> n) & 1) for (int j = 0; j < 8; ++j) tiles[c++] = n * 256 + 32 * j;
        for (int kb = qb * 256; kb < q0 + 128; kb += 32) tiles[c++] = kb;
        tiles[64] = c; }
    __syncthreads();
    const int ntiles = tiles[64];
    const int qi = lane & 15, g = lane >> 4, myq = q0 + wave * 16 + qi, mymask = selm[wave * 16 + qi];
    WTile w; wt_reset(w); wt_load_q(w, Q0 + (size_t)myq * 1024, lane);
    const int srow = tid >> 4, sch = tid & 15;
    u32x4 kreg, vreg;
    { const int kb = tiles[0]; kreg = *(const u32x4*)(K0 + (size_t)(kb + srow) * 1024 + 8 * sch); vreg = *(const u32x4*)(V0 + (size_t)(kb + srow) * 1024 + 8 * sch); }
    *(LAS u32x4*)(lds + MB_KBUF + srow * KSTR + sch * 16) = kreg; *(LAS u32x4*)(lds + MB_VBUF + srow * VSTR + sch * 16) = vreg;
    __syncthreads();
    for (int t = 0; t < ntiles; ++t) {
        const int kb = tiles[t], cur = t & 1;
        if (t + 1 < ntiles) { const int kn = tiles[t + 1]; kreg = *(const u32x4*)(K0 + (size_t)(kn + srow) * 1024 + 8 * sch); vreg = *(const u32x4*)(V0 + (size_t)(kn + srow) * 1024 + 8 * sch); }
        const int n = kb >> 8; bool active;
        if (n < qb) active = __ballot((mymask >> n) & 1) != 0ull; else active = kb <= q0 + wave * 16 + 15;
        if (active) {
            f32x4 s0, s1; wt_qk_lds(w, lds + MB_KBUF + cur * 32 * KSTR, lane, s0, s1);
            const float NEG = -__builtin_inff();
            if (n < qb) { if (!((mymask >> n) & 1)) { s0 = (f32x4){NEG, NEG, NEG, NEG}; s1 = s0; } }
            else {
#pragma unroll
                for (int r = 0; r < 4; ++r) { if (kb + 4 * g + r > myq) s0[r] = NEG; if (kb + 16 + 4 * g + r > myq) s1[r] = NEG; } }
            wt_softmax_pv(w, s0, s1, lds + MB_VBUF + cur * 32 * VSTR, lane);
        }
        if (t + 1 < ntiles) { *(LAS u32x4*)(lds + MB_KBUF + (cur ^ 1) * 32 * KSTR + srow * KSTR + sch * 16) = kreg; *(LAS u32x4*)(lds + MB_VBUF + (cur ^ 1) * 32 * VSTR + srow * VSTR + sch * 16) = vreg; }
        __syncthreads();
    }
    float l = w.l; l += __shfl_xor(l, 16); l += __shfl_xor(l, 32); const float inv = 1.0f / l;
    bf16_t* yp = Y0 + (size_t)myq * 2048 + 4 * g;
#pragma unroll
    for (int dt = 0; dt < 8; ++dt) { const u32x2 gw = *(const u32x2*)(yp + 16 * dt);
        u32x2 o; o.x = pk2(w.o[dt][0] * inv * bf_lo(gw.x), w.o[dt][1] * inv * bf_hi(gw.x)); o.y = pk2(w.o[dt][2] * inv * bf_lo(gw.y), w.o[dt][3] * inv * bf_hi(gw.y));
        *(u32x2*)(yp + 16 * dt) = o; }
}

constexpr int DL_OACC = 0, DL_LSE = 65536, DL_V = 66560;
__device__ __forceinline__ void dilated_item_mfma(const Params& P, LAS unsigned char* lds, int b, int h, int blk) {
    unsigned char* ws = P.ws; const int tid = threadIdx.x, lane = tid & 63, wave = __builtin_amdgcn_readfirstlane(tid >> 6);
    bf16_t* Q1 = (bf16_t*)(ws + WS_QO1) + (size_t)b * SEQ * 2048 + h * 128; const bf16_t* K1 = (const bf16_t*)(ws + WS_K1) + (size_t)b * SEQ * 2048 + h * 128;
    const bf16_t* V1 = (const bf16_t*)(ws + WS_V1) + (size_t)b * SEQ * 2048 + h * 128;
    LAS unsigned char* Vw = lds + DL_V + wave * (32 * VSTR); LAS float* lse = (LAS float*)(lds + DL_LSE);
    const int T0 = blk * 256, qi = lane & 15, g = lane >> 4;
    __syncthreads();
#pragma unroll 1
    for (int pt = 0; pt < 3; ++pt) {
        const int r = 1 << (2 * pt);
#pragma unroll 1
        for (int half = 0; half < 2; ++half) {
            const int wt = wave + 8 * half;
            const int t0 = T0 + (pt == 0 ? 16 * wt : (pt == 1 ? (wt & 3) + 64 * (wt >> 2) : wt));
            const int myq = t0 + r * qi;
            WTile w; wt_reset(w); wt_load_q(w, Q1 + (size_t)myq * 2048, lane);
            const int kp0 = t0 - 144 * r;
#pragma unroll 1
            for (int s = 0; s < 5; ++s) {
                const int kps = kp0 + 32 * s * r;
                if (kps + 31 * r < 0) continue;
                bf16x8 ka[2][4];
#pragma unroll
                for (int a = 0; a < 2; ++a) { int pos = kps + (16 * a + qi) * r; pos = pos < 0 ? 0 : pos; const bf16_t* kr = K1 + (size_t)pos * 2048 + 8 * g;
#pragma unroll
                    for (int ks = 0; ks < 4; ++ks) ka[a][ks] = *(const bf16x8*)(kr + 32 * ks); }
                u32x4 vr[8];
#pragma unroll
                for (int j = 0; j < 8; ++j) { const int c = lane + 64 * j, row = c >> 4, ch = c & 15; int pos = kps + row * r; pos = pos < 0 ? 0 : pos; vr[j] = *(const u32x4*)(V1 + (size_t)pos * 2048 + 8 * ch); }
#pragma unroll
                for (int j = 0; j < 8; ++j) { const int c = lane + 64 * j, row = c >> 4, ch = c & 15; *(LAS u32x4*)(Vw + row * VSTR + ch * 16) = vr[j]; }
                f32x4 s0 = (f32x4){0.f, 0.f, 0.f, 0.f}, s1 = s0;
#pragma unroll
                for (int ks = 0; ks < 4; ++ks) { s0 = MFMA16(ka[0][ks], w.qf[ks], s0); s1 = MFMA16(ka[1][ks], w.qf[ks], s1); }
                const float NEG = -__builtin_inff();
#pragma unroll
                for (int e = 0; e < 4; ++e) { const int kk0 = 4 * g + e, kk1 = 16 + 4 * g + e; const int d0 = qi + 144 - 32 * s - kk0, d1 = qi + 144 - 32 * s - kk1;
                    if (d0 < 0 || d0 > 128 || kps + kk0 * r < 0) s0[e] = NEG; if (d1 < 0 || d1 > 128 || kps + kk1 * r < 0) s1[e] = NEG; }
                wt_softmax_pv(w, s0, s1, Vw, lane);
            }
            float l = w.l; l += __shfl_xor(l, 16); l += __shfl_xor(l, 32); const float inv = 1.0f / l; const float ls = w.m + __log2f(l);
            const int row = myq - T0;
            LAS unsigned char* orow = lds + DL_OACC + row * 256 + 8 * g;
            if (pt == 0) {
#pragma unroll
                for (int dt = 0; dt < 8; ++dt) { u32x2 o; o.x = pk2(w.o[dt][0] * inv, w.o[dt][1] * inv); o.y = pk2(w.o[dt][2] * inv, w.o[dt][3] * inv); *(LAS u32x2*)(orow + 32 * dt) = o; }
                if (g == 0) lse[row] = ls;
            } else {
                const float lo = lse[row], mxl = fmaxf(lo, ls); const float eo = __builtin_amdgcn_exp2f(lo - mxl), en = __builtin_amdgcn_exp2f(ls - mxl), den = eo + en;
                const float wo = eo / den, wn = en / den * inv;
                bf16_t* gout = Q1 + (size_t)myq * 2048 + 4 * g;
#pragma unroll
                for (int dt = 0; dt < 8; ++dt) { const u32x2 ov = *(const LAS u32x2*)(orow + 32 * dt);
                    u32x2 o; o.x = pk2(wo * bf_lo(ov.x) + wn * w.o[dt][0], wo * bf_hi(ov.x) + wn * w.o[dt][1]); o.y = pk2(wo * bf_lo(ov.y) + wn * w.o[dt][2], wo * bf_hi(ov.y) + wn * w.o[dt][3]);
                    if (pt == 1) *(LAS u32x2*)(orow + 32 * dt) = o; else *(u32x2*)(gout + 16 * dt) = o; }
                if (pt == 1) { asm volatile("s_waitcnt lgkmcnt(0)" ::: "memory"); if (g == 0) lse[row] = mxl + __log2f(den); }
            }
        }
        __syncthreads();
    }
}

__global__ void __launch_bounds__(NTHREADS, 2) fwd_megakernel(Params P) {
    extern __shared__ __attribute__((aligned(16))) unsigned char lds_raw[];
    LAS unsigned char* lds = (LAS unsigned char*)lds_raw;
    cg::grid_group grid = cg::this_grid();
    const int G = gridDim.x, tid = threadIdx.x;
    unsigned char* ws = P.ws;
    LAS int* misc = (LAS int*)(lds + LDS_BYTES - 64);

    if (PHASE_MASK & 1) phase_prep(P, lds, G);
    grid.sync();
    if (PHASE_MASK & 2) {
        pg8::Gemm g{(const bf16_t*)P.out, (const bf16_t*)(ws + WS_W0T), MTOK, N0, DM}; pg8::StaticOrder S; S.init(MTOK, N0, G, (int)blockIdx.x);
        EpiIn0 E{(bf16_t*)(ws + WS_Y0), (bf16_t*)(ws + WS_XBC), (bf16_t*)(ws + WS_Q0), (bf16_t*)(ws + WS_K0), (bf16_t*)(ws + WS_V0), (const float*)(ws + WS_RSTD0), (float*)(ws + WS_KPART)};
        pg8::gemm_phase(lds, g, S, E, pg8::NoHook{});
    }
    grid.sync();
    if (PHASE_MASK & 4) {
        unsigned* ctr = (unsigned*)(ws + WS_CTL);
        for (;;) {
            __syncthreads();
            if (tid == 0) misc[0] = (int)atomicAdd(ctr, 1u);
            __syncthreads();
            const int it = misc[0];
#if MOBA_MFMA
            if (it >= 128 + 1024) break;
            if (it < 128) ssd_item(P, lds, it >> 4, it & 15);
            else { const int r = it - 128; const int qt = 15 - (r >> 6), bh = r & 63; moba_item_mfma(P, lds, bh >> 3, bh & 7, qt); }
#else
            if (it >= 128 + 4096) break;
            if (it < 128) ssd_item(P, lds, it >> 4, it & 15);
            else { const int r = it - 128; const int qt = 63 - (r >> 6), bh = r & 63; moba_item(P, lds, bh >> 3, bh & 7, qt); }
#endif
        }
    }
    grid.sync();
    if (PHASE_MASK & 8) {
        pg8::Gemm g{(const bf16_t*)(ws + WS_Y0), (const bf16_t*)(ws + WS_WO0T), MTOK, DM, 2048}; pg8::StaticOrder S; S.init(MTOK, DM, G, (int)blockIdx.x);
        EpiRes E{P.x, P.out, (bf16_t*)(ws + WS_X1B), (float*)(ws + WS_RSQ1)};
        HookSsdNorm H{(const float*)(ws + WS_SSQ)};
        pg8::gemm_phase(lds, g, S, E, H);
    }
    grid.sync();
    if (PHASE_MASK & 16) {
        pg8::Gemm g{(const bf16_t*)(ws + WS_X1B), (const bf16_t*)(ws + WS_W1T), MTOK, 6144, DM}; pg8::StaticOrder S; S.init(MTOK, 6144, G, (int)blockIdx.x);
        EpiQkv1 E{(bf16_t*)(ws + WS_QO1), (size_t)(WS_K1 - WS_QO1) / 2, (const float*)(ws + WS_RSQ1)};
        pg8::gemm_phase(lds, g, S, E, pg8::NoHook{});
    }
    grid.sync();
#if DIL_MFMA
    if (PHASE_MASK & 32) for (int it = blockIdx.x; it < 8 * 16 * 8; it += G) { const int blk = (it ^ (it >> 8)) & 7, bh = it >> 3; dilated_item_mfma(P, lds, bh >> 4, bh & 15, blk); }
#else
    if (PHASE_MASK & 32) for (int it = blockIdx.x; it < 8 * 16 * 64; it += G) { const int qt = it & 63, bh = it >> 6; dilated_item(P, lds, bh >> 4, bh & 15, qt); }
#endif
    grid.sync();
    if (PHASE_MASK & 64) {
        pg8::Gemm g{(const bf16_t*)(ws + WS_X1B), (const bf16_t*)(ws + WS_W1T) + (size_t)6144 * 1024, MTOK, 2048, DM}; pg8::StaticOrder S; S.init(MTOK, 2048, G, (int)blockIdx.x);
        EpiGate1 E{(bf16_t*)(ws + WS_QO1), (const float*)(ws + WS_RSQ1)};
        pg8::gemm_phase(lds, g, S, E, pg8::NoHook{});
    }
    grid.sync();
    if (PHASE_MASK & 128) {
        pg8::Gemm g{(const bf16_t*)(ws + WS_QO1), (const bf16_t*)(ws + WS_WO1T), MTOK, DM, 2048}; pg8::StaticOrder S; S.init(MTOK, DM, G, (int)blockIdx.x);
        EpiRes E{P.out, P.out, nullptr, (float*)(ws + WS_RSQ2)};
        pg8::gemm_phase(lds, g, S, E, pg8::NoHook{});
    }
    grid.sync();
    if (PHASE_MASK & 256) {
        const int lane = tid & 63, wave = tid >> 6; const float* rsq2 = (const float*)(ws + WS_RSQ2);
        for (int m = blockIdx.x * 8 + wave; m < MTOK; m += G * 8) {
            const float rs = rstd_from16(rsq2 + (size_t)m * 16);
            f32x4* xr = (f32x4*)(P.out + (size_t)m * DM) + lane; const f32x4* gr = (const f32x4*)P.final_norm + lane;
#pragma unroll
            for (int j = 0; j < 4; ++j) { const f32x4 v = xr[64 * j], gg = gr[64 * j]; xr[64 * j] = v * rs * gg; }
        }
    }
}

extern "C" void kernel_launch(void* const* d_in, const int* in_sizes, int n_in, void* d_out, int out_size, void* d_ws, size_t ws_size, hipStream_t stream) {
    static int grid_blocks = 0;
    if (grid_blocks == 0) {
        if (n_in != 14 || ws_size < WS_END) { fprintf(stderr, "kernel_launch: unexpected n_in %d / ws_size %zu\n", n_in, ws_size); grid_blocks = -1; return; }
        int dev = 0, cus = 0, per_cu = 0;
        hipGetDevice(&dev);
        hipDeviceGetAttribute(&cus, hipDeviceAttributeMultiprocessorCount, dev);
        hipFuncSetAttribute((const void*)fwd_megakernel, hipFuncAttributeMaxDynamicSharedMemorySize, LDS_BYTES);
        hipOccupancyMaxActiveBlocksPerMultiprocessor(&per_cu, (const void*)fwd_megakernel, NTHREADS, LDS_BYTES);
        if (per_cu < 1) { fprintf(stderr, "kernel_launch: occupancy query says %d blocks per CU\n", per_cu); per_cu = 1; }
        grid_blocks = cus * 1;
        (void)hipGetLastError();
    }
    if (grid_blocks < 0) return;
    Params p{};
    p.x = (const float*)d_in[0]; p.even_norm = (const float*)d_in[1]; p.w_in0 = (const float*)d_in[2]; p.conv_w = (const float*)d_in[3]; p.conv_b = (const float*)d_in[4];
    p.dt_bias = (const float*)d_in[5]; p.a_log = (const float*)d_in[6]; p.d_skip = (const float*)d_in[7]; p.ssd_norm = (const float*)d_in[8]; p.w_out0 = (const float*)d_in[9];
    p.odd_norm = (const float*)d_in[10]; p.w_in1 = (const float*)d_in[11]; p.w_out1 = (const float*)d_in[12]; p.final_norm = (const float*)d_in[13];
    p.out = (float*)d_out; p.ws = (unsigned char*)d_ws;
    void* args[] = {&p};
    hipError_t e = hipLaunchCooperativeKernel((const void*)fwd_megakernel, dim3(grid_blocks), dim3(NTHREADS), args, LDS_BYTES, stream);
    if (e != hipSuccess) fprintf(stderr, "cooperative launch failed: %s (grid %d)\n", hipGetErrorString(e), grid_blocks);
}
```

```cpp
#include <hip/hip_runtime.h>
#include <hip/hip_cooperative_groups.h>
#include <cstdio>
#include <cstdint>
namespace cg = cooperative_groups;

#define LAS __attribute__((address_space(3)))
typedef unsigned short bf16_t;
typedef short bf16x8 __attribute__((ext_vector_type(8)));
typedef float f32x4 __attribute__((ext_vector_type(4)));
typedef float f32x2 __attribute__((ext_vector_type(2)));
typedef unsigned u32x4 __attribute__((ext_vector_type(4)));
typedef unsigned u32x2 __attribute__((ext_vector_type(2)));

constexpr int BATCH = 8, SEQ = 2048, DM = 1024, MTOK = BATCH * SEQ;
constexpr int EVEN_IN = 6672;
constexpr int N0 = 6656;
constexpr float NORM_EPS = 1e-5f;
constexpr float QSCALE = 0.08838834764831845f * 1.4426950408889634f;
#ifndef PHASE_MASK
#define PHASE_MASK 0x1ff
#endif
#ifndef SSD_MFMA
#define SSD_MFMA 1
#endif
#ifndef MOBA_MFMA
#define MOBA_MFMA 1
#endif
#ifndef DIL_MFMA
#define DIL_MFMA 1
#endif
constexpr int NTHREADS = 512;
constexpr int LDS_BYTES = 155648;
constexpr int RING_BYTES = 131072;

constexpr size_t MiB = 1u << 20;
constexpr size_t WS_CTL = 0;
constexpr size_t WS_RSTD0 = 64 * 1024;
constexpr size_t WS_KPART = 512 * 1024;
constexpr size_t WS_DT = 1 * MiB;
constexpr size_t WS_SSQ = 2 * MiB;
constexpr size_t WS_RSQ1 = 3 * MiB;
constexpr size_t WS_RSQ2 = 4 * MiB;
constexpr size_t WS_W1T = 5 * MiB;
constexpr size_t WS_WO1T = 21 * MiB;
constexpr size_t WS_W0T = 25 * MiB;
constexpr size_t WS_WO0T = 38 * MiB;
constexpr size_t WS_Y0 = 42 * MiB;
constexpr size_t WS_XBC = 106 * MiB;
constexpr size_t WS_Q0 = 154 * MiB;
constexpr size_t WS_K0 = 186 * MiB;
constexpr size_t WS_V0 = 218 * MiB;
constexpr size_t WS_X1B = 224 * MiB;
constexpr size_t WS_QO1 = 25 * MiB;
constexpr size_t WS_K1 = 89 * MiB;
constexpr size_t WS_V1 = 153 * MiB;
constexpr size_t WS_END = 256 * MiB;

struct Params {
    const float* x; const float* even_norm; const float* w_in0; const float* conv_w; const float* conv_b; const float* dt_bias; const float* a_log;
    const float* d_skip; const float* ssd_norm; const float* w_out0; const float* odd_norm; const float* w_in1; const float* w_out1; const float* final_norm;
    float* out; unsigned char* ws;
};

__device__ __forceinline__ unsigned f2bf(float f) { unsigned u = __builtin_bit_cast(unsigned, f); return (u + 0x7fffu + ((u >> 16) & 1u)) >> 16; }
__device__ __forceinline__ unsigned pk2(float lo, float hi) { return f2bf(lo) | (f2bf(hi) << 16); }
__device__ __forceinline__ float bf_lo(unsigned w) { return __builtin_bit_cast(float, w << 16); }
__device__ __forceinline__ float bf_hi(unsigned w) { return __builtin_bit_cast(float, w & 0xffff0000u); }
__device__ __forceinline__ float bf2f(bf16_t h) { return __builtin_bit_cast(float, (unsigned)h << 16); }
__device__ __forceinline__ float silu_f(float v) { return v / (1.0f + __expf(-v)); }
__device__ __forceinline__ float wave_sum(float v) {
#pragma unroll
    for (int o = 1; o < 64; o <<= 1) v += __shfl_xor(v, o);
    return v;
}

namespace pg8 {
constexpr int BM = 256, BK = 64, HALF = 128, HTB = HALF * BK * 2, NXCD = 8, WGM = 8;
__host__ __device__ __forceinline__ int lds_byte(int r, int c) { const int st = (r >> 4) * 2 + (c >> 5), rr = r & 15, cc = c & 31, ob = rr * 64 + cc * 2; return st * 1024 + (ob ^ (((ob >> 9) & 1) << 5)); }
__host__ __device__ __forceinline__ void stage_rc(int b, int& R, int& C) { const int st = b / 1024, sb = b % 1024, swz = sb ^ (((sb >> 9) & 1) << 5); R = (st >> 1) * 16 + swz / 64; C = (st & 1) * 32 + (swz % 64) / 2; }
__host__ __device__ __forceinline__ int perm32(int rho) { const int n = rho >> 4, i = rho & 15; return 8 * (i >> 2) + 4 * n + (i & 3); }

struct Unit { int pm, pn; };
struct Gemm { const bf16_t* A; const bf16_t* Bt; int M, N, K; };

struct StaticOrder {
    int nM, nN, nwg, G, c;
    __device__ void init(int M, int N, int G_, int c_) { nM = M / BM; nN = N / BM; nwg = nM * nN; G = G_; c = c_; }
    __device__ bool next(int i, Unit& u) const {
        const long L = (long)i * G + c; if (L >= nwg) return false;
        int wgid = (int)L; { const int q = nwg / NXCD, r = nwg % NXCD, xcd = wgid % NXCD, off = wgid / NXCD; wgid = (xcd < r ? xcd * (q + 1) : r * (q + 1) + (xcd - r) * q) + off; }
        const int nig = WGM * nN, gid = wgid / nig, fm = gid * WGM, gsz = (nM - fm) < WGM ? (nM - fm) : WGM;
        u.pm = fm + ((wgid % nig) % gsz); u.pn = (wgid % nig) / gsz; return true;
    }
};
struct NoHook {
    __device__ __forceinline__ void begin(const Unit&, LAS unsigned char*) const {}
    __device__ __forceinline__ void at(f32x4 (&)[2][2][4][2], int, int, int, LAS unsigned char*) const {}
};

template <class Epi, class Sched, class Hook>
__device__ __forceinline__ void gemm_phase(LAS unsigned char* lds, const Gemm g, const Sched& S, const Epi& E, const Hook& H) {
    int tid_ = threadIdx.x; asm volatile("" : "+v"(tid_));
    const int tid = tid_, wid = __builtin_amdgcn_readfirstlane(tid >> 6), lane = tid & 63, wr = wid >> 2, wc = wid & 3, fr = lane & 15, fq = lane >> 4;
    const int K = g.K, nt = K / BK;
    unsigned voffA[2], voffB[2];
#pragma unroll
    for (int i = 0; i < 2; ++i) { int R, C; stage_rc(tid * 16 + i * 8192, R, C); const int Rb = Epi::PERM ? ((R & ~31) + perm32(R & 31)) : R;
        voffA[i] = (unsigned)(R * K + C) * 2u; voffB[i] = (unsigned)(Rb * K + C) * 2u; }
    const size_t kstep = (size_t)(BK * 2);
    const size_t hstep = (size_t)HALF * K * 2;
    const size_t tstep = 2 * hstep;
    const unsigned ldsw = (unsigned)wid * 1024u;
    const int aoff = lds_byte(wr * 64 + fr, fq * 8), boff = lds_byte(wc * 32 + fr, fq * 8);
#define PG8_SA(b, h) (((b) * 2 + (h)) * HTB)
#define PG8_SB(b, h) ((4 + (b) * 2 + (h)) * HTB)
#define PG8_STAGE(bufoff, gbase, voff) do { _Pragma("unroll") for (int _i = 0; _i < 2; ++_i) \
        __builtin_amdgcn_global_load_lds((const unsigned*)((const char*)(gbase) + (voff)[_i]), (LAS unsigned*)(lds + (bufoff) + ldsw + _i * 8192), 16, 0, 0); } while (0)
#define PG8_LDA(dst, b, h) do { _Pragma("unroll") for (int m = 0; m < 4; ++m) _Pragma("unroll") for (int k = 0; k < 2; ++k) dst[m][k] = *(const LAS bf16x8*)(lds + PG8_SA(b, h) + aoff + m * 2048 + k * 1024); } while (0)
#define PG8_LDB(dst, b, h) do { _Pragma("unroll") for (int n = 0; n < 2; ++n) _Pragma("unroll") for (int k = 0; k < 2; ++k) dst[n][k] = *(const LAS bf16x8*)(lds + PG8_SB(b, h) + boff + n * 2048 + k * 1024); } while (0)
#define PG8_MMA(ai, bj, At, Bt) do { __builtin_amdgcn_s_setprio(1); _Pragma("unroll") for (int m = 0; m < 4; ++m) _Pragma("unroll") for (int n = 0; n < 2; ++n) _Pragma("unroll") for (int k = 0; k < 2; ++k) \
        acc[ai][bj][m][n] = __builtin_amdgcn_mfma_f32_16x16x32_bf16(Bt[n][k], At[m][k], acc[ai][bj][m][n], 0, 0, 0); __builtin_amdgcn_s_setprio(0); } while (0)
#define PG8_WAIT_V(n) asm volatile("s_waitcnt vmcnt(" #n ")" ::: "memory")
#define PG8_WAIT_L(n) asm volatile("s_waitcnt lgkmcnt(" #n ")" ::: "memory")
#define PG8_BAR __builtin_amdgcn_s_barrier()
#define PG8_SCHED __builtin_amdgcn_sched_barrier(0)
    Unit cur, nxt; int ui = 0;
    if (!S.next(0, cur)) return;
    f32x4 acc[2][2][4][2];
#pragma unroll
    for (int a = 0; a < 2; ++a)
#pragma unroll
        for (int b = 0; b < 2; ++b)
#pragma unroll
            for (int m = 0; m < 4; ++m)
#pragma unroll
                for (int n = 0; n < 2; ++n) acc[a][b][m][n] = (f32x4){0.f, 0.f, 0.f, 0.f};
    bf16x8 At[4][2], B0[2][2], B1[2][2];
    const char* cA = (const char*)g.A + (size_t)cur.pm * tstep; const char* cB = (const char*)g.Bt + (size_t)cur.pn * tstep;
    H.begin(cur, lds);
    PG8_STAGE(PG8_SB(0, 0), cB, voffB); PG8_STAGE(PG8_SA(0, 0), cA, voffA); PG8_STAGE(PG8_SB(0, 1), cB + hstep, voffB); PG8_STAGE(PG8_SA(0, 1), cA + hstep, voffA);
    if (wr == 1) PG8_BAR;
    PG8_WAIT_V(4); PG8_BAR;
    PG8_STAGE(PG8_SB(1, 0), cB + kstep, voffB); PG8_STAGE(PG8_SA(1, 0), cA + kstep, voffA); PG8_STAGE(PG8_SB(1, 1), cB + hstep + kstep, voffB);
    PG8_WAIT_V(6); PG8_BAR;
    for (;;) {
        const bool has_next = S.next(ui + 1, nxt);
        const char* nA = has_next ? (const char*)g.A + (size_t)nxt.pm * tstep : cA; const char* nB = has_next ? (const char*)g.Bt + (size_t)nxt.pn * tstep : cB;
        for (int t = 0; t < nt; t += 2) {
            const bool last = (t == nt - 2);
            const char* a1 = cA + (size_t)(t + 1) * kstep;
            const char* a2 = last ? nA : cA + (size_t)(t + 2) * kstep; const char* b2 = last ? nB : cB + (size_t)(t + 2) * kstep;
            const char* a3 = a2 + kstep; const char* b3 = b2 + kstep;
            H.at(acc, t, wr, fr, lds);
            PG8_LDB(B0, 0, 0); PG8_SCHED; PG8_LDA(At, 0, 0); PG8_STAGE(PG8_SA(1, 1), a1 + hstep, voffA);
            PG8_WAIT_L(8); PG8_BAR; PG8_WAIT_L(0); PG8_MMA(0, 0, At, B0); PG8_BAR; PG8_SCHED;
            PG8_LDB(B1, 0, 1); PG8_STAGE(PG8_SB(0, 0), b2, voffB);
            PG8_BAR; PG8_WAIT_L(0); PG8_MMA(0, 1, At, B1); PG8_BAR;
            PG8_LDA(At, 0, 1); PG8_STAGE(PG8_SA(0, 0), a2, voffA);
            PG8_BAR; PG8_WAIT_L(0); PG8_MMA(1, 0, At, B0); PG8_BAR; PG8_SCHED;
            PG8_STAGE(PG8_SB(0, 1), b2 + hstep, voffB);
            PG8_WAIT_V(6); PG8_BAR; PG8_MMA(1, 1, At, B1); PG8_BAR;
            PG8_LDB(B0, 1, 0); PG8_SCHED; PG8_LDA(At, 1, 0); PG8_STAGE(PG8_SA(0, 1), a2 + hstep, voffA);
            PG8_WAIT_L(8); PG8_BAR; PG8_WAIT_L(0); PG8_MMA(0, 0, At, B0); PG8_BAR; PG8_SCHED;
            PG8_LDB(B1, 1, 1); PG8_STAGE(PG8_SB(1, 0), b3, voffB);
            PG8_BAR; PG8_WAIT_L(0); PG8_MMA(0, 1, At, B1); PG8_BAR;
            PG8_LDA(At, 1, 1); PG8_STAGE(PG8_SA(1, 0), a3, voffA);
            PG8_BAR; PG8_WAIT_L(0); PG8_MMA(1, 0, At, B0); PG8_BAR; PG8_SCHED;
            PG8_STAGE(PG8_SB(1, 1), b3 + hstep, voffB);
            PG8_WAIT_V(6); PG8_BAR; PG8_MMA(1, 1, At, B1); PG8_BAR;
        }
        E(acc, cur, wr, wc, fr, fq);
        if (!has_next) break;
#pragma unroll
        for (int a = 0; a < 2; ++a)
#pragma unroll
            for (int b = 0; b < 2; ++b)
#pragma unroll
                for (int m = 0; m < 4; ++m)
#pragma unroll
                    for (int n = 0; n < 2; ++n) acc[a][b][m][n] = (f32x4){0.f, 0.f, 0.f, 0.f};
        cur = nxt; cA = nA; cB = nB; ++ui;
        H.begin(cur, lds);
    }
    PG8_WAIT_V(0);
    if (wr == 0) PG8_BAR;
    PG8_BAR;
#undef PG8_SA
#undef PG8_SB
#undef PG8_STAGE
#undef PG8_LDA
#undef PG8_LDB
#undef PG8_MMA
#undef PG8_WAIT_V
#undef PG8_WAIT_L
#undef PG8_BAR
#undef PG8_SCHED
}
}

struct EpiIn0 {
    static constexpr bool PERM = true;
    bf16_t *Y0, *XBC, *Q0, *K0, *V0; const float* rstd; float* kpart;
    __device__ __forceinline__ void operator()(const f32x4 (&acc)[2][2][4][2], const pg8::Unit& u, int wr, int wc, int fr, int fq) const {
        const int pn = u.pn; bf16_t* base; int ld, colt, mode;
        if (pn < 8) { base = Y0; ld = 2048; colt = pn * 256; mode = 1; }
        else if (pn < 14) { base = XBC; ld = 1536; colt = (pn - 8) * 256; mode = 0; }
        else if (pn < 18) { base = Q0; ld = 1024; colt = (pn - 14) * 256; mode = 2; }
        else if (pn < 22) { base = K0; ld = 1024; colt = (pn - 18) * 256; mode = 3; }
        else { base = V0; ld = 1024; colt = (pn - 22) * 256; mode = 0; }
        const int row0 = u.pm * 256 + wr * 64 + fr, col0 = colt + wc * 32 + 8 * fq;
        float cs[2][8];
#pragma unroll
        for (int bj = 0; bj < 2; ++bj)
#pragma unroll
            for (int e = 0; e < 8; ++e) cs[bj][e] = 0.f;
#pragma unroll
        for (int ai = 0; ai < 2; ++ai)
#pragma unroll
            for (int m = 0; m < 4; ++m) {
                const int row = row0 + ai * 128 + m * 16; const float rs = rstd[row]; bf16_t* rowp = base + (size_t)row * ld + col0;
#pragma unroll
                for (int bj = 0; bj < 2; ++bj) {
                    float v[8];
#pragma unroll
                    for (int e = 0; e < 4; ++e) { v[e] = acc[ai][bj][m][0][e] * rs; v[4 + e] = acc[ai][bj][m][1][e] * rs; }
                    if (mode == 1) {
#pragma unroll
                        for (int e = 0; e < 8; ++e) v[e] = silu_f(v[e]);
                    } else if (mode == 2) {
#pragma unroll
                        for (int e = 0; e < 8; ++e) v[e] *= QSCALE;
                    } else if (mode == 3) {
#pragma unroll
                        for (int e = 0; e < 8; ++e) cs[bj][e] += v[e];
                    }
                    u32x4 w; w.x = pk2(v[0], v[1]); w.y = pk2(v[2], v[3]); w.z = pk2(v[4], v[5]); w.w = pk2(v[6], v[7]);
                    *(u32x4*)(rowp + bj * 128) = w;
                }
            }
        if (mode == 3) {
#pragma unroll
            for (int bj = 0; bj < 2; ++bj)
#pragma unroll
                for (int e = 0; e < 8; ++e) { float s = cs[bj][e]; s += __shfl_xor(s, 1); s += __shfl_xor(s, 2); s += __shfl_xor(s, 4); s += __shfl_xor(s, 8); cs[bj][e] = s; }
            if (fr == 0) {
                float* kp = kpart + ((size_t)u.pm * 2 + wr) * 1024 + col0;
#pragma unroll
                for (int bj = 0; bj < 2; ++bj) { *(f32x4*)(kp + bj * 128) = (f32x4){cs[bj][0], cs[bj][1], cs[bj][2], cs[bj][3]}; *(f32x4*)(kp + bj * 128 + 4) = (f32x4){cs[bj][4], cs[bj][5], cs[bj][6], cs[bj][7]}; }
            }
        }
    }
};
struct EpiRes {
    static constexpr bool PERM = false;
    const float* xi; float* xo; bf16_t* xb; float* rsq;
    __device__ __forceinline__ void operator()(const f32x4 (&acc)[2][2][4][2], const pg8::Unit& u, int wr, int wc, int fr, int fq) const {
        const int col0 = u.pn * 256 + wc * 32 + 4 * fq;
#pragma unroll
        for (int ai = 0; ai < 2; ++ai)
#pragma unroll
            for (int m = 0; m < 4; ++m) {
                const int row = u.pm * 256 + ai * 128 + wr * 64 + m * 16 + fr; const size_t off = (size_t)row * DM + col0; float ss = 0.f;
#pragma unroll
                for (int bj = 0; bj < 2; ++bj)
#pragma unroll
                    for (int n = 0; n < 2; ++n) {
                        const f32x4 b = *(const f32x4*)(xi + off + bj * 128 + n * 16); const f32x4 o = b + acc[ai][bj][m][n];
                        *(f32x4*)(xo + off + bj * 128 + n * 16) = o; ss += (o[0] * o[0] + o[1] * o[1]) + (o[2] * o[2] + o[3] * o[3]);
                        if (xb) { u32x2 w; w.x = pk2(o[0], o[1]); w.y = pk2(o[2], o[3]); *(u32x2*)(xb + off + bj * 128 + n * 16) = w; }
                    }
                ss += __shfl_xor(ss, 16); ss += __shfl_xor(ss, 32);
                if (fq == 0) rsq[(size_t)row * 16 + u.pn * 4 + wc] = ss;
            }
    }
};
__device__ __forceinline__ float rstd_from16(const float* p) {
    const f32x4 a = *(const f32x4*)p, b = *(const f32x4*)(p + 4), c = *(const f32x4*)(p + 8), d = *(const f32x4*)(p + 12);
    const float s = ((a[0] + a[1]) + (a[2] + a[3])) + ((b[0] + b[1]) + (b[2] + b[3])) + ((c[0] + c[1]) + (c[2] + c[3])) + ((d[0] + d[1]) + (d[2] + d[3]));
    return 1.0f / sqrtf(s * (1.0f / 1024.0f) + NORM_EPS);
}
struct EpiQkv1 {
    static constexpr bool PERM = true;
    bf16_t* O; size_t split_stride; const float* rsq;
    __device__ __forceinline__ void operator()(const f32x4 (&acc)[2][2][4][2], const pg8::Unit& u, int wr, int wc, int fr, int fq) const {
        const int t = u.pn >> 3; bf16_t* base = O + (size_t)t * split_stride; const int colt = (u.pn & 7) * 256; const float sc = (t == 0) ? QSCALE : 1.0f;
        const int row0 = u.pm * 256 + wr * 64 + fr, col0 = colt + wc * 32 + 8 * fq;
#pragma unroll
        for (int ai = 0; ai < 2; ++ai)
#pragma unroll
            for (int m = 0; m < 4; ++m) {
                const int row = row0 + ai * 128 + m * 16; const float rs = rstd_from16(rsq + (size_t)row * 16) * sc; bf16_t* rowp = base + (size_t)row * 2048 + col0;
#pragma unroll
                for (int bj = 0; bj < 2; ++bj) { const f32x4 v0 = acc[ai][bj][m][0] * rs, v1 = acc[ai][bj][m][1] * rs;
                    u32x4 w; w.x = pk2(v0[0], v0[1]); w.y = pk2(v0[2], v0[3]); w.z = pk2(v1[0], v1[1]); w.w = pk2(v1[2], v1[3]); *(u32x4*)(rowp + bj * 128) = w; }
            }
    }
};
struct EpiGate1 {
    static constexpr bool PERM = true;
    bf16_t* O; const float* rsq;
    __device__ __forceinline__ void operator()(const f32x4 (&acc)[2][2][4][2], const pg8::Unit& u, int wr, int wc, int fr, int fq) const {
        const int row0 = u.pm * 256 + wr * 64 + fr, col0 = u.pn * 256 + wc * 32 + 8 * fq;
#pragma unroll
        for (int ai = 0; ai < 2; ++ai)
#pragma unroll
            for (int m = 0; m < 4; ++m) {
                const int row = row0 + ai * 128 + m * 16; const float rs = rstd_from16(rsq + (size_t)row * 16); bf16_t* rowp = O + (size_t)row * 2048 + col0;
#pragma unroll
                for (int bj = 0; bj < 2; ++bj) { const f32x4 v0 = acc[ai][bj][m][0] * rs, v1 = acc[ai][bj][m][1] * rs; const u32x4 o = *(const u32x4*)(rowp + bj * 128);
                    u32x4 w; w.x = pk2(bf_lo(o.x) * silu_f(v0[0]), bf_hi(o.x) * silu_f(v0[1])); w.y = pk2(bf_lo(o.y) * silu_f(v0[2]), bf_hi(o.y) * silu_f(v0[3]));
                    w.z = pk2(bf_lo(o.z) * silu_f(v1[0]), bf_hi(o.z) * silu_f(v1[1])); w.w = pk2(bf_lo(o.w) * silu_f(v1[2]), bf_hi(o.w) * silu_f(v1[3])); *(u32x4*)(rowp + bj * 128) = w; }
            }
    }
};
struct HookSsdNorm {
    const float* ssq;
    __device__ __forceinline__ void begin(const pg8::Unit& u, LAS unsigned char* lds) const {
        LAS float* T = (LAS float*)(lds + RING_BYTES);
        const int t = threadIdx.x;
        if (t < 256) { const float* p = ssq + (size_t)(u.pm * 256 + t) * 16; const f32x4 a = *(const f32x4*)p, b = *(const f32x4*)(p + 4), c = *(const f32x4*)(p + 8), d = *(const f32x4*)(p + 12);
            const float g0 = ((a[0] + a[1]) + (a[2] + a[3])) + ((b[0] + b[1]) + (b[2] + b[3])), g1 = ((c[0] + c[1]) + (c[2] + c[3])) + ((d[0] + d[1]) + (d[2] + d[3]));
            const float r0 = 1.0f / sqrtf(g0 * (1.0f / 512.0f) + NORM_EPS), r1 = 1.0f / sqrtf(g1 * (1.0f / 512.0f) + NORM_EPS);
            T[2 * t] = r0 / r1; T[2 * t + 1] = r1; }
    }
    __device__ __forceinline__ void at(f32x4 (&acc)[2][2][4][2], int t, int wr, int fr, LAS unsigned char* lds) const {
        if (t == 8 || t == 16) {
            const LAS float* T = (const LAS float*)(lds + RING_BYTES); const int sel = (t == 16);
#pragma unroll
            for (int ai = 0; ai < 2; ++ai)
#pragma unroll
                for (int m = 0; m < 4; ++m) { const float f = T[2 * (ai * 128 + wr * 64 + m * 16 + fr) + sel];
#pragma unroll
                    for (int bj = 0; bj < 2; ++bj)
#pragma unroll
                        for (int n = 0; n < 2; ++n) acc[ai][bj][m][n] = acc[ai][bj][m][n] * f; }
        }
    }
};

__device__ __forceinline__ void transpose_item(const float* W, int K, int Nsrc, int src_col0, bf16_t* WT, int dst_row0, const float* gain, int gain_n, LAS float* scr, int kb, int nb, int lane) {
    const int k0 = 64 * kb, n0 = 32 * nb;
#pragma unroll 8
    for (int i = 0; i < 32; ++i) { const int kk = 2 * i + (lane >> 5); const int k = k0 + kk; const float gsc = (gain && k < gain_n) ? gain[k] : 1.0f;
        scr[kk * 33 + (lane & 31)] = W[(size_t)k * Nsrc + src_col0 + n0 + (lane & 31)] * gsc; }
    asm volatile("s_waitcnt lgkmcnt(0)" ::: "memory");
    const int c = lane & 7;
#pragma unroll
    for (int j = 0; j < 4; ++j) { const int n = (lane >> 3) + 8 * j; const LAS float* s = scr + (8 * c) * 33 + n;
        u32x4 o; o.x = pk2(s[0 * 33], s[1 * 33]); o.y = pk2(s[2 * 33], s[3 * 33]); o.z = pk2(s[4 * 33], s[5 * 33]); o.w = pk2(s[6 * 33], s[7 * 33]);
        *(u32x4*)(WT + (size_t)(dst_row0 + n0 + n) * K + k0 + 8 * c) = o; }
    asm volatile("s_waitcnt lgkmcnt(0)" ::: "memory");
}
__device__ __forceinline__ float softplus_f(float v) { return v > 20.f ? v : log1pf(expf(v)); }

__device__ __forceinline__ void phase_prep(const Params& P, LAS unsigned char* lds, int G) {
    const int tid = threadIdx.x, lane = tid & 63, wave = tid >> 6;
    const int gw = blockIdx.x * 8 + wave, NGW = G * 8;
    unsigned char* ws = P.ws;
    if (blockIdx.x == 0 && tid < 64) ((unsigned*)(ws + WS_CTL))[tid] = 0u;
    {
        LAS float* scr = (LAS float*)(lds + wave * 16384);
        bf16_t* W0T = (bf16_t*)(ws + WS_W0T); bf16_t* WO0T = (bf16_t*)(ws + WS_WO0T); bf16_t* W1T = (bf16_t*)(ws + WS_W1T); bf16_t* WO1T = (bf16_t*)(ws + WS_WO1T);
        constexpr int I0 = 16 * 208, IO0 = 32 * 32, I1 = 16 * 256, IO1 = 32 * 32;
        for (int it = gw; it < I0 + IO0 + I1 + IO1; it += NGW) {
            int r = it;
            if (r < I0) { const int kb = r / 208, nb = r % 208; const int n0 = nb * 32;
                int src; if (n0 < 1024) src = n0; else if (n0 < 2048) src = n0 - 1024 + 5648; else if (n0 < 3584) src = n0 - 2048 + 1024; else src = n0 - 3584 + 2576;
                transpose_item(P.w_in0, 1024, EVEN_IN, src - n0, W0T, 0, P.even_norm, 1024, scr, kb, nb, lane); continue; }
            r -= I0;
            if (r < IO0) { transpose_item(P.w_out0, 2048, 1024, 0, WO0T, 0, P.ssd_norm, 1024, scr, r / 32, r % 32, lane); continue; }
            r -= IO0;
            if (r < I1) { transpose_item(P.w_in1, 1024, 8192, 0, W1T, 0, P.odd_norm, 1024, scr, r / 256, r % 256, lane); continue; }
            r -= I1;
            transpose_item(P.w_out1, 2048, 1024, 0, WO1T, 0, nullptr, 0, scr, r / 32, r % 32, lane);
        }
    }
    __syncthreads();
    {
        LAS float* Wd = (LAS float*)lds;
        for (int i = tid; i < 16 * 1024; i += NTHREADS) { const int k = i >> 4, h = i & 15; Wd[h * 1024 + k] = P.w_in0[(size_t)k * EVEN_IN + 2560 + h] * P.even_norm[k]; }
        __syncthreads();
        bf16_t* xb = (bf16_t*)P.out; float* rstd0 = (float*)(ws + WS_RSTD0); float* dt = (float*)(ws + WS_DT);
        for (int m = gw; m < MTOK; m += NGW) {
            const f32x4* xr = (const f32x4*)(P.x + (size_t)m * DM) + lane;
            f32x4 v[4]; float s = 0.f;
#pragma unroll
            for (int j = 0; j < 4; ++j) { v[j] = xr[64 * j]; s += (v[j][0] * v[j][0] + v[j][1] * v[j][1]) + (v[j][2] * v[j][2] + v[j][3] * v[j][3]); }
            const float rs = 1.0f / sqrtf(wave_sum(s) * (1.0f / DM) + NORM_EPS);
            unsigned long long* o8 = (unsigned long long*)(xb + (size_t)m * DM) + lane;
#pragma unroll
            for (int j = 0; j < 4; ++j) o8[64 * j] = (unsigned long long)pk2(v[j][0], v[j][1]) | ((unsigned long long)pk2(v[j][2], v[j][3]) << 32);
            float mine = 0.f;
#pragma unroll 1
            for (int h = 0; h < 16; ++h) { float a = 0.f;
#pragma unroll
                for (int j = 0; j < 4; ++j) { const f32x4 w = *(const LAS f32x4*)(Wd + h * 1024 + 256 * j + 4 * lane); a += (v[j][0] * w[0] + v[j][1] * w[1]) + (v[j][2] * w[2] + v[j][3] * w[3]); }
                a = wave_sum(a); if (lane == h) mine = a; }
            if (lane == 0) rstd0[m] = rs;
            if (lane < 16) dt[(size_t)m * 16 + lane] = softplus_f(mine * rs + P.dt_bias[lane]);
        }
    }
}

__device__ __forceinline__ void ssd_item(const Params& P, LAS unsigned char* lds, int b, int h) {
    constexpr int TT = 64;
    const int tid = threadIdx.x;
    unsigned char* ws = P.ws;
    const bf16_t* XBC = (const bf16_t*)(ws + WS_XBC); bf16_t* Y0 = (bf16_t*)(ws + WS_Y0); const float* dt = (const float*)(ws + WS_DT); float* ssq = (float*)(ws + WS_SSQ);
    LAS float* xc = (LAS float*)lds;
    LAS float* Bc = xc + TT * 64;
    LAS float* Cc = Bc + TT * 128;
    LAS float* zs = Cc + TT * 128;
    LAS float* uo = zs + TT * 64;
    LAS float* dtv = uo + TT * 64;
    LAS float* dec = dtv + TT;
    const int g = h >> 3;
    const float a = -expf(P.a_log[h]), Dh = P.d_skip[h];
    const int p = tid >> 3, ng = tid & 7;
    float st[16];
#pragma unroll
    for (int i = 0; i < 16; ++i) st[i] = 0.f;
    int ch = 0; float cw0 = 0.f, cw1 = 0.f, cw2 = 0.f, cw3 = 0.f, cb = 0.f;
    if (tid < 320) { ch = tid < 64 ? h * 64 + tid : (tid < 192 ? 1024 + g * 128 + (tid - 64) : 1280 + g * 128 + (tid - 192));
        cw0 = P.conv_w[ch]; cw1 = P.conv_w[1536 + ch]; cw2 = P.conv_w[2 * 1536 + ch]; cw3 = P.conv_w[3 * 1536 + ch]; cb = P.conv_b[ch]; }
    for (int t0 = 0; t0 < SEQ; t0 += TT) {
        const size_t tok0 = (size_t)b * SEQ + t0;
        if (tid < 320) {
            float w0 = 0.f, w1 = 0.f, w2 = 0.f;
            if (t0 > 0) { w0 = bf2f(XBC[(tok0 - 3) * 1536 + ch]); w1 = bf2f(XBC[(tok0 - 2) * 1536 + ch]); w2 = bf2f(XBC[(tok0 - 1) * 1536 + ch]); }
            LAS float* dst = tid < 64 ? xc + tid : (tid < 192 ? Bc + (tid - 64) : Cc + (tid - 192)); const int dstride = tid < 64 ? 64 : 128;
            for (int tt = 0; tt < TT; ++tt) { const float w3 = bf2f(XBC[(tok0 + tt) * 1536 + ch]);
                const float v = cb + cw0 * w0 + cw1 * w1 + cw2 * w2 + cw3 * w3; dst[tt * dstride] = silu_f(v); w0 = w1; w1 = w2; w2 = w3; }
        } else if (tid < 320 + TT) { const int tt = tid - 320; const float d = dt[(tok0 + tt) * 16 + h]; dtv[tt] = d; dec[tt] = expf(d * a); }
        for (int i = tid; i < TT * 64; i += NTHREADS) { const int tt = i >> 6, pp = i & 63; zs[i] = bf2f(Y0[(tok0 + tt) * 2048 + h * 64 + pp]); }
        __syncthreads();
        for (int tt = 0; tt < TT; ++tt) {
            const float xv = xc[tt * 64 + p], xdt = xv * dtv[tt], dc = dec[tt];
            const LAS float* Bp = Bc + tt * 128 + 16 * ng; const LAS float* Cp = Cc + tt * 128 + 16 * ng;
            float yp = 0.f;
#pragma unroll
            for (int i = 0; i < 16; ++i) { st[i] = st[i] * dc + xdt * Bp[i]; yp += st[i] * Cp[i]; }
            yp += __shfl_xor(yp, 1); yp += __shfl_xor(yp, 2); yp += __shfl_xor(yp, 4);
            if (ng == 0) uo[tt * 64 + p] = (yp + Dh * xv) * zs[tt * 64 + p];
        }
        __syncthreads();
        { const int tt = tid >> 3, part = tid & 7; const LAS float* up = uo + tt * 64 + part * 8; float v[8]; float ss = 0.f;
#pragma unroll
            for (int e = 0; e < 8; ++e) { v[e] = up[e]; ss += v[e] * v[e]; }
            u32x4 w; w.x = pk2(v[0], v[1]); w.y = pk2(v[2], v[3]); w.z = pk2(v[4], v[5]); w.w = pk2(v[6], v[7]);
            *(u32x4*)(Y0 + (tok0 + tt) * 2048 + h * 64 + part * 8) = w;
            ss += __shfl_xor(ss, 1); ss += __shfl_xor(ss, 2); ss += __shfl_xor(ss, 4);
            if (part == 0) ssq[(tok0 + tt) * 16 + h] = ss; }
        __syncthreads();
    }
}

struct KeysDilated {
    __device__ __forceinline__ int nkeys(int) const { return 387; }
    __device__ __forceinline__ int keypos(int qpos, int idx) const { const int pt = idx / 129, j = idx - pt * 129; return qpos - (j << (2 * pt)); }
};
struct KeysMoba {
    const LAS int* sel;
    int q0;
    __device__ __forceinline__ int nkeys(int qpos) const { return sel[(qpos - q0) * 4] * 256 + (qpos & 255) + 1; }
    __device__ __forceinline__ int keypos(int qpos, int idx) const { const LAS int* s = sel + (qpos - q0) * 4; const int ns = s[0];
        if (idx < ns * 256) return s[1 + (idx >> 8)] * 256 + (idx & 255);
        return (qpos & ~255) + (idx - ns * 256); }
};
template <class KS>
__device__ __forceinline__ void attn_simple_core(const KS& ks, LAS float* qs, LAS float* Ssc, const bf16_t* Kp, const bf16_t* Vp, int ld, int q0, float (&o)[8], float& lsum) {
    const int tid = threadIdx.x, qi = tid >> 4, part = tid & 15;
    const int qpos = q0 + qi, nk = ks.nkeys(qpos);
    LAS float* Sr = Ssc + qi * 1024; const LAS float* qr = qs + qi * 128;
    float mx = -3.0e38f;
    for (int idx = part; idx < nk; idx += 16) {
        const int pos = ks.keypos(qpos, idx); float s = -__builtin_inff();
        if (pos >= 0) { const u32x4* kr = (const u32x4*)(Kp + (size_t)pos * ld); float a = 0.f;
#pragma unroll
            for (int c = 0; c < 16; ++c) { const u32x4 w = kr[c]; const f32x4 q0v = *(const LAS f32x4*)(qr + 8 * c), q1v = *(const LAS f32x4*)(qr + 8 * c + 4);
                a += (bf_lo(w.x) * q0v[0] + bf_hi(w.x) * q0v[1]) + (bf_lo(w.y) * q0v[2] + bf_hi(w.y) * q0v[3]) + (bf_lo(w.z) * q1v[0] + bf_hi(w.z) * q1v[1]) + (bf_lo(w.w) * q1v[2] + bf_hi(w.w) * q1v[3]); }
            s = a; }
        Sr[idx] = s; mx = fmaxf(mx, s);
    }
    mx = fmaxf(mx, __shfl_xor(mx, 1)); mx = fmaxf(mx, __shfl_xor(mx, 2)); mx = fmaxf(mx, __shfl_xor(mx, 4)); mx = fmaxf(mx, __shfl_xor(mx, 8));
    float l = 0.f;
    for (int idx = part; idx < nk; idx += 16) { const float pv = exp2f(Sr[idx] - mx); Sr[idx] = pv; l += pv; }
    l += __shfl_xor(l, 1); l += __shfl_xor(l, 2); l += __shfl_xor(l, 4); l += __shfl_xor(l, 8);
    lsum = l;
    asm volatile("s_waitcnt lgkmcnt(0)" ::: "memory");
    __syncthreads();
#pragma unroll
    for (int e = 0; e < 8; ++e) o[e] = 0.f;
    for (int idx = 0; idx < nk; ++idx) {
        const float pv = Sr[idx];
        if (pv != 0.f) { const int pos = ks.keypos(qpos, idx); const u32x4 w = *(const u32x4*)(Vp + (size_t)pos * ld + 8 * part);
            o[0] += pv * bf_lo(w.x); o[1] += pv * bf_hi(w.x); o[2] += pv * bf_lo(w.y); o[3] += pv * bf_hi(w.y); o[4] += pv * bf_lo(w.z); o[5] += pv * bf_hi(w.z); o[6] += pv * bf_lo(w.w); o[7] += pv * bf_hi(w.w); }
    }
}
__device__ __forceinline__ void load_q_tile(LAS float* qs, const bf16_t* Qp, int ld) {
    const int tid = threadIdx.x, r = tid >> 4, c = tid & 15;
    const u32x4 w = *(const u32x4*)(Qp + (size_t)r * ld + 8 * c); LAS float* d = qs + r * 128 + 8 * c;
    d[0] = bf_lo(w.x); d[1] = bf_hi(w.x); d[2] = bf_lo(w.y); d[3] = bf_hi(w.y); d[4] = bf_lo(w.z); d[5] = bf_hi(w.z); d[6] = bf_lo(w.w); d[7] = bf_hi(w.w);
}
__device__ __forceinline__ void moba_item(const Params& P, LAS unsigned char* lds, int b, int h, int qt) {
    unsigned char* ws = P.ws; const int tid = threadIdx.x;
    LAS float* Ssc = (LAS float*)lds; LAS float* qs = (LAS float*)(lds + 131072); LAS float* gts = (LAS float*)(lds + 131072 + 16384); LAS int* sel = (LAS int*)(lds + 131072 + 16384 + 1024);
    const bf16_t* Q0 = (const bf16_t*)(ws + WS_Q0) + (size_t)b * SEQ * 1024 + h * 128; const bf16_t* K0 = (const bf16_t*)(ws + WS_K0) + (size_t)b * SEQ * 1024 + h * 128;
    const bf16_t* V0 = (const bf16_t*)(ws + WS_V0) + (size_t)b * SEQ * 1024 + h * 128; bf16_t* Y0 = (bf16_t*)(ws + WS_Y0) + (size_t)b * SEQ * 2048 + 1024 + h * 128;
    const float* kpart = (const float*)(ws + WS_KPART);
    const int q0 = qt * 32, qb = q0 >> 8;
    __syncthreads();
    load_q_tile(qs, Q0 + (size_t)q0 * 1024, 1024);
    __syncthreads();
    { const int qi = tid >> 4, n = tid & 15;
        if (n < qb) { const float* k0p = kpart + ((size_t)(b * 8 + n) * 2) * 1024 + h * 128; const float* k1p = k0p + 1024; float a = 0.f;
            for (int d = 0; d < 128; ++d) a += qs[qi * 128 + d] * (k0p[d] + k1p[d]);
            gts[qi * 8 + n] = a; } }
    __syncthreads();
    if (tid < 32) { const int ns = qb < 3 ? qb : 3; int s0 = -1, s1 = -1, s2 = -1; float g0 = -__builtin_inff(), g1 = g0, g2 = g0;
        for (int n = 0; n < qb; ++n) { const float gv = gts[tid * 8 + n];
            if (gv > g0) { g2 = g1; s2 = s1; g1 = g0; s1 = s0; g0 = gv; s0 = n; } else if (gv > g1) { g2 = g1; s2 = s1; g1 = gv; s1 = n; } else if (gv > g2) { g2 = gv; s2 = n; } }
        sel[tid * 4] = ns; sel[tid * 4 + 1] = s0 < 0 ? 0 : s0; sel[tid * 4 + 2] = s1 < 0 ? 0 : s1; sel[tid * 4 + 3] = s2 < 0 ? 0 : s2; }
    __syncthreads();
    KeysMoba ks{sel, q0}; float o[8]; float l;
    attn_simple_core(ks, qs, Ssc, K0, V0, 1024, q0, o, l);
    const int qi = tid >> 4, part = tid & 15; const float inv = 1.0f / l;
    bf16_t* yp = Y0 + (size_t)(q0 + qi) * 2048 + 8 * part; const u32x4 gw = *(const u32x4*)yp;
    u32x4 w; w.x = pk2(o[0] * inv * bf_lo(gw.x), o[1] * inv * bf_hi(gw.x)); w.y = pk2(o[2] * inv * bf_lo(gw.y), o[3] * inv * bf_hi(gw.y));
    w.z = pk2(o[4] * inv * bf_lo(gw.z), o[5] * inv * bf_hi(gw.z)); w.w = pk2(o[6] * inv * bf_lo(gw.w), o[7] * inv * bf_hi(gw.w));
    *(u32x4*)yp = w;
}
__device__ __forceinline__ void dilated_item(const Params& P, LAS unsigned char* lds, int b, int h, int qt) {
    unsigned char* ws = P.ws; const int tid = threadIdx.x;
    LAS float* Ssc = (LAS float*)lds; LAS float* qs = (LAS float*)(lds + 131072);
    bf16_t* Q1 = (bf16_t*)(ws + WS_QO1) + (size_t)b * SEQ * 2048 + h * 128; const bf16_t* K1 = (const bf16_t*)(ws + WS_K1) + (size_t)b * SEQ * 2048 + h * 128;
    const bf16_t* V1 = (const bf16_t*)(ws + WS_V1) + (size_t)b * SEQ * 2048 + h * 128;
    const int q0 = qt * 32;
    __syncthreads();
    load_q_tile(qs, Q1 + (size_t)q0 * 2048, 2048);
    __syncthreads();
    KeysDilated ks; float o[8]; float l;
    attn_simple_core(ks, qs, Ssc, K1, V1, 2048, q0, o, l);
    const int qi = tid >> 4, part = tid & 15; const float inv = 1.0f / l;
    u32x4 w; w.x = pk2(o[0] * inv, o[1] * inv); w.y = pk2(o[2] * inv, o[3] * inv); w.z = pk2(o[4] * inv, o[5] * inv); w.w = pk2(o[6] * inv, o[7] * inv);
    *(u32x4*)(Q1 + (size_t)(q0 + qi) * 2048 + 8 * part) = w;
}

typedef short s16x4 __attribute__((ext_vector_type(4)));
constexpr int KSTR = 272, VSTR = 288;
#define MFMA16(a, b, c) __builtin_amdgcn_mfma_f32_16x16x32_bf16((a), (b), (c), 0, 0, 0)
struct WTile { bf16x8 qf[4]; f32x4 o[8]; float m, l; };
__device__ __forceinline__ void wt_reset(WTile& w) {
#pragma unroll
    for (int d = 0; d < 8; ++d) w.o[d] = (f32x4){0.f, 0.f, 0.f, 0.f};
    w.m = -1.0e30f; w.l = 0.f;
}
__device__ __forceinline__ void wt_load_q(WTile& w, const bf16_t* qrow, int lane) {
    const int g = lane >> 4;
#pragma unroll
    for (int ks = 0; ks < 4; ++ks) w.qf[ks] = *(const bf16x8*)(qrow + 32 * ks + 8 * g);
}
__device__ __forceinline__ void wt_qk_lds(const WTile& w, const LAS unsigned char* Kb, int lane, f32x4& s0, f32x4& s1) {
    const LAS unsigned char* p = Kb + (lane & 15) * KSTR + (lane >> 4) * 16;
    s0 = (f32x4){0.f, 0.f, 0.f, 0.f}; s1 = s0;
#pragma unroll
    for (int ks = 0; ks < 4; ++ks) { const bf16x8 a0 = *(const LAS bf16x8*)(p + ks * 64), a1 = *(const LAS bf16x8*)(p + 16 * KSTR + ks * 64);
        s0 = MFMA16(a0, w.qf[ks], s0); s1 = MFMA16(a1, w.qf[ks], s1); }
}
__device__ __forceinline__ void wt_softmax_pv(WTile& w, f32x4 s0, f32x4 s1, const LAS unsigned char* Vb, int lane) {
    float mx = fmaxf(fmaxf(fmaxf(s0[0], s0[1]), fmaxf(s0[2], s0[3])), fmaxf(fmaxf(s1[0], s1[1]), fmaxf(s1[2], s1[3])));
    mx = fmaxf(mx, __shfl_xor(mx, 16)); mx = fmaxf(mx, __shfl_xor(mx, 32));
    const float mn = fmaxf(w.m, mx), alpha = __builtin_amdgcn_exp2f(w.m - mn);
    w.m = mn;
    float p[8];
#pragma unroll
    for (int r = 0; r < 4; ++r) { p[r] = __builtin_amdgcn_exp2f(s0[r] - mn); p[4 + r] = __builtin_amdgcn_exp2f(s1[r] - mn); }
    w.l = w.l * alpha + (((p[0] + p[1]) + (p[2] + p[3])) + ((p[4] + p[5]) + (p[6] + p[7])));
    u32x4 pw; pw.x = pk2(p[0], p[1]); pw.y = pk2(p[2], p[3]); pw.z = pk2(p[4], p[5]); pw.w = pk2(p[6], p[7]);
    const bf16x8 pf = __builtin_bit_cast(bf16x8, pw);
    const int i = lane & 15, g = lane >> 4;
    const LAS unsigned char* vp = Vb + (4 * g + (i >> 2)) * VSTR + (i & 3) * 8;
#pragma unroll
    for (int dt = 0; dt < 8; ++dt) {
        const s16x4 lo = __builtin_amdgcn_ds_read_tr16_b64_v4i16((LAS s16x4*)(vp + dt * 32));
        const s16x4 hi = __builtin_amdgcn_ds_read_tr16_b64_v4i16((LAS s16x4*)(vp + 16 * VSTR + dt * 32));
        const bf16x8 vf = __builtin_shufflevector(lo, hi, 0, 1, 2, 3, 4, 5, 6, 7);
        w.o[dt] = MFMA16(vf, pf, w.o[dt] * alpha);
    }
}

constexpr int SI_B = 0, SI_C = 34816, SI_XT = 69632, SI_PREV = 87040, SI_ARR = 121856, SI_STR = 272;
__device__ __forceinline__ void ssd_item_mfma(const Params& P, LAS unsigned char* lds, int b, int h) {
    int tid_ = threadIdx.x; asm volatile("" : "+v"(tid_));
    const int tid = tid_, lane = tid & 63, w = __builtin_amdgcn_readfirstlane(tid >> 6), i = lane & 15, g = lane >> 4;
    unsigned char* ws = P.ws;
    const bf16_t* XBC = (const bf16_t*)(ws + WS_XBC); bf16_t* Y0 = (bf16_t*)(ws + WS_Y0); const float* dtg = (const float*)(ws + WS_DT); float* ssq = (float*)(ws + WS_SSQ);
    LAS unsigned char* Bi = lds + SI_B; LAS unsigned char* Ci = lds + SI_C; LAS unsigned char* XT = lds + SI_XT;
    LAS float* A2 = (LAS float*)(lds + SI_ARR); LAS float* A3 = A2 + 128; LAS float* WL = A2 + 256; LAS float* EL = A2 + 384; LAS float* CD = A2 + 512;
    const int grp = h >> 3;
    const float a2 = -expf(P.a_log[h]) * 1.4426950408889634f, Dh = P.d_skip[h];
    const int q4 = tid % 80, sg = tid / 80;
    int ch = 0; float cw[4][4], cb[4];
    if (tid < 320) { ch = q4 < 16 ? h * 64 + 4 * q4 : (q4 < 48 ? 1024 + grp * 128 + 4 * (q4 - 16) : 1280 + grp * 128 + 4 * (q4 - 48));
#pragma unroll
        for (int e = 0; e < 4; ++e) { cb[e] = P.conv_b[ch + e];
#pragma unroll
            for (int j = 0; j < 4; ++j) cw[j][e] = P.conv_w[j * 1536 + ch + e]; } }
    f32x4 carry[4];
#pragma unroll
    for (int pt = 0; pt < 4; ++pt) carry[pt] = (f32x4){0.f, 0.f, 0.f, 0.f};
    __syncthreads();
#pragma unroll 1
    for (int c = 0; c < 16; ++c) {
        const size_t tok0 = (size_t)b * SEQ + c * 128;
        if (tid < 320) {
            float win[3][4];
#pragma unroll
            for (int j = 0; j < 3; ++j) { const int l = 32 * sg - 3 + j; u32x2 v = (u32x2){0u, 0u}; if (c > 0 || l >= 0) v = *(const u32x2*)(XBC + (tok0 + l) * 1536 + ch);
                win[j][0] = bf_lo(v.x); win[j][1] = bf_hi(v.x); win[j][2] = bf_lo(v.y); win[j][3] = bf_hi(v.y); }
#pragma unroll 4
            for (int tt = 0; tt < 32; ++tt) { const int l = 32 * sg + tt; const u32x2 v = *(const u32x2*)(XBC + (tok0 + l) * 1536 + ch);
                const float cur[4] = {bf_lo(v.x), bf_hi(v.x), bf_lo(v.y), bf_hi(v.y)}; float o[4];
#pragma unroll
                for (int e = 0; e < 4; ++e) { o[e] = silu_f(cb[e] + cw[0][e] * win[0][e] + cw[1][e] * win[1][e] + cw[2][e] * win[2][e] + cw[3][e] * cur[e]); win[0][e] = win[1][e]; win[1][e] = win[2][e]; win[2][e] = cur[e]; }
                if (q4 < 16) {
#pragma unroll
                    for (int e = 0; e < 4; ++e) *(LAS bf16_t*)(XT + (4 * q4 + e) * SI_STR + l * 2) = (bf16_t)f2bf(o[e]);
                } else { LAS unsigned char* img = q4 < 48 ? Bi + (q4 - 16) * 8 : Ci + (q4 - 48) * 8; u32x2 pw; pw.x = pk2(o[0], o[1]); pw.y = pk2(o[2], o[3]); *(LAS u32x2*)(img + l * SI_STR) = pw; }
            }
        } else if (w == 7) {
            const float d0 = dtg[(tok0 + lane) * 16 + h], d1 = dtg[(tok0 + 64 + lane) * 16 + h];
            float v0 = d0 * a2, v1 = d1 * a2;
#pragma unroll
            for (int o = 1; o < 64; o <<= 1) { const float t0 = __shfl_up(v0, o), t1 = __shfl_up(v1, o); if (lane >= o) { v0 += t0; v1 += t1; } }
            v1 += __shfl(v0, 63);
            const float aend = __shfl(v1, 63);
            A2[lane] = v0; A2[64 + lane] = v1; A3[lane] = v0 - __log2f(d0); A3[64 + lane] = v1 - __log2f(d1);
            WL[lane] = d0 * __builtin_amdgcn_exp2f(aend - v0); WL[64 + lane] = d1 * __builtin_amdgcn_exp2f(aend - v1);
            EL[lane] = __builtin_amdgcn_exp2f(v0); EL[64 + lane] = __builtin_amdgcn_exp2f(v1);
            if (lane == 0) CD[0] = __builtin_amdgcn_exp2f(aend);
        }
        __syncthreads();
        const LAS unsigned char* PV = lds + SI_PREV + (c & 1) * 17408; LAS unsigned char* PN = lds + SI_PREV + ((c & 1) ^ 1) * 17408;
        const int lidx = 16 * w + i;
        bf16x8 cf[4];
#pragma unroll
        for (int ks = 0; ks < 4; ++ks) cf[ks] = *(const LAS bf16x8*)(Ci + lidx * SI_STR + (32 * ks + 8 * g) * 2);
        f32x4 yd[4], yo[4];
#pragma unroll
        for (int pt = 0; pt < 4; ++pt) { yd[pt] = (f32x4){0.f, 0.f, 0.f, 0.f}; yo[pt] = yd[pt]; }
        const float A2l = A2[lidx];
#pragma unroll
        for (int sp = 0; sp < 4; ++sp) {
            if (2 * sp <= w) {
                f32x4 g0 = (f32x4){0.f, 0.f, 0.f, 0.f}, g1 = g0;
#pragma unroll
                for (int ks = 0; ks < 4; ++ks) { const bf16x8 b0 = *(const LAS bf16x8*)(Bi + (32 * sp + i) * SI_STR + (32 * ks + 8 * g) * 2), b1 = *(const LAS bf16x8*)(Bi + (32 * sp + 16 + i) * SI_STR + (32 * ks + 8 * g) * 2);
                    g0 = MFMA16(b0, cf[ks], g0); g1 = MFMA16(b1, cf[ks], g1); }
                const f32x4 a30 = *(const LAS f32x4*)(A3 + 32 * sp + 4 * g), a31 = *(const LAS f32x4*)(A3 + 32 * sp + 16 + 4 * g);
                float m[8];
#pragma unroll
                for (int r = 0; r < 4; ++r) { const int s0i = 32 * sp + 4 * g + r, s1i = s0i + 16;
                    m[r] = (s0i <= lidx) ? g0[r] * __builtin_amdgcn_exp2f(A2l - a30[r]) : 0.f; m[4 + r] = (s1i <= lidx) ? g1[r] * __builtin_amdgcn_exp2f(A2l - a31[r]) : 0.f; }
                u32x4 mw; mw.x = pk2(m[0], m[1]); mw.y = pk2(m[2], m[3]); mw.z = pk2(m[4], m[5]); mw.w = pk2(m[6], m[7]);
                const bf16x8 mf = __builtin_bit_cast(bf16x8, mw);
#pragma unroll
                for (int pt = 0; pt < 4; ++pt) { const u32x2 lo = *(const LAS u32x2*)(XT + (16 * pt + i) * SI_STR + (32 * sp + 4 * g) * 2), hi = *(const LAS u32x2*)(XT + (16 * pt + i) * SI_STR + (32 * sp + 16 + 4 * g) * 2);
                    const u32x4 xw = (u32x4){lo.x, lo.y, hi.x, hi.y}; yd[pt] = MFMA16(__builtin_bit_cast(bf16x8, xw), mf, yd[pt]); }
            }
        }
        if (c > 0) {
#pragma unroll
            for (int ks = 0; ks < 4; ++ks)
#pragma unroll
                for (int pt = 0; pt < 4; ++pt) { const bf16x8 pf = *(const LAS bf16x8*)(PV + (16 * pt + i) * SI_STR + (32 * ks + 8 * g) * 2); yo[pt] = MFMA16(pf, cf[ks], yo[pt]); }
        }
        {
            const float el = EL[lidx]; float ss = 0.f; bf16_t* yrow = Y0 + (tok0 + lidx) * 2048 + h * 64 + 4 * g;
#pragma unroll
            for (int pt = 0; pt < 4; ++pt) {
                const s16x4 xs = __builtin_amdgcn_ds_read_tr16_b64_v4i16((LAS s16x4*)(XT + (16 * pt + 4 * g + (i >> 2)) * SI_STR + (16 * w + 4 * (i & 3)) * 2));
                const u32x2 zw = *(const u32x2*)(yrow + 16 * pt); const float zf[4] = {bf_lo(zw.x), bf_hi(zw.x), bf_lo(zw.y), bf_hi(zw.y)}; float u[4];
#pragma unroll
                for (int r = 0; r < 4; ++r) { u[r] = (yd[pt][r] + el * yo[pt][r] + Dh * bf2f((bf16_t)xs[r])) * zf[r]; ss += u[r] * u[r]; }
                u32x2 uw; uw.x = pk2(u[0], u[1]); uw.y = pk2(u[2], u[3]); *(u32x2*)(yrow + 16 * pt) = uw;
            }
            ss += __shfl_xor(ss, 16); ss += __shfl_xor(ss, 32);
            if (g == 0) ssq[(tok0 + lidx) * 16 + h] = ss;
        }
        {
            f32x4 st[4];
#pragma unroll
            for (int pt = 0; pt < 4; ++pt) st[pt] = (f32x4){0.f, 0.f, 0.f, 0.f};
#pragma unroll
            for (int ks = 0; ks < 4; ++ks) {
                const s16x4 lo = __builtin_amdgcn_ds_read_tr16_b64_v4i16((LAS s16x4*)(Bi + (32 * ks + 8 * g + (i >> 2)) * SI_STR + (16 * w + 4 * (i & 3)) * 2));
                const s16x4 hi = __builtin_amdgcn_ds_read_tr16_b64_v4i16((LAS s16x4*)(Bi + (32 * ks + 8 * g + 4 + (i >> 2)) * SI_STR + (16 * w + 4 * (i & 3)) * 2));
                const f32x4 w0 = *(const LAS f32x4*)(WL + 32 * ks + 8 * g), w1 = *(const LAS f32x4*)(WL + 32 * ks + 8 * g + 4);
                u32x4 bw; bw.x = pk2(bf2f((bf16_t)lo[0]) * w0[0], bf2f((bf16_t)lo[1]) * w0[1]); bw.y = pk2(bf2f((bf16_t)lo[2]) * w0[2], bf2f((bf16_t)lo[3]) * w0[3]);
                bw.z = pk2(bf2f((bf16_t)hi[0]) * w1[0], bf2f((bf16_t)hi[1]) * w1[1]); bw.w = pk2(bf2f((bf16_t)hi[2]) * w1[2], bf2f((bf16_t)hi[3]) * w1[3]);
                const bf16x8 btf = __builtin_bit_cast(bf16x8, bw);
#pragma unroll
                for (int pt = 0; pt < 4; ++pt) { const bf16x8 xb = *(const LAS bf16x8*)(XT + (16 * pt + i) * SI_STR + (32 * ks + 8 * g) * 2); st[pt] = MFMA16(btf, xb, st[pt]); }
            }
            const float cd = CD[0];
#pragma unroll
            for (int pt = 0; pt < 4; ++pt) { carry[pt] = carry[pt] * cd + st[pt];
                u32x2 cwv; cwv.x = pk2(carry[pt][0], carry[pt][1]); cwv.y = pk2(carry[pt][2], carry[pt][3]); *(LAS u32x2*)(PN + (16 * pt + i) * SI_STR + (16 * w + 4 * g) * 2) = cwv; }
        }
        __syncthreads();
    }
}

constexpr int MB_KBUF = 0, MB_VBUF = 2 * 32 * KSTR, MB_MISC = MB_VBUF + 2 * 32 * VSTR;
__device__ __forceinline__ void moba_item_mfma(const Params& P, LAS unsigned char* lds, int b, int h, int qt) {
    unsigned char* ws = P.ws; int tid_ = threadIdx.x; asm volatile("" : "+v"(tid_)); const int tid = tid_, lane = tid & 63, wave = __builtin_amdgcn_readfirstlane(tid >> 6);
    const bf16_t* Q0 = (const bf16_t*)(ws + WS_Q0) + (size_t)b * SEQ * 1024 + h * 128; const bf16_t* K0 = (const bf16_t*)(ws + WS_K0) + (size_t)b * SEQ * 1024 + h * 128;
    const bf16_t* V0 = (const bf16_t*)(ws + WS_V0) + (size_t)b * SEQ * 1024 + h * 128; bf16_t* Y0 = (bf16_t*)(ws + WS_Y0) + (size_t)b * SEQ * 2048 + 1024 + h * 128;
    const float* kpart = (const float*)(ws + WS_KPART);
    LAS float* ksum = (LAS float*)(lds + MB_MISC);
    LAS float* gts = ksum + 8 * 128;
    LAS int* selm = (LAS int*)(gts + 128 * 8);
    LAS int* tiles = selm + 128;
    LAS int* bmask = tiles + 72;
    const int q0 = qt * 128, qb = q0 >> 8;
    __syncthreads();
    for (int i = tid; i < qb * 128; i += NTHREADS) { const int n = i >> 7, d = i & 127; const float* kp = kpart + ((size_t)(b * 8 + n) * 2) * 1024 + h * 128 + d; ksum[i] = kp[0] + kp[1024]; }
    if (tid == 0) bmask[0] = 0;
    __syncthreads();
    { const int q = tid >> 2, nn = tid & 3; const u32x4* qr = (const u32x4*)(Q0 + (size_t)(q0 + q) * 1024);
        float a0 = 0.f, a1 = 0.f; const LAS float* k0p = ksum + nn * 128; const LAS float* k1p = ksum + (nn + 4) * 128;
        const bool d0 = nn < qb, d1 = nn + 4 < qb;
        if (d0) {
#pragma unroll 4
            for (int c = 0; c < 16; ++c) { const u32x4 w = qr[c]; const float qv[8] = {bf_lo(w.x), bf_hi(w.x), bf_lo(w.y), bf_hi(w.y), bf_lo(w.z), bf_hi(w.z), bf_lo(w.w), bf_hi(w.w)};
#pragma unroll
                for (int e = 0; e < 8; ++e) { a0 += qv[e] * k0p[8 * c + e]; if (d1) a1 += qv[e] * k1p[8 * c + e]; } }
            gts[q * 8 + nn] = a0; if (d1) gts[q * 8 + nn + 4] = a1; }
    }
    __syncthreads();
    if (tid < 128) { int s0 = -1, s1 = -1, s2 = -1; float g0 = -__builtin_inff(), g1 = g0, g2 = g0;
        for (int n = 0; n < qb; ++n) { const float gv = gts[tid * 8 + n];
            if (gv > g0) { g2 = g1; s2 = s1; g1 = g0; s1 = s0; g0 = gv; s0 = n; } else if (gv > g1) { g2 = g1; s2 = s1; g1 = gv; s1 = n; } else if (gv > g2) { g2 = gv; s2 = n; } }
        int mk = 0; if (s0 >= 0) mk |= 1 << s0; if (s1 >= 0) mk |= 1 << s1; if (s2 >= 0) mk |= 1 << s2;
        selm[tid] = mk; atomicOr((int*)bmask, mk); }
    __syncthreads();
    if (tid == 0) { const int bm = bmask[0]; int c = 0;
        for (int n = 0; n < qb; ++n) if ((bm >> n) & 1) for (int j = 0; j < 8; ++j) tiles[c++] = n * 256 + 32 * j;
        for (int kb = qb * 256; kb < q0 + 128; kb += 32) tiles[c++] = kb;
        tiles[64] = c; }
    __syncthreads();
    const int ntiles = tiles[64];
    const int qi = lane & 15, g = lane >> 4, myq = q0 + wave * 16 + qi, mymask = selm[wave * 16 + qi];
    WTile w; wt_reset(w); wt_load_q(w, Q0 + (size_t)myq * 1024, lane);
    const int srow = tid >> 4, sch = tid & 15;
    u32x4 kreg, vreg;
    { const int kb = tiles[0]; kreg = *(const u32x4*)(K0 + (size_t)(kb + srow) * 1024 + 8 * sch); vreg = *(const u32x4*)(V0 + (size_t)(kb + srow) * 1024 + 8 * sch); }
    *(LAS u32x4*)(lds + MB_KBUF + srow * KSTR + sch * 16) = kreg; *(LAS u32x4*)(lds + MB_VBUF + srow * VSTR + sch * 16) = vreg;
    __syncthreads();
    for (int t = 0; t < ntiles; ++t) {
        const int kb = tiles[t], cur = t & 1;
        if (t + 1 < ntiles) { const int kn = tiles[t + 1]; kreg = *(const u32x4*)(K0 + (size_t)(kn + srow) * 1024 + 8 * sch); vreg = *(const u32x4*)(V0 + (size_t)(kn + srow) * 1024 + 8 * sch); }
        const int n = kb >> 8; bool active;
        if (n < qb) active = __ballot((mymask >> n) & 1) != 0ull; else active = kb <= q0 + wave * 16 + 15;
        if (active) {
            f32x4 s0, s1; wt_qk_lds(w, lds + MB_KBUF + cur * 32 * KSTR, lane, s0, s1);
            const float NEG = -__builtin_inff();
            if (n < qb) { if (!((mymask >> n) & 1)) { s0 = (f32x4){NEG, NEG, NEG, NEG}; s1 = s0; } }
            else {
#pragma unroll
                for (int r = 0; r < 4; ++r) { if (kb + 4 * g + r > myq) s0[r] = NEG; if (kb + 16 + 4 * g + r > myq) s1[r] = NEG; } }
            wt_softmax_pv(w, s0, s1, lds + MB_VBUF + cur * 32 * VSTR, lane);
        }
        if (t + 1 < ntiles) { *(LAS u32x4*)(lds + MB_KBUF + (cur ^ 1) * 32 * KSTR + srow * KSTR + sch * 16) = kreg; *(LAS u32x4*)(lds + MB_VBUF + (cur ^ 1) * 32 * VSTR + srow * VSTR + sch * 16) = vreg; }
        __syncthreads();
    }
    float l = w.l; l += __shfl_xor(l, 16); l += __shfl_xor(l, 32); const float inv = 1.0f / l;
    bf16_t* yp = Y0 + (size_t)myq * 2048 + 4 * g;
#pragma unroll
    for (int dt = 0; dt < 8; ++dt) { const u32x2 gw = *(const u32x2*)(yp + 16 * dt);
        u32x2 o; o.x = pk2(w.o[dt][0] * inv * bf_lo(gw.x), w.o[dt][1] * inv * bf_hi(gw.x)); o.y = pk2(w.o[dt][2] * inv * bf_lo(gw.y), w.o[dt][3] * inv * bf_hi(gw.y));
        *(u32x2*)(yp + 16 * dt) = o; }
}

constexpr int DL_OACC = 0, DL_LSE = 65536, DL_V = 66560;
__device__ __forceinline__ void dilated_item_mfma(const Params& P, LAS unsigned char* lds, int b, int h, int blk) {
    unsigned char* ws = P.ws; int tid_ = threadIdx.x; asm volatile("" : "+v"(tid_)); const int tid = tid_, lane = tid & 63, wave = __builtin_amdgcn_readfirstlane(tid >> 6);
    bf16_t* Q1 = (bf16_t*)(ws + WS_QO1) + (size_t)b * SEQ * 2048 + h * 128; const bf16_t* K1 = (const bf16_t*)(ws + WS_K1) + (size_t)b * SEQ * 2048 + h * 128;
    const bf16_t* V1 = (const bf16_t*)(ws + WS_V1) + (size_t)b * SEQ * 2048 + h * 128;
    LAS unsigned char* Vw = lds + DL_V + wave * (32 * VSTR); LAS float* lse = (LAS float*)(lds + DL_LSE);
    const int T0 = blk * 256, qi = lane & 15, g = lane >> 4;
    __syncthreads();
#pragma unroll 1
    for (int pt = 0; pt < 3; ++pt) {
        const int r = 1 << (2 * pt);
#pragma unroll 1
        for (int half = 0; half < 2; ++half) {
            const int wt = wave + 8 * half;
            const int t0 = T0 + (pt == 0 ? 16 * wt : (pt == 1 ? (wt & 3) + 64 * (wt >> 2) : wt));
            const int myq = t0 + r * qi;
            WTile w; wt_reset(w); wt_load_q(w, Q1 + (size_t)myq * 2048, lane);
            const int kp0 = t0 - 144 * r;
#pragma unroll 1
            for (int s = 0; s < 5; ++s) {
                const int kps = kp0 + 32 * s * r;
                if (kps + 31 * r < 0) continue;
                bf16x8 ka[2][4];
#pragma unroll
                for (int a = 0; a < 2; ++a) { int pos = kps + (16 * a + qi) * r; pos = pos < 0 ? 0 : pos; const bf16_t* kr = K1 + (size_t)pos * 2048 + 8 * g;
#pragma unroll
                    for (int ks = 0; ks < 4; ++ks) ka[a][ks] = *(const bf16x8*)(kr + 32 * ks); }
                u32x4 vr[8];
#pragma unroll
                for (int j = 0; j < 8; ++j) { const int c = lane + 64 * j, row = c >> 4, ch = c & 15; int pos = kps + row * r; pos = pos < 0 ? 0 : pos; vr[j] = *(const u32x4*)(V1 + (size_t)pos * 2048 + 8 * ch); }
#pragma unroll
                for (int j = 0; j < 8; ++j) { const int c = lane + 64 * j, row = c >> 4, ch = c & 15; *(LAS u32x4*)(Vw + row * VSTR + ch * 16) = vr[j]; }
                f32x4 s0 = (f32x4){0.f, 0.f, 0.f, 0.f}, s1 = s0;
#pragma unroll
                for (int ks = 0; ks < 4; ++ks) { s0 = MFMA16(ka[0][ks], w.qf[ks], s0); s1 = MFMA16(ka[1][ks], w.qf[ks], s1); }
                const float NEG = -__builtin_inff();
#pragma unroll
                for (int e = 0; e < 4; ++e) { const int kk0 = 4 * g + e, kk1 = 16 + 4 * g + e; const int d0 = qi + 144 - 32 * s - kk0, d1 = qi + 144 - 32 * s - kk1;
                    if (d0 < 0 || d0 > 128 || kps + kk0 * r < 0) s0[e] = NEG; if (d1 < 0 || d1 > 128 || kps + kk1 * r < 0) s1[e] = NEG; }
                wt_softmax_pv(w, s0, s1, Vw, lane);
            }
            float l = w.l; l += __shfl_xor(l, 16); l += __shfl_xor(l, 32); const float inv = 1.0f / l; const float ls = w.m + __log2f(l);
            const int row = myq - T0;
            LAS unsigned char* orow = lds + DL_OACC + row * 256 + 8 * g;
            if (pt == 0) {
#pragma unroll
                for (int dt = 0; dt < 8; ++dt) { u32x2 o; o.x = pk2(w.o[dt][0] * inv, w.o[dt][1] * inv); o.y = pk2(w.o[dt][2] * inv, w.o[dt][3] * inv); *(LAS u32x2*)(orow + 32 * dt) = o; }
                if (g == 0) lse[row] = ls;
            } else {
                const float lo = lse[row], mxl = fmaxf(lo, ls); const float eo = __builtin_amdgcn_exp2f(lo - mxl), en = __builtin_amdgcn_exp2f(ls - mxl), den = eo + en;
                const float wo = eo / den, wn = en / den * inv;
                bf16_t* gout = Q1 + (size_t)myq * 2048 + 4 * g;
#pragma unroll
                for (int dt = 0; dt < 8; ++dt) { const u32x2 ov = *(const LAS u32x2*)(orow + 32 * dt);
                    u32x2 o; o.x = pk2(wo * bf_lo(ov.x) + wn * w.o[dt][0], wo * bf_hi(ov.x) + wn * w.o[dt][1]); o.y = pk2(wo * bf_lo(ov.y) + wn * w.o[dt][2], wo * bf_hi(ov.y) + wn * w.o[dt][3]);
                    if (pt == 1) *(LAS u32x2*)(orow + 32 * dt) = o; else *(u32x2*)(gout + 16 * dt) = o; }
                if (pt == 1) { asm volatile("s_waitcnt lgkmcnt(0)" ::: "memory"); if (g == 0) lse[row] = mxl + __log2f(den); }
            }
        }
        __syncthreads();
    }
}

__global__ void __launch_bounds__(NTHREADS, 2) fwd_megakernel(Params P) {
    extern __shared__ __attribute__((aligned(16))) unsigned char lds_raw[];
    LAS unsigned char* lds = (LAS unsigned char*)lds_raw;
    cg::grid_group grid = cg::this_grid();
    const int G = gridDim.x, tid = threadIdx.x;
    unsigned char* ws = P.ws;
    LAS int* misc = (LAS int*)(lds + LDS_BYTES - 64);

    if (PHASE_MASK & 1) phase_prep(P, lds, G);
    grid.sync();
    if (PHASE_MASK & 2) {
        pg8::Gemm g{(const bf16_t*)P.out, (const bf16_t*)(ws + WS_W0T), MTOK, N0, DM}; pg8::StaticOrder S; S.init(MTOK, N0, G, (int)blockIdx.x);
        EpiIn0 E{(bf16_t*)(ws + WS_Y0), (bf16_t*)(ws + WS_XBC), (bf16_t*)(ws + WS_Q0), (bf16_t*)(ws + WS_K0), (bf16_t*)(ws + WS_V0), (const float*)(ws + WS_RSTD0), (float*)(ws + WS_KPART)};
        pg8::gemm_phase(lds, g, S, E, pg8::NoHook{});
    }
    grid.sync();
    if (PHASE_MASK & 4) {
        unsigned* ctr = (unsigned*)(ws + WS_CTL);
        for (;;) {
            __syncthreads();
            if (tid == 0) misc[0] = (int)atomicAdd(ctr, 1u);
            __syncthreads();
            const int it = misc[0];
#if MOBA_MFMA
            if (it >= 128 + 1024) break;
            if (it < 128) { if (SSD_MFMA) ssd_item_mfma(P, lds, it >> 4, it & 15); else ssd_item(P, lds, it >> 4, it & 15); }
            else { const int r = it - 128; const int qt = 15 - (r >> 6), bh = r & 63; moba_item_mfma(P, lds, bh >> 3, bh & 7, qt); }
#else
            if (it >= 128 + 4096) break;
            if (it < 128) ssd_item(P, lds, it >> 4, it & 15);
            else { const int r = it - 128; const int qt = 63 - (r >> 6), bh = r & 63; moba_item(P, lds, bh >> 3, bh & 7, qt); }
#endif
        }
    }
    grid.sync();
    if (PHASE_MASK & 8) {
        pg8::Gemm g{(const bf16_t*)(ws + WS_Y0), (const bf16_t*)(ws + WS_WO0T), MTOK, DM, 2048}; pg8::StaticOrder S; S.init(MTOK, DM, G, (int)blockIdx.x);
        EpiRes E{P.x, P.out, (bf16_t*)(ws + WS_X1B), (float*)(ws + WS_RSQ1)};
        HookSsdNorm H{(const float*)(ws + WS_SSQ)};
        pg8::gemm_phase(lds, g, S, E, H);
    }
    grid.sync();
    if (PHASE_MASK & 16) {
        pg8::Gemm g{(const bf16_t*)(ws + WS_X1B), (const bf16_t*)(ws + WS_W1T), MTOK, 6144, DM}; pg8::StaticOrder S; S.init(MTOK, 6144, G, (int)blockIdx.x);
        EpiQkv1 E{(bf16_t*)(ws + WS_QO1), (size_t)(WS_K1 - WS_QO1) / 2, (const float*)(ws + WS_RSQ1)};
        pg8::gemm_phase(lds, g, S, E, pg8::NoHook{});
    }
    grid.sync();
#if DIL_MFMA
    if (PHASE_MASK & 32) for (int it = blockIdx.x; it < 8 * 16 * 8; it += G) { const int blk = (it ^ (it >> 8)) & 7, bh = it >> 3; dilated_item_mfma(P, lds, bh >> 4, bh & 15, blk); }
#else
    if (PHASE_MASK & 32) for (int it = blockIdx.x; it < 8 * 16 * 64; it += G) { const int qt = it & 63, bh = it >> 6; dilated_item(P, lds, bh >> 4, bh & 15, qt); }
#endif
    grid.sync();
    if (PHASE_MASK & 64) {
        pg8::Gemm g{(const bf16_t*)(ws + WS_X1B), (const bf16_t*)(ws + WS_W1T) + (size_t)6144 * 1024, MTOK, 2048, DM}; pg8::StaticOrder S; S.init(MTOK, 2048, G, (int)blockIdx.x);
        EpiGate1 E{(bf16_t*)(ws + WS_QO1), (const float*)(ws + WS_RSQ1)};
        pg8::gemm_phase(lds, g, S, E, pg8::NoHook{});
    }
    grid.sync();
    if (PHASE_MASK & 128) {
        pg8::Gemm g{(const bf16_t*)(ws + WS_QO1), (const bf16_t*)(ws + WS_WO1T), MTOK, DM, 2048}; pg8::StaticOrder S; S.init(MTOK, DM, G, (int)blockIdx.x);
        EpiRes E{P.out, P.out, nullptr, (float*)(ws + WS_RSQ2)};
        pg8::gemm_phase(lds, g, S, E, pg8::NoHook{});
    }
    grid.sync();
    if (PHASE_MASK & 256) {
        const int lane = tid & 63, wave = tid >> 6; const float* rsq2 = (const float*)(ws + WS_RSQ2);
        for (int m = blockIdx.x * 8 + wave; m < MTOK; m += G * 8) {
            const float rs = rstd_from16(rsq2 + (size_t)m * 16);
            f32x4* xr = (f32x4*)(P.out + (size_t)m * DM) + lane; const f32x4* gr = (const f32x4*)P.final_norm + lane;
#pragma unroll
            for (int j = 0; j < 4; ++j) { const f32x4 v = xr[64 * j], gg = gr[64 * j]; xr[64 * j] = v * rs * gg; }
        }
    }
}

extern "C" void kernel_launch(void* const* d_in, const int* in_sizes, int n_in, void* d_out, int out_size, void* d_ws, size_t ws_size, hipStream_t stream) {
    static int grid_blocks = 0;
    if (grid_blocks == 0) {
        if (n_in != 14 || ws_size < WS_END) { fprintf(stderr, "kernel_launch: unexpected n_in %d / ws_size %zu\n", n_in, ws_size); grid_blocks = -1; return; }
        int dev = 0, cus = 0, per_cu = 0;
        hipGetDevice(&dev);
        hipDeviceGetAttribute(&cus, hipDeviceAttributeMultiprocessorCount, dev);
        hipFuncSetAttribute((const void*)fwd_megakernel, hipFuncAttributeMaxDynamicSharedMemorySize, LDS_BYTES);
        hipOccupancyMaxActiveBlocksPerMultiprocessor(&per_cu, (const void*)fwd_megakernel, NTHREADS, LDS_BYTES);
        if (per_cu < 1) { fprintf(stderr, "kernel_launch: occupancy query says %d blocks per CU\n", per_cu); per_cu = 1; }
        grid_blocks = cus * 1;
        (void)hipGetLastError();
    }
    if (grid_blocks < 0) return;
    Params p{};
    p.x = (const float*)d_in[0]; p.even_norm = (const float*)d_in[1]; p.w_in0 = (const float*)d_in[2]; p.conv_w = (const float*)d_in[3]; p.conv_b = (const float*)d_in[4];
    p.dt_bias = (const float*)d_in[5]; p.a_log = (const float*)d_in[6]; p.d_skip = (const float*)d_in[7]; p.ssd_norm = (const float*)d_in[8]; p.w_out0 = (const float*)d_in[9];
    p.odd_norm = (const float*)d_in[10]; p.w_in1 = (const float*)d_in[11]; p.w_out1 = (const float*)d_in[12]; p.final_norm = (const float*)d_in[13];
    p.out = (float*)d_out; p.ws = (unsigned char*)d_ws;
    void* args[] = {&p};
    hipError_t e = hipLaunchCooperativeKernel((const void*)fwd_megakernel, dim3(grid_blocks), dim3(NTHREADS), args, LDS_BYTES, stream);
    if (e != hipSuccess) fprintf(stderr, "cooperative launch failed: %s (grid %d)\n", hipGetErrorString(e), grid_blocks);
}
```

```cpp
#include <hip/hip_runtime.h>
#include <hip/hip_cooperative_groups.h>
#include <cstdio>
#include <cstdint>
namespace cg = cooperative_groups;

#define LAS __attribute__((address_space(3)))
typedef unsigned short bf16_t;
typedef short bf16x8 __attribute__((ext_vector_type(8)));
typedef float f32x4 __attribute__((ext_vector_type(4)));
typedef float f32x2 __attribute__((ext_vector_type(2)));
typedef unsigned u32x4 __attribute__((ext_vector_type(4)));
typedef unsigned u32x2 __attribute__((ext_vector_type(2)));

constexpr int BATCH = 8, SEQ = 2048, DM = 1024, MTOK = BATCH * SEQ;
constexpr int EVEN_IN = 6672;
constexpr int N0 = 6656;
constexpr float NORM_EPS = 1e-5f;
constexpr float QSCALE = 0.08838834764831845f * 1.4426950408889634f;
#ifndef PHASE_MASK
#define PHASE_MASK 0x1ff
#endif
#ifndef PROBE_PHASE
#define PROBE_PHASE -1
#endif
#ifndef PROBE_MULT
#define PROBE_MULT 4
#endif
#ifndef GEMM_SP2
#define GEMM_SP2 true
#endif
#ifndef GEMM_ALIGN
#define GEMM_ALIGN true
#endif
#ifndef SSD_MFMA
#define SSD_MFMA 1
#endif
#ifndef MOBA_MFMA
#define MOBA_MFMA 1
#endif
#ifndef DIL_MFMA
#define DIL_MFMA 1
#endif
constexpr int NTHREADS = 512;
constexpr int LDS_BYTES = 155648;
constexpr int RING_BYTES = 131072;

constexpr size_t MiB = 1u << 20;
constexpr size_t WS_CTL = 0;
constexpr size_t WS_RSTD0 = 64 * 1024;
constexpr size_t WS_KPART = 512 * 1024;
constexpr size_t WS_DT = 1 * MiB;
constexpr size_t WS_SSQ = 2 * MiB;
constexpr size_t WS_RSQ1 = 3 * MiB;
constexpr size_t WS_RSQ2 = 4 * MiB;
constexpr size_t WS_W1T = 5 * MiB;
constexpr size_t WS_WO1T = 21 * MiB;
constexpr size_t WS_W0T = 25 * MiB;
constexpr size_t WS_WO0T = 38 * MiB;
constexpr size_t WS_Y0 = 42 * MiB;
constexpr size_t WS_XBC = 106 * MiB;
constexpr size_t WS_Q0 = 154 * MiB;
constexpr size_t WS_K0 = 186 * MiB;
constexpr size_t WS_V0 = 218 * MiB;
constexpr size_t WS_X1B = 224 * MiB;
constexpr size_t WS_QO1 = 25 * MiB;
constexpr size_t WS_K1 = 89 * MiB;
constexpr size_t WS_V1 = 153 * MiB;
constexpr size_t WS_END = 256 * MiB;

struct Params {
    const float* x; const float* even_norm; const float* w_in0; const float* conv_w; const float* conv_b; const float* dt_bias; const float* a_log;
    const float* d_skip; const float* ssd_norm; const float* w_out0; const float* odd_norm; const float* w_in1; const float* w_out1; const float* final_norm;
    float* out; unsigned char* ws;
};

__device__ __forceinline__ unsigned f2bf(float f) { unsigned u = __builtin_bit_cast(unsigned, f); return (u + 0x7fffu + ((u >> 16) & 1u)) >> 16; }
__device__ __forceinline__ unsigned pk2(float lo, float hi) { return f2bf(lo) | (f2bf(hi) << 16); }
__device__ __forceinline__ float bf_lo(unsigned w) { return __builtin_bit_cast(float, w << 16); }
__device__ __forceinline__ float bf_hi(unsigned w) { return __builtin_bit_cast(float, w & 0xffff0000u); }
__device__ __forceinline__ float bf2f(bf16_t h) { return __builtin_bit_cast(float, (unsigned)h << 16); }
__device__ __forceinline__ float silu_f(float v) { return v * __builtin_amdgcn_rcpf(1.0f + __builtin_amdgcn_exp2f(-1.4426950408889634f * v)); }
__device__ __forceinline__ float wave_sum(float v) {
#pragma unroll
    for (int o = 1; o < 64; o <<= 1) v += __shfl_xor(v, o);
    return v;
}

namespace pg8 {
constexpr int BM = 256, BK = 64, HALF = 128, HTB = HALF * BK * 2, NXCD = 8, WGM = 8;
__host__ __device__ __forceinline__ int lds_byte(int r, int c) { const int st = (r >> 4) * 2 + (c >> 5), rr = r & 15, cc = c & 31, ob = rr * 64 + cc * 2; return st * 1024 + (ob ^ (((ob >> 9) & 1) << 5)); }
__host__ __device__ __forceinline__ void stage_rc(int b, int& R, int& C) { const int st = b / 1024, sb = b % 1024, swz = sb ^ (((sb >> 9) & 1) << 5); R = (st >> 1) * 16 + swz / 64; C = (st & 1) * 32 + (swz % 64) / 2; }
__host__ __device__ __forceinline__ int perm32(int rho) { const int n = rho >> 4, i = rho & 15; return 8 * (i >> 2) + 4 * n + (i & 3); }

struct Unit { int pm, pn; };
struct Gemm { const bf16_t* A; const bf16_t* Bt; int M, N, K; };

struct StaticOrder {
    int nM, nN, nwg, G, c;
    __device__ void init(int M, int N, int G_, int c_) { nM = M / BM; nN = N / BM; nwg = nM * nN; G = G_; c = c_; }
    __device__ bool next(int i, Unit& u) const {
        const long L = (long)i * G + c; if (L >= nwg) return false;
        int wgid = (int)L; { const int q = nwg / NXCD, r = nwg % NXCD, xcd = wgid % NXCD, off = wgid / NXCD; wgid = (xcd < r ? xcd * (q + 1) : r * (q + 1) + (xcd - r) * q) + off; }
        const int nig = WGM * nN, gid = wgid / nig, fm = gid * WGM, gsz = (nM - fm) < WGM ? (nM - fm) : WGM;
        u.pm = fm + ((wgid % nig) % gsz); u.pn = (wgid % nig) / gsz; return true;
    }
};
struct NoHook {
    __device__ __forceinline__ void begin(const Unit&, LAS unsigned char*) const {}
    __device__ __forceinline__ void at(f32x4 (&)[2][2][4][2], int, int, int, LAS unsigned char*) const {}
};

template <bool ALIGN_EPI, bool SP2, class Epi, class Sched, class Hook>
__device__ __forceinline__ void gemm_phase(LAS unsigned char* lds, const Gemm g, const Sched& S, const Epi& E, const Hook& H) {
    int tid_ = threadIdx.x; asm volatile("" : "+v"(tid_));
    const int tid = tid_, wid = __builtin_amdgcn_readfirstlane(tid >> 6), lane = tid & 63, wr = wid >> 2, wc = wid & 3, fr = lane & 15, fq = lane >> 4;
    const int K = g.K, nt = K / BK;
    unsigned voffA[2], voffB[2];
#pragma unroll
    for (int i = 0; i < 2; ++i) { int R, C; stage_rc(tid * 16 + i * 8192, R, C); const int Rb = Epi::PERM ? ((R & ~31) + perm32(R & 31)) : R;
        voffA[i] = (unsigned)(R * K + C) * 2u; voffB[i] = (unsigned)(Rb * K + C) * 2u; }
    const size_t kstep = (size_t)(BK * 2);
    const size_t hstep = (size_t)HALF * K * 2;
    const size_t tstep = 2 * hstep;
    const unsigned ldsw = (unsigned)wid * 1024u;
    const int aoff = lds_byte(wr * 64 + fr, fq * 8), boff = lds_byte(wc * 32 + fr, fq * 8);
#define PG8_SA(b, h) (((b) * 2 + (h)) * HTB)
#define PG8_SB(b, h) ((4 + (b) * 2 + (h)) * HTB)
#define PG8_STAGE(bufoff, gbase, voff) do { _Pragma("unroll") for (int _i = 0; _i < 2; ++_i) \
        __builtin_amdgcn_global_load_lds((const unsigned*)((const char*)(gbase) + (voff)[_i]), (LAS unsigned*)(lds + (bufoff) + ldsw + _i * 8192), 16, 0, 0); } while (0)
#define PG8_LDA(dst, b, h) do { _Pragma("unroll") for (int m = 0; m < 4; ++m) _Pragma("unroll") for (int k = 0; k < 2; ++k) dst[m][k] = *(const LAS bf16x8*)(lds + PG8_SA(b, h) + aoff + m * 2048 + k * 1024); } while (0)
#define PG8_LDB(dst, b, h) do { _Pragma("unroll") for (int n = 0; n < 2; ++n) _Pragma("unroll") for (int k = 0; k < 2; ++k) dst[n][k] = *(const LAS bf16x8*)(lds + PG8_SB(b, h) + boff + n * 2048 + k * 1024); } while (0)
#define PG8_MMA(ai, bj, At, Bt) do { __builtin_amdgcn_s_setprio(1); _Pragma("unroll") for (int m = 0; m < 4; ++m) _Pragma("unroll") for (int n = 0; n < 2; ++n) _Pragma("unroll") for (int k = 0; k < 2; ++k) \
        acc[ai][bj][m][n] = __builtin_amdgcn_mfma_f32_16x16x32_bf16(Bt[n][k], At[m][k], acc[ai][bj][m][n], 0, 0, 0); __builtin_amdgcn_s_setprio(0); } while (0)
#define PG8_WAIT_V(n) asm volatile("s_waitcnt vmcnt(" #n ")" ::: "memory")
#define PG8_WAIT_L(n) asm volatile("s_waitcnt lgkmcnt(" #n ")" ::: "memory")
#define PG8_BAR __builtin_amdgcn_s_barrier()
#define PG8_SCHED __builtin_amdgcn_sched_barrier(0)
    Unit cur, nxt; int ui = 0;
    if (!S.next(0, cur)) return;
    f32x4 acc[2][2][4][2];
#pragma unroll
    for (int a = 0; a < 2; ++a)
#pragma unroll
        for (int b = 0; b < 2; ++b)
#pragma unroll
            for (int m = 0; m < 4; ++m)
#pragma unroll
                for (int n = 0; n < 2; ++n) acc[a][b][m][n] = (f32x4){0.f, 0.f, 0.f, 0.f};
    bf16x8 At[4][2], B0[2][2], B1[2][2];
    const char* cA = (const char*)g.A + (size_t)cur.pm * tstep; const char* cB = (const char*)g.Bt + (size_t)cur.pn * tstep;
    H.begin(cur, lds);
    if constexpr (SP2) {
        PG8_STAGE(PG8_SB(0, 0), cB, voffB); PG8_STAGE(PG8_SB(0, 1), cB + hstep, voffB); PG8_STAGE(PG8_SA(0, 0), cA, voffA); PG8_STAGE(PG8_SA(0, 1), cA + hstep, voffA);
        if (wr == 1) PG8_BAR;
        PG8_WAIT_V(2); PG8_BAR;
        PG8_STAGE(PG8_SB(1, 0), cB + kstep, voffB); PG8_STAGE(PG8_SA(1, 0), cA + kstep, voffA); PG8_STAGE(PG8_SB(1, 1), cB + hstep + kstep, voffB);
        PG8_WAIT_V(6); PG8_BAR;
    } else {
        PG8_STAGE(PG8_SB(0, 0), cB, voffB); PG8_STAGE(PG8_SA(0, 0), cA, voffA); PG8_STAGE(PG8_SB(0, 1), cB + hstep, voffB); PG8_STAGE(PG8_SA(0, 1), cA + hstep, voffA);
        if (wr == 1) PG8_BAR;
        PG8_WAIT_V(4); PG8_BAR;
        PG8_STAGE(PG8_SB(1, 0), cB + kstep, voffB); PG8_STAGE(PG8_SA(1, 0), cA + kstep, voffA); PG8_STAGE(PG8_SB(1, 1), cB + hstep + kstep, voffB);
        PG8_WAIT_V(6); PG8_BAR;
    }
    for (;;) {
        const bool has_next = S.next(ui + 1, nxt);
        const char* nA = has_next ? (const char*)g.A + (size_t)nxt.pm * tstep : cA; const char* nB = has_next ? (const char*)g.Bt + (size_t)nxt.pn * tstep : cB;
        for (int t = 0; t < nt; t += 2) {
            const bool last = (t == nt - 2);
            const char* a1 = cA + (size_t)(t + 1) * kstep;
            const char* a2 = last ? nA : cA + (size_t)(t + 2) * kstep; const char* b2 = last ? nB : cB + (size_t)(t + 2) * kstep;
            const char* a3 = a2 + kstep; const char* b3 = b2 + kstep;
            H.at(acc, t, wr, fr, lds);
            if constexpr (SP2) {
            PG8_LDB(B0, 0, 0); PG8_LDB(B1, 0, 1); PG8_SCHED; PG8_LDA(At, 0, 0); PG8_STAGE(PG8_SA(1, 1), a1 + hstep, voffA);
            PG8_WAIT_V(8); PG8_WAIT_L(0); PG8_BAR; PG8_MMA(0, 0, At, B0); PG8_MMA(0, 1, At, B1); PG8_BAR; PG8_SCHED;
            PG8_LDA(At, 0, 1); PG8_STAGE(PG8_SB(0, 0), b2, voffB); PG8_STAGE(PG8_SB(0, 1), b2 + hstep, voffB); PG8_STAGE(PG8_SA(0, 0), a2, voffA);
            PG8_WAIT_V(8); PG8_WAIT_L(0); PG8_BAR; PG8_MMA(1, 0, At, B0); PG8_MMA(1, 1, At, B1); PG8_BAR; PG8_SCHED;
            PG8_LDB(B0, 1, 0); PG8_LDB(B1, 1, 1); PG8_SCHED; PG8_LDA(At, 1, 0); PG8_STAGE(PG8_SA(0, 1), a2 + hstep, voffA);
            PG8_WAIT_V(8); PG8_WAIT_L(0); PG8_BAR; PG8_MMA(0, 0, At, B0); PG8_MMA(0, 1, At, B1); PG8_BAR; PG8_SCHED;
            PG8_LDA(At, 1, 1); PG8_STAGE(PG8_SB(1, 0), b3, voffB); PG8_STAGE(PG8_SB(1, 1), b3 + hstep, voffB); PG8_STAGE(PG8_SA(1, 0), a3, voffA);
            PG8_WAIT_V(8); PG8_WAIT_L(0); PG8_BAR; PG8_MMA(1, 0, At, B0); PG8_MMA(1, 1, At, B1); PG8_BAR; PG8_SCHED;
            } else {
            PG8_LDB(B0, 0, 0); PG8_SCHED; PG8_LDA(At, 0, 0); PG8_STAGE(PG8_SA(1, 1), a1 + hstep, voffA);
            PG8_WAIT_L(8); PG8_BAR; PG8_WAIT_L(0); PG8_MMA(0, 0, At, B0); PG8_BAR; PG8_SCHED;
            PG8_LDB(B1, 0, 1); PG8_STAGE(PG8_SB(0, 0), b2, voffB);
            PG8_BAR; PG8_WAIT_L(0); PG8_MMA(0, 1, At, B1); PG8_BAR;
            PG8_LDA(At, 0, 1); PG8_STAGE(PG8_SA(0, 0), a2, voffA);
            PG8_BAR; PG8_WAIT_L(0); PG8_MMA(1, 0, At, B0); PG8_BAR; PG8_SCHED;
            PG8_STAGE(PG8_SB(0, 1), b2 + hstep, voffB);
            PG8_WAIT_V(6); PG8_BAR; PG8_MMA(1, 1, At, B1); PG8_BAR;
            PG8_LDB(B0, 1, 0); PG8_SCHED; PG8_LDA(At, 1, 0); PG8_STAGE(PG8_SA(0, 1), a2 + hstep, voffA);
            PG8_WAIT_L(8); PG8_BAR; PG8_WAIT_L(0); PG8_MMA(0, 0, At, B0); PG8_BAR; PG8_SCHED;
            PG8_LDB(B1, 1, 1); PG8_STAGE(PG8_SB(1, 0), b3, voffB);
            PG8_BAR; PG8_WAIT_L(0); PG8_MMA(0, 1, At, B1); PG8_BAR;
            PG8_LDA(At, 1, 1); PG8_STAGE(PG8_SA(1, 0), a3, voffA);
            PG8_BAR; PG8_WAIT_L(0); PG8_MMA(1, 0, At, B0); PG8_BAR; PG8_SCHED;
            PG8_STAGE(PG8_SB(1, 1), b3 + hstep, voffB);
            PG8_WAIT_V(6); PG8_BAR; PG8_MMA(1, 1, At, B1); PG8_BAR;
            }
        }
        if constexpr (ALIGN_EPI) { if (wr == 0) PG8_BAR; }
        E(acc, cur, wr, wc, fr, fq);
        if (!has_next) break;
#pragma unroll
        for (int a = 0; a < 2; ++a)
#pragma unroll
            for (int b = 0; b < 2; ++b)
#pragma unroll
                for (int m = 0; m < 4; ++m)
#pragma unroll
                    for (int n = 0; n < 2; ++n) acc[a][b][m][n] = (f32x4){0.f, 0.f, 0.f, 0.f};
        cur = nxt; cA = nA; cB = nB; ++ui;
        H.begin(cur, lds);
        if constexpr (ALIGN_EPI) { if (wr == 1) PG8_BAR; }
    }
    PG8_WAIT_V(0);
    if constexpr (!ALIGN_EPI) { if (wr == 0) PG8_BAR; }
    PG8_BAR;
#undef PG8_SA
#undef PG8_SB
#undef PG8_STAGE
#undef PG8_LDA
#undef PG8_LDB
#undef PG8_MMA
#undef PG8_WAIT_V
#undef PG8_WAIT_L
#undef PG8_BAR
#undef PG8_SCHED
}
}

struct EpiIn0 {
    static constexpr bool PERM = true;
    bf16_t *Y0, *XBC, *Q0, *K0, *V0; const float* rstd; float* kpart;
    __device__ __forceinline__ void operator()(const f32x4 (&acc)[2][2][4][2], const pg8::Unit& u, int wr, int wc, int fr, int fq) const {
        const int pn = u.pn; bf16_t* base; int ld, colt, mode;
        if (pn < 8) { base = Y0; ld = 2048; colt = pn * 256; mode = 1; }
        else if (pn < 14) { base = XBC; ld = 1536; colt = (pn - 8) * 256; mode = 0; }
        else if (pn < 18) { base = Q0; ld = 1024; colt = (pn - 14) * 256; mode = 2; }
        else if (pn < 22) { base = K0; ld = 1024; colt = (pn - 18) * 256; mode = 3; }
        else { base = V0; ld = 1024; colt = (pn - 22) * 256; mode = 0; }
        const int row0 = u.pm * 256 + wr * 64 + fr, col0 = colt + wc * 32 + 8 * fq;
        float cs[2][8];
#pragma unroll
        for (int bj = 0; bj < 2; ++bj)
#pragma unroll
            for (int e = 0; e < 8; ++e) cs[bj][e] = 0.f;
#pragma unroll
        for (int ai = 0; ai < 2; ++ai)
#pragma unroll
            for (int m = 0; m < 4; ++m) {
                const int row = row0 + ai * 128 + m * 16; const float rs = rstd[row]; bf16_t* rowp = base + (size_t)row * ld + col0;
#pragma unroll
                for (int bj = 0; bj < 2; ++bj) {
                    float v[8];
#pragma unroll
                    for (int e = 0; e < 4; ++e) { v[e] = acc[ai][bj][m][0][e] * rs; v[4 + e] = acc[ai][bj][m][1][e] * rs; }
                    if (mode == 1) {
#pragma unroll
                        for (int e = 0; e < 8; ++e) v[e] = silu_f(v[e]);
                    } else if (mode == 2) {
#pragma unroll
                        for (int e = 0; e < 8; ++e) v[e] *= QSCALE;
                    } else if (mode == 3) {
#pragma unroll
                        for (int e = 0; e < 8; ++e) cs[bj][e] += v[e];
                    }
                    u32x4 w; w.x = pk2(v[0], v[1]); w.y = pk2(v[2], v[3]); w.z = pk2(v[4], v[5]); w.w = pk2(v[6], v[7]);
                    *(u32x4*)(rowp + bj * 128) = w;
                }
            }
        if (mode == 3) {
#pragma unroll
            for (int bj = 0; bj < 2; ++bj)
#pragma unroll
                for (int e = 0; e < 8; ++e) { float s = cs[bj][e]; s += __shfl_xor(s, 1); s += __shfl_xor(s, 2); s += __shfl_xor(s, 4); s += __shfl_xor(s, 8); cs[bj][e] = s; }
            if (fr == 0) {
                float* kp = kpart + ((size_t)u.pm * 2 + wr) * 1024 + col0;
#pragma unroll
                for (int bj = 0; bj < 2; ++bj) { *(f32x4*)(kp + bj * 128) = (f32x4){cs[bj][0], cs[bj][1], cs[bj][2], cs[bj][3]}; *(f32x4*)(kp + bj * 128 + 4) = (f32x4){cs[bj][4], cs[bj][5], cs[bj][6], cs[bj][7]}; }
            }
        }
    }
};
struct EpiRes {
    static constexpr bool PERM = false;
    const float* xi; float* xo; bf16_t* xb; float* rsq;
    __device__ __forceinline__ void operator()(const f32x4 (&acc)[2][2][4][2], const pg8::Unit& u, int wr, int wc, int fr, int fq) const {
        const int col0 = u.pn * 256 + wc * 32 + 4 * fq;
#pragma unroll
        for (int ai = 0; ai < 2; ++ai)
#pragma unroll
            for (int m = 0; m < 4; ++m) {
                const int row = u.pm * 256 + ai * 128 + wr * 64 + m * 16 + fr; const size_t off = (size_t)row * DM + col0; float ss = 0.f;
#pragma unroll
                for (int bj = 0; bj < 2; ++bj)
#pragma unroll
                    for (int n = 0; n < 2; ++n) {
                        const f32x4 b = *(const f32x4*)(xi + off + bj * 128 + n * 16); const f32x4 o = b + acc[ai][bj][m][n];
                        *(f32x4*)(xo + off + bj * 128 + n * 16) = o; ss += (o[0] * o[0] + o[1] * o[1]) + (o[2] * o[2] + o[3] * o[3]);
                        if (xb) { u32x2 w; w.x = pk2(o[0], o[1]); w.y = pk2(o[2], o[3]); *(u32x2*)(xb + off + bj * 128 + n * 16) = w; }
                    }
                ss += __shfl_xor(ss, 16); ss += __shfl_xor(ss, 32);
                if (fq == 0) rsq[(size_t)row * 16 + u.pn * 4 + wc] = ss;
            }
    }
};
__device__ __forceinline__ float rstd_from16(const float* p) {
    const f32x4 a = *(const f32x4*)p, b = *(const f32x4*)(p + 4), c = *(const f32x4*)(p + 8), d = *(const f32x4*)(p + 12);
    const float s = ((a[0] + a[1]) + (a[2] + a[3])) + ((b[0] + b[1]) + (b[2] + b[3])) + ((c[0] + c[1]) + (c[2] + c[3])) + ((d[0] + d[1]) + (d[2] + d[3]));
    return 1.0f / sqrtf(s * (1.0f / 1024.0f) + NORM_EPS);
}
struct EpiQkv1 {
    static constexpr bool PERM = true;
    bf16_t* O; size_t split_stride; const float* rsq;
    __device__ __forceinline__ void operator()(const f32x4 (&acc)[2][2][4][2], const pg8::Unit& u, int wr, int wc, int fr, int fq) const {
        const int t = u.pn >> 3; bf16_t* base = O + (size_t)t * split_stride; const int colt = (u.pn & 7) * 256; const float sc = (t == 0) ? QSCALE : 1.0f;
        const int row0 = u.pm * 256 + wr * 64 + fr, col0 = colt + wc * 32 + 8 * fq;
#pragma unroll
        for (int ai = 0; ai < 2; ++ai)
#pragma unroll
            for (int m = 0; m < 4; ++m) {
                const int row = row0 + ai * 128 + m * 16; const float rs = rstd_from16(rsq + (size_t)row * 16) * sc; bf16_t* rowp = base + (size_t)row * 2048 + col0;
#pragma unroll
                for (int bj = 0; bj < 2; ++bj) { const f32x4 v0 = acc[ai][bj][m][0] * rs, v1 = acc[ai][bj][m][1] * rs;
                    u32x4 w; w.x = pk2(v0[0], v0[1]); w.y = pk2(v0[2], v0[3]); w.z = pk2(v1[0], v1[1]); w.w = pk2(v1[2], v1[3]); *(u32x4*)(rowp + bj * 128) = w; }
            }
    }
};
struct EpiGate1 {
    static constexpr bool PERM = true;
    bf16_t* O; const float* rsq;
    __device__ __forceinline__ void operator()(const f32x4 (&acc)[2][2][4][2], const pg8::Unit& u, int wr, int wc, int fr, int fq) const {
        const int row0 = u.pm * 256 + wr * 64 + fr, col0 = u.pn * 256 + wc * 32 + 8 * fq;
#pragma unroll
        for (int ai = 0; ai < 2; ++ai)
#pragma unroll
            for (int m = 0; m < 4; ++m) {
                const int row = row0 + ai * 128 + m * 16; const float rs = rstd_from16(rsq + (size_t)row * 16); bf16_t* rowp = O + (size_t)row * 2048 + col0;
#pragma unroll
                for (int bj = 0; bj < 2; ++bj) { const f32x4 v0 = acc[ai][bj][m][0] * rs, v1 = acc[ai][bj][m][1] * rs; const u32x4 o = *(const u32x4*)(rowp + bj * 128);
                    u32x4 w; w.x = pk2(bf_lo(o.x) * silu_f(v0[0]), bf_hi(o.x) * silu_f(v0[1])); w.y = pk2(bf_lo(o.y) * silu_f(v0[2]), bf_hi(o.y) * silu_f(v0[3]));
                    w.z = pk2(bf_lo(o.z) * silu_f(v1[0]), bf_hi(o.z) * silu_f(v1[1])); w.w = pk2(bf_lo(o.w) * silu_f(v1[2]), bf_hi(o.w) * silu_f(v1[3])); *(u32x4*)(rowp + bj * 128) = w; }
            }
    }
};
struct HookSsdNorm {
    const float* ssq;
    __device__ __forceinline__ void begin(const pg8::Unit& u, LAS unsigned char* lds) const {
        LAS float* T = (LAS float*)(lds + RING_BYTES);
        const int t = threadIdx.x;
        if (t < 256) { const float* p = ssq + (size_t)(u.pm * 256 + t) * 16; const f32x4 a = *(const f32x4*)p, b = *(const f32x4*)(p + 4), c = *(const f32x4*)(p + 8), d = *(const f32x4*)(p + 12);
            const float g0 = ((a[0] + a[1]) + (a[2] + a[3])) + ((b[0] + b[1]) + (b[2] + b[3])), g1 = ((c[0] + c[1]) + (c[2] + c[3])) + ((d[0] + d[1]) + (d[2] + d[3]));
            const float r0 = 1.0f / sqrtf(g0 * (1.0f / 512.0f) + NORM_EPS), r1 = 1.0f / sqrtf(g1 * (1.0f / 512.0f) + NORM_EPS);
            T[2 * t] = r0 / r1; T[2 * t + 1] = r1; }
    }
    __device__ __forceinline__ void at(f32x4 (&acc)[2][2][4][2], int t, int wr, int fr, LAS unsigned char* lds) const {
        if (t == 8 || t == 16) {
            const LAS float* T = (const LAS float*)(lds + RING_BYTES); const int sel = (t == 16);
#pragma unroll
            for (int ai = 0; ai < 2; ++ai)
#pragma unroll
                for (int m = 0; m < 4; ++m) { const float f = T[2 * (ai * 128 + wr * 64 + m * 16 + fr) + sel];
#pragma unroll
                    for (int bj = 0; bj < 2; ++bj)
#pragma unroll
                        for (int n = 0; n < 2; ++n) acc[ai][bj][m][n] = acc[ai][bj][m][n] * f; }
        }
    }
};

__device__ __forceinline__ void transpose_item(const float* W, int K, int Nsrc, int src_col0, bf16_t* WT, int dst_row0, const float* gain, int gain_n, LAS float* scr, int kb, int nb, int lane) {
    const int k0 = 64 * kb, n0 = 32 * nb;
    float wv[32];
#pragma unroll
    for (int i = 0; i < 32; ++i) wv[i] = W[(size_t)(k0 + 2 * i + (lane >> 5)) * Nsrc + src_col0 + n0 + (lane & 31)];
#pragma unroll
    for (int i = 0; i < 32; ++i) { const int kk = 2 * i + (lane >> 5); const int k = k0 + kk; const float gsc = (gain && k < gain_n) ? gain[k] : 1.0f;
        scr[kk * 33 + (lane & 31)] = wv[i] * gsc; }
    asm volatile("s_waitcnt lgkmcnt(0)" ::: "memory");
    const int c = lane & 7;
#pragma unroll
    for (int j = 0; j < 4; ++j) { const int n = (lane >> 3) + 8 * j; const LAS float* s = scr + (8 * c) * 33 + n;
        u32x4 o; o.x = pk2(s[0 * 33], s[1 * 33]); o.y = pk2(s[2 * 33], s[3 * 33]); o.z = pk2(s[4 * 33], s[5 * 33]); o.w = pk2(s[6 * 33], s[7 * 33]);
        *(u32x4*)(WT + (size_t)(dst_row0 + n0 + n) * K + k0 + 8 * c) = o; }
    asm volatile("s_waitcnt lgkmcnt(0)" ::: "memory");
}
__device__ __forceinline__ float softplus_f(float v) { return v > 20.f ? v : log1pf(expf(v)); }

__device__ __forceinline__ void phase_prep(const Params& P, LAS unsigned char* lds, int G) {
    const int tid = threadIdx.x, lane = tid & 63, wave = tid >> 6;
    const int gw = blockIdx.x * 8 + wave, NGW = G * 8;
    unsigned char* ws = P.ws;
    if (blockIdx.x == 0 && tid < 256) ((unsigned*)(ws + WS_CTL))[tid] = 0u;
    {
        LAS float* scr = (LAS float*)(lds + wave * 16384);
        bf16_t* W0T = (bf16_t*)(ws + WS_W0T); bf16_t* WO0T = (bf16_t*)(ws + WS_WO0T); bf16_t* W1T = (bf16_t*)(ws + WS_W1T); bf16_t* WO1T = (bf16_t*)(ws + WS_WO1T);
        constexpr int I0 = 16 * 208, IO0 = 32 * 32, I1 = 16 * 256, IO1 = 32 * 32;
        for (int it = gw; it < I0 + IO0 + I1 + IO1; it += NGW) {
            int r = it;
            if (r < I0) { const int kb = r / 208, nb = r % 208; const int n0 = nb * 32;
                int src; if (n0 < 1024) src = n0; else if (n0 < 2048) src = n0 - 1024 + 5648; else if (n0 < 3584) src = n0 - 2048 + 1024; else src = n0 - 3584 + 2576;
                transpose_item(P.w_in0, 1024, EVEN_IN, src - n0, W0T, 0, P.even_norm, 1024, scr, kb, nb, lane); continue; }
            r -= I0;
            if (r < IO0) { transpose_item(P.w_out0, 2048, 1024, 0, WO0T, 0, P.ssd_norm, 1024, scr, r / 32, r % 32, lane); continue; }
            r -= IO0;
            if (r < I1) { transpose_item(P.w_in1, 1024, 8192, 0, W1T, 0, P.odd_norm, 1024, scr, r / 256, r % 256, lane); continue; }
            r -= I1;
            transpose_item(P.w_out1, 2048, 1024, 0, WO1T, 0, nullptr, 0, scr, r / 32, r % 32, lane);
        }
    }
    __syncthreads();
    {
        LAS float* Wd = (LAS float*)lds;
        for (int i = tid; i < 16 * 1024; i += NTHREADS) { const int k = i >> 4, h = i & 15; Wd[h * 1024 + k] = P.w_in0[(size_t)k * EVEN_IN + 2560 + h] * P.even_norm[k]; }
        __syncthreads();
        bf16_t* xb = (bf16_t*)P.out; float* rstd0 = (float*)(ws + WS_RSTD0); float* dt = (float*)(ws + WS_DT);
        for (int m = gw; m < MTOK; m += NGW) {
            const f32x4* xr = (const f32x4*)(P.x + (size_t)m * DM) + lane;
            f32x4 v[4]; float s = 0.f;
#pragma unroll
            for (int j = 0; j < 4; ++j) { v[j] = xr[64 * j]; s += (v[j][0] * v[j][0] + v[j][1] * v[j][1]) + (v[j][2] * v[j][2] + v[j][3] * v[j][3]); }
            const float rs = 1.0f / sqrtf(wave_sum(s) * (1.0f / DM) + NORM_EPS);
            unsigned long long* o8 = (unsigned long long*)(xb + (size_t)m * DM) + lane;
#pragma unroll
            for (int j = 0; j < 4; ++j) o8[64 * j] = (unsigned long long)pk2(v[j][0], v[j][1]) | ((unsigned long long)pk2(v[j][2], v[j][3]) << 32);
            float mine = 0.f;
#pragma unroll 1
            for (int h = 0; h < 16; ++h) { float a = 0.f;
#pragma unroll
                for (int j = 0; j < 4; ++j) { const f32x4 w = *(const LAS f32x4*)(Wd + h * 1024 + 256 * j + 4 * lane); a += (v[j][0] * w[0] + v[j][1] * w[1]) + (v[j][2] * w[2] + v[j][3] * w[3]); }
                a = wave_sum(a); if (lane == h) mine = a; }
            if (lane == 0) rstd0[m] = rs;
            if (lane < 16) dt[(size_t)m * 16 + lane] = softplus_f(mine * rs + P.dt_bias[lane]);
        }
    }
}

__device__ __forceinline__ void ssd_item(const Params& P, LAS unsigned char* lds, int b, int h) {
    constexpr int TT = 64;
    const int tid = threadIdx.x;
    unsigned char* ws = P.ws;
    const bf16_t* XBC = (const bf16_t*)(ws + WS_XBC); bf16_t* Y0 = (bf16_t*)(ws + WS_Y0); const float* dt = (const float*)(ws + WS_DT); float* ssq = (float*)(ws + WS_SSQ);
    LAS float* xc = (LAS float*)lds;
    LAS float* Bc = xc + TT * 64;
    LAS float* Cc = Bc + TT * 128;
    LAS float* zs = Cc + TT * 128;
    LAS float* uo = zs + TT * 64;
    LAS float* dtv = uo + TT * 64;
    LAS float* dec = dtv + TT;
    const int g = h >> 3;
    const float a = -expf(P.a_log[h]), Dh = P.d_skip[h];
    const int p = tid >> 3, ng = tid & 7;
    float st[16];
#pragma unroll
    for (int i = 0; i < 16; ++i) st[i] = 0.f;
    int ch = 0; float cw0 = 0.f, cw1 = 0.f, cw2 = 0.f, cw3 = 0.f, cb = 0.f;
    if (tid < 320) { ch = tid < 64 ? h * 64 + tid : (tid < 192 ? 1024 + g * 128 + (tid - 64) : 1280 + g * 128 + (tid - 192));
        cw0 = P.conv_w[ch]; cw1 = P.conv_w[1536 + ch]; cw2 = P.conv_w[2 * 1536 + ch]; cw3 = P.conv_w[3 * 1536 + ch]; cb = P.conv_b[ch]; }
    for (int t0 = 0; t0 < SEQ; t0 += TT) {
        const size_t tok0 = (size_t)b * SEQ + t0;
        if (tid < 320) {
            float w0 = 0.f, w1 = 0.f, w2 = 0.f;
            if (t0 > 0) { w0 = bf2f(XBC[(tok0 - 3) * 1536 + ch]); w1 = bf2f(XBC[(tok0 - 2) * 1536 + ch]); w2 = bf2f(XBC[(tok0 - 1) * 1536 + ch]); }
            LAS float* dst = tid < 64 ? xc + tid : (tid < 192 ? Bc + (tid - 64) : Cc + (tid - 192)); const int dstride = tid < 64 ? 64 : 128;
            for (int tt = 0; tt < TT; ++tt) { const float w3 = bf2f(XBC[(tok0 + tt) * 1536 + ch]);
                const float v = cb + cw0 * w0 + cw1 * w1 + cw2 * w2 + cw3 * w3; dst[tt * dstride] = silu_f(v); w0 = w1; w1 = w2; w2 = w3; }
        } else if (tid < 320 + TT) { const int tt = tid - 320; const float d = dt[(tok0 + tt) * 16 + h]; dtv[tt] = d; dec[tt] = expf(d * a); }
        for (int i = tid; i < TT * 64; i += NTHREADS) { const int tt = i >> 6, pp = i & 63; zs[i] = bf2f(Y0[(tok0 + tt) * 2048 + h * 64 + pp]); }
        __syncthreads();
        for (int tt = 0; tt < TT; ++tt) {
            const float xv = xc[tt * 64 + p], xdt = xv * dtv[tt], dc = dec[tt];
            const LAS float* Bp = Bc + tt * 128 + 16 * ng; const LAS float* Cp = Cc + tt * 128 + 16 * ng;
            float yp = 0.f;
#pragma unroll
            for (int i = 0; i < 16; ++i) { st[i] = st[i] * dc + xdt * Bp[i]; yp += st[i] * Cp[i]; }
            yp += __shfl_xor(yp, 1); yp += __shfl_xor(yp, 2); yp += __shfl_xor(yp, 4);
            if (ng == 0) uo[tt * 64 + p] = (yp + Dh * xv) * zs[tt * 64 + p];
        }
        __syncthreads();
        { const int tt = tid >> 3, part = tid & 7; const LAS float* up = uo + tt * 64 + part * 8; float v[8]; float ss = 0.f;
#pragma unroll
            for (int e = 0; e < 8; ++e) { v[e] = up[e]; ss += v[e] * v[e]; }
            u32x4 w; w.x = pk2(v[0], v[1]); w.y = pk2(v[2], v[3]); w.z = pk2(v[4], v[5]); w.w = pk2(v[6], v[7]);
            *(u32x4*)(Y0 + (tok0 + tt) * 2048 + h * 64 + part * 8) = w;
            ss += __shfl_xor(ss, 1); ss += __shfl_xor(ss, 2); ss += __shfl_xor(ss, 4);
            if (part == 0) ssq[(tok0 + tt) * 16 + h] = ss; }
        __syncthreads();
    }
}

struct KeysDilated {
    __device__ __forceinline__ int nkeys(int) const { return 387; }
    __device__ __forceinline__ int keypos(int qpos, int idx) const { const int pt = idx / 129, j = idx - pt * 129; return qpos - (j << (2 * pt)); }
};
struct KeysMoba {
    const LAS int* sel;
    int q0;
    __device__ __forceinline__ int nkeys(int qpos) const { return sel[(qpos - q0) * 4] * 256 + (qpos & 255) + 1; }
    __device__ __forceinline__ int keypos(int qpos, int idx) const { const LAS int* s = sel + (qpos - q0) * 4; const int ns = s[0];
        if (idx < ns * 256) return s[1 + (idx >> 8)] * 256 + (idx & 255);
        return (qpos & ~255) + (idx - ns * 256); }
};
template <class KS>
__device__ __forceinline__ void attn_simple_core(const KS& ks, LAS float* qs, LAS float* Ssc, const bf16_t* Kp, const bf16_t* Vp, int ld, int q0, float (&o)[8], float& lsum) {
    const int tid = threadIdx.x, qi = tid >> 4, part = tid & 15;
    const int qpos = q0 + qi, nk = ks.nkeys(qpos);
    LAS float* Sr = Ssc + qi * 1024; const LAS float* qr = qs + qi * 128;
    float mx = -3.0e38f;
    for (int idx = part; idx < nk; idx += 16) {
        const int pos = ks.keypos(qpos, idx); float s = -__builtin_inff();
        if (pos >= 0) { const u32x4* kr = (const u32x4*)(Kp + (size_t)pos * ld); float a = 0.f;
#pragma unroll
            for (int c = 0; c < 16; ++c) { const u32x4 w = kr[c]; const f32x4 q0v = *(const LAS f32x4*)(qr + 8 * c), q1v = *(const LAS f32x4*)(qr + 8 * c + 4);
                a += (bf_lo(w.x) * q0v[0] + bf_hi(w.x) * q0v[1]) + (bf_lo(w.y) * q0v[2] + bf_hi(w.y) * q0v[3]) + (bf_lo(w.z) * q1v[0] + bf_hi(w.z) * q1v[1]) + (bf_lo(w.w) * q1v[2] + bf_hi(w.w) * q1v[3]); }
            s = a; }
        Sr[idx] = s; mx = fmaxf(mx, s);
    }
    mx = fmaxf(mx, __shfl_xor(mx, 1)); mx = fmaxf(mx, __shfl_xor(mx, 2)); mx = fmaxf(mx, __shfl_xor(mx, 4)); mx = fmaxf(mx, __shfl_xor(mx, 8));
    float l = 0.f;
    for (int idx = part; idx < nk; idx += 16) { const float pv = exp2f(Sr[idx] - mx); Sr[idx] = pv; l += pv; }
    l += __shfl_xor(l, 1); l += __shfl_xor(l, 2); l += __shfl_xor(l, 4); l += __shfl_xor(l, 8);
    lsum = l;
    asm volatile("s_waitcnt lgkmcnt(0)" ::: "memory");
    __syncthreads();
#pragma unroll
    for (int e = 0; e < 8; ++e) o[e] = 0.f;
    for (int idx = 0; idx < nk; ++idx) {
        const float pv = Sr[idx];
        if (pv != 0.f) { const int pos = ks.keypos(qpos, idx); const u32x4 w = *(const u32x4*)(Vp + (size_t)pos * ld + 8 * part);
            o[0] += pv * bf_lo(w.x); o[1] += pv * bf_hi(w.x); o[2] += pv * bf_lo(w.y); o[3] += pv * bf_hi(w.y); o[4] += pv * bf_lo(w.z); o[5] += pv * bf_hi(w.z); o[6] += pv * bf_lo(w.w); o[7] += pv * bf_hi(w.w); }
    }
}
__device__ __forceinline__ void load_q_tile(LAS float* qs, const bf16_t* Qp, int ld) {
    const int tid = threadIdx.x, r = tid >> 4, c = tid & 15;
    const u32x4 w = *(const u32x4*)(Qp + (size_t)r * ld + 8 * c); LAS float* d = qs + r * 128 + 8 * c;
    d[0] = bf_lo(w.x); d[1] = bf_hi(w.x); d[2] = bf_lo(w.y); d[3] = bf_hi(w.y); d[4] = bf_lo(w.z); d[5] = bf_hi(w.z); d[6] = bf_lo(w.w); d[7] = bf_hi(w.w);
}
__device__ __forceinline__ void moba_item(const Params& P, LAS unsigned char* lds, int b, int h, int qt) {
    unsigned char* ws = P.ws; const int tid = threadIdx.x;
    LAS float* Ssc = (LAS float*)lds; LAS float* qs = (LAS float*)(lds + 131072); LAS float* gts = (LAS float*)(lds + 131072 + 16384); LAS int* sel = (LAS int*)(lds + 131072 + 16384 + 1024);
    const bf16_t* Q0 = (const bf16_t*)(ws + WS_Q0) + (size_t)b * SEQ * 1024 + h * 128; const bf16_t* K0 = (const bf16_t*)(ws + WS_K0) + (size_t)b * SEQ * 1024 + h * 128;
    const bf16_t* V0 = (const bf16_t*)(ws + WS_V0) + (size_t)b * SEQ * 1024 + h * 128; bf16_t* Y0 = (bf16_t*)(ws + WS_Y0) + (size_t)b * SEQ * 2048 + 1024 + h * 128;
    const float* kpart = (const float*)(ws + WS_KPART);
    const int q0 = qt * 32, qb = q0 >> 8;
    __syncthreads();
    load_q_tile(qs, Q0 + (size_t)q0 * 1024, 1024);
    __syncthreads();
    { const int qi = tid >> 4, n = tid & 15;
        if (n < qb) { const float* k0p = kpart + ((size_t)(b * 8 + n) * 2) * 1024 + h * 128; const float* k1p = k0p + 1024; float a = 0.f;
            for (int d = 0; d < 128; ++d) a += qs[qi * 128 + d] * (k0p[d] + k1p[d]);
            gts[qi * 8 + n] = a; } }
    __syncthreads();
    if (tid < 32) { const int ns = qb < 3 ? qb : 3; int s0 = -1, s1 = -1, s2 = -1; float g0 = -__builtin_inff(), g1 = g0, g2 = g0;
        for (int n = 0; n < qb; ++n) { const float gv = gts[tid * 8 + n];
            if (gv > g0) { g2 = g1; s2 = s1; g1 = g0; s1 = s0; g0 = gv; s0 = n; } else if (gv > g1) { g2 = g1; s2 = s1; g1 = gv; s1 = n; } else if (gv > g2) { g2 = gv; s2 = n; } }
        sel[tid * 4] = ns; sel[tid * 4 + 1] = s0 < 0 ? 0 : s0; sel[tid * 4 + 2] = s1 < 0 ? 0 : s1; sel[tid * 4 + 3] = s2 < 0 ? 0 : s2; }
    __syncthreads();
    KeysMoba ks{sel, q0}; float o[8]; float l;
    attn_simple_core(ks, qs, Ssc, K0, V0, 1024, q0, o, l);
    const int qi = tid >> 4, part = tid & 15; const float inv = 1.0f / l;
    bf16_t* yp = Y0 + (size_t)(q0 + qi) * 2048 + 8 * part; const u32x4 gw = *(const u32x4*)yp;
    u32x4 w; w.x = pk2(o[0] * inv * bf_lo(gw.x), o[1] * inv * bf_hi(gw.x)); w.y = pk2(o[2] * inv * bf_lo(gw.y), o[3] * inv * bf_hi(gw.y));
    w.z = pk2(o[4] * inv * bf_lo(gw.z), o[5] * inv * bf_hi(gw.z)); w.w = pk2(o[6] * inv * bf_lo(gw.w), o[7] * inv * bf_hi(gw.w));
    *(u32x4*)yp = w;
}
__device__ __forceinline__ void dilated_item(const Params& P, LAS unsigned char* lds, int b, int h, int qt) {
    unsigned char* ws = P.ws; const int tid = threadIdx.x;
    LAS float* Ssc = (LAS float*)lds; LAS float* qs = (LAS float*)(lds + 131072);
    bf16_t* Q1 = (bf16_t*)(ws + WS_QO1) + (size_t)b * SEQ * 2048 + h * 128; const bf16_t* K1 = (const bf16_t*)(ws + WS_K1) + (size_t)b * SEQ * 2048 + h * 128;
    const bf16_t* V1 = (const bf16_t*)(ws + WS_V1) + (size_t)b * SEQ * 2048 + h * 128;
    const int q0 = qt * 32;
    __syncthreads();
    load_q_tile(qs, Q1 + (size_t)q0 * 2048, 2048);
    __syncthreads();
    KeysDilated ks; float o[8]; float l;
    attn_simple_core(ks, qs, Ssc, K1, V1, 2048, q0, o, l);
    const int qi = tid >> 4, part = tid & 15; const float inv = 1.0f / l;
    u32x4 w; w.x = pk2(o[0] * inv, o[1] * inv); w.y = pk2(o[2] * inv, o[3] * inv); w.z = pk2(o[4] * inv, o[5] * inv); w.w = pk2(o[6] * inv, o[7] * inv);
    *(u32x4*)(Q1 + (size_t)(q0 + qi) * 2048 + 8 * part) = w;
}

typedef short s16x4 __attribute__((ext_vector_type(4)));
constexpr int KSTR = 272, VSTR = 288;
#define MFMA16(a, b, c) __builtin_amdgcn_mfma_f32_16x16x32_bf16((a), (b), (c), 0, 0, 0)
struct WTile { bf16x8 qf[4]; f32x4 o[8]; float m, l; };
__device__ __forceinline__ void wt_reset(WTile& w) {
#pragma unroll
    for (int d = 0; d < 8; ++d) w.o[d] = (f32x4){0.f, 0.f, 0.f, 0.f};
    w.m = -1.0e30f; w.l = 0.f;
}
__device__ __forceinline__ void wt_load_q(WTile& w, const bf16_t* qrow, int lane) {
    const int g = lane >> 4;
#pragma unroll
    for (int ks = 0; ks < 4; ++ks) w.qf[ks] = *(const bf16x8*)(qrow + 32 * ks + 8 * g);
}
__device__ __forceinline__ void wt_qk_lds(const WTile& w, const LAS unsigned char* Kb, int lane, f32x4& s0, f32x4& s1) {
    const LAS unsigned char* p = Kb + (lane & 15) * KSTR + (lane >> 4) * 16;
    s0 = (f32x4){0.f, 0.f, 0.f, 0.f}; s1 = s0;
#pragma unroll
    for (int ks = 0; ks < 4; ++ks) { const bf16x8 a0 = *(const LAS bf16x8*)(p + ks * 64), a1 = *(const LAS bf16x8*)(p + 16 * KSTR + ks * 64);
        s0 = MFMA16(a0, w.qf[ks], s0); s1 = MFMA16(a1, w.qf[ks], s1); }
}
__device__ __forceinline__ void wt_softmax_pv(WTile& w, f32x4 s0, f32x4 s1, const LAS unsigned char* Vb, int lane) {
    float mx = fmaxf(fmaxf(fmaxf(s0[0], s0[1]), fmaxf(s0[2], s0[3])), fmaxf(fmaxf(s1[0], s1[1]), fmaxf(s1[2], s1[3])));
    mx = fmaxf(mx, __shfl_xor(mx, 16)); mx = fmaxf(mx, __shfl_xor(mx, 32));
    const float mn = fmaxf(w.m, mx), alpha = __builtin_amdgcn_exp2f(w.m - mn);
    w.m = mn;
    float p[8];
#pragma unroll
    for (int r = 0; r < 4; ++r) { p[r] = __builtin_amdgcn_exp2f(s0[r] - mn); p[4 + r] = __builtin_amdgcn_exp2f(s1[r] - mn); }
    w.l = w.l * alpha + (((p[0] + p[1]) + (p[2] + p[3])) + ((p[4] + p[5]) + (p[6] + p[7])));
    u32x4 pw; pw.x = pk2(p[0], p[1]); pw.y = pk2(p[2], p[3]); pw.z = pk2(p[4], p[5]); pw.w = pk2(p[6], p[7]);
    const bf16x8 pf = __builtin_bit_cast(bf16x8, pw);
    const int i = lane & 15, g = lane >> 4;
    const LAS unsigned char* vp = Vb + (4 * g + (i >> 2)) * VSTR + (i & 3) * 8;
#pragma unroll
    for (int dt = 0; dt < 8; ++dt) {
        const s16x4 lo = __builtin_amdgcn_ds_read_tr16_b64_v4i16((LAS s16x4*)(vp + dt * 32));
        const s16x4 hi = __builtin_amdgcn_ds_read_tr16_b64_v4i16((LAS s16x4*)(vp + 16 * VSTR + dt * 32));
        const bf16x8 vf = __builtin_shufflevector(lo, hi, 0, 1, 2, 3, 4, 5, 6, 7);
        w.o[dt] = MFMA16(vf, pf, w.o[dt] * alpha);
    }
}

__device__ __forceinline__ void conv_prepass(const Params& P, int G) {
    const bf16_t* XBC = (const bf16_t*)(P.ws + WS_XBC); bf16_t* XC = (bf16_t*)P.out;
    const int ntask = 192 * 1024;
    for (int task = blockIdx.x * NTHREADS + threadIdx.x; task < ntask; task += G * NTHREADS) {
        const int cg8 = task % 192, run = task / 192, ch = 8 * cg8; const size_t tok0 = (size_t)run * 16; const bool first = (run & 127) == 0;
        u32x4 raw[19];
#pragma unroll
        for (int j = 0; j < 19; ++j) { raw[j] = (u32x4){0u, 0u, 0u, 0u}; if (j >= 3 || !first) raw[j] = *(const u32x4*)(XBC + (tok0 + j - 3) * 1536 + ch); }
        float cw[4][8], cb[8];
#pragma unroll
        for (int j = 0; j < 4; ++j) { const f32x4 a = *(const f32x4*)(P.conv_w + j * 1536 + ch), b2 = *(const f32x4*)(P.conv_w + j * 1536 + ch + 4);
#pragma unroll
            for (int e = 0; e < 4; ++e) { cw[j][e] = a[e]; cw[j][4 + e] = b2[e]; } }
        { const f32x4 a = *(const f32x4*)(P.conv_b + ch), b2 = *(const f32x4*)(P.conv_b + ch + 4);
#pragma unroll
            for (int e = 0; e < 4; ++e) { cb[e] = a[e]; cb[4 + e] = b2[e]; } }
#pragma unroll
        for (int tt = 0; tt < 16; ++tt) { float o[8];
#pragma unroll
            for (int e = 0; e < 8; ++e) { float acc = cb[e];
#pragma unroll
                for (int j = 0; j < 4; ++j) { const unsigned wq = (e < 2) ? raw[tt + j].x : (e < 4 ? raw[tt + j].y : (e < 6 ? raw[tt + j].z : raw[tt + j].w)); acc += cw[j][e] * ((e & 1) ? bf_hi(wq) : bf_lo(wq)); }
                o[e] = silu_f(acc); }
            u32x4 w; w.x = pk2(o[0], o[1]); w.y = pk2(o[2], o[3]); w.z = pk2(o[4], o[5]); w.w = pk2(o[6], o[7]);
            *(u32x4*)(XC + (tok0 + tt) * 1536 + ch) = w; }
    }
}

constexpr int SI_B = 0, SI_C = 34816, SI_XT = 69632, SI_PREV = 87040, SI_ARR = 121856, SI_STR = 272;
__device__ __forceinline__ void ssd_item_mfma(const Params& P, LAS unsigned char* lds, int b, int h) {
    int tid_ = threadIdx.x; asm volatile("" : "+v"(tid_));
    const int tid = tid_, lane = tid & 63, w = __builtin_amdgcn_readfirstlane(tid >> 6), i = lane & 15, g = lane >> 4;
    unsigned char* ws = P.ws;
    const bf16_t* XBC = (const bf16_t*)(ws + WS_XBC); bf16_t* Y0 = (bf16_t*)(ws + WS_Y0); const float* dtg = (const float*)(ws + WS_DT); float* ssq = (float*)(ws + WS_SSQ);
    LAS unsigned char* Bi = lds + SI_B; LAS unsigned char* Ci = lds + SI_C; LAS unsigned char* XT = lds + SI_XT;
    LAS float* A2 = (LAS float*)(lds + SI_ARR); LAS float* A3 = A2 + 128; LAS float* WL = A2 + 256; LAS float* EL = A2 + 384; LAS float* CD = A2 + 512;
    const int grp = h >> 3;
    const float a2 = -expf(P.a_log[h]) * 1.4426950408889634f, Dh = P.d_skip[h];
    const bf16_t* XC = (const bf16_t*)P.out;
    f32x4 carry[4];
#pragma unroll
    for (int pt = 0; pt < 4; ++pt) carry[pt] = (f32x4){0.f, 0.f, 0.f, 0.f};
    __syncthreads();
#pragma unroll 1
    for (int c = 0; c < 16; ++c) {
        const size_t tok0 = (size_t)b * SEQ + c * 128;
        {
            const int r0 = tid >> 4, c16 = tid & 15;
            u32x4 bq[4], cq[4], xq[2];
#pragma unroll
            for (int j = 0; j < 4; ++j) { const bf16_t* rp = XC + (tok0 + r0 + 32 * j) * 1536 + 1024 + grp * 128 + 8 * c16; bq[j] = *(const u32x4*)rp; cq[j] = *(const u32x4*)(rp + 256); }
            const int xr0 = tid >> 3, xc = tid & 7;
#pragma unroll
            for (int j = 0; j < 2; ++j) xq[j] = *(const u32x4*)(XC + (tok0 + xr0 + 64 * j) * 1536 + h * 64 + 8 * xc);
#pragma unroll
            for (int j = 0; j < 4; ++j) { *(LAS u32x4*)(Bi + (r0 + 32 * j) * SI_STR + c16 * 16) = bq[j]; *(LAS u32x4*)(Ci + (r0 + 32 * j) * SI_STR + c16 * 16) = cq[j]; }
#pragma unroll
            for (int j = 0; j < 2; ++j) { const int l = xr0 + 64 * j; LAS unsigned char* xp = XT + (8 * xc) * SI_STR + l * 2; const u32x4 v = xq[j];
                *(LAS bf16_t*)(xp) = (bf16_t)(v.x & 0xffffu); *(LAS bf16_t*)(xp + SI_STR) = (bf16_t)(v.x >> 16); *(LAS bf16_t*)(xp + 2 * SI_STR) = (bf16_t)(v.y & 0xffffu); *(LAS bf16_t*)(xp + 3 * SI_STR) = (bf16_t)(v.y >> 16);
                *(LAS bf16_t*)(xp + 4 * SI_STR) = (bf16_t)(v.z & 0xffffu); *(LAS bf16_t*)(xp + 5 * SI_STR) = (bf16_t)(v.z >> 16); *(LAS bf16_t*)(xp + 6 * SI_STR) = (bf16_t)(v.w & 0xffffu); *(LAS bf16_t*)(xp + 7 * SI_STR) = (bf16_t)(v.w >> 16); }
        }
        if (w == 7) {
            const float d0 = dtg[(tok0 + lane) * 16 + h], d1 = dtg[(tok0 + 64 + lane) * 16 + h];
            float v0 = d0 * a2, v1 = d1 * a2;
#pragma unroll
            for (int o = 1; o < 64; o <<= 1) { const float t0 = __shfl_up(v0, o), t1 = __shfl_up(v1, o); if (lane >= o) { v0 += t0; v1 += t1; } }
            v1 += __shfl(v0, 63);
            const float aend = __shfl(v1, 63);
            A2[lane] = v0; A2[64 + lane] = v1; A3[lane] = v0 - __log2f(d0); A3[64 + lane] = v1 - __log2f(d1);
            WL[lane] = d0 * __builtin_amdgcn_exp2f(aend - v0); WL[64 + lane] = d1 * __builtin_amdgcn_exp2f(aend - v1);
            EL[lane] = __builtin_amdgcn_exp2f(v0); EL[64 + lane] = __builtin_amdgcn_exp2f(v1);
            if (lane == 0) CD[0] = __builtin_amdgcn_exp2f(aend);
        }
        __syncthreads();
        const LAS unsigned char* PV = lds + SI_PREV + (c & 1) * 17408; LAS unsigned char* PN = lds + SI_PREV + ((c & 1) ^ 1) * 17408;
        const int lidx = 16 * w + i;
        bf16x8 cf[4];
#pragma unroll
        for (int ks = 0; ks < 4; ++ks) cf[ks] = *(const LAS bf16x8*)(Ci + lidx * SI_STR + (32 * ks + 8 * g) * 2);
        f32x4 yd[4], yo[4];
#pragma unroll
        for (int pt = 0; pt < 4; ++pt) { yd[pt] = (f32x4){0.f, 0.f, 0.f, 0.f}; yo[pt] = yd[pt]; }
        const float A2l = A2[lidx];
#pragma unroll
        for (int sp = 0; sp < 4; ++sp) {
            if (2 * sp <= w) {
                f32x4 g0 = (f32x4){0.f, 0.f, 0.f, 0.f}, g1 = g0;
#pragma unroll
                for (int ks = 0; ks < 4; ++ks) { const bf16x8 b0 = *(const LAS bf16x8*)(Bi + (32 * sp + i) * SI_STR + (32 * ks + 8 * g) * 2), b1 = *(const LAS bf16x8*)(Bi + (32 * sp + 16 + i) * SI_STR + (32 * ks + 8 * g) * 2);
                    g0 = MFMA16(b0, cf[ks], g0); g1 = MFMA16(b1, cf[ks], g1); }
                const f32x4 a30 = *(const LAS f32x4*)(A3 + 32 * sp + 4 * g), a31 = *(const LAS f32x4*)(A3 + 32 * sp + 16 + 4 * g);
                float m[8];
#pragma unroll
                for (int r = 0; r < 4; ++r) { const int s0i = 32 * sp + 4 * g + r, s1i = s0i + 16;
                    m[r] = (s0i <= lidx) ? g0[r] * __builtin_amdgcn_exp2f(A2l - a30[r]) : 0.f; m[4 + r] = (s1i <= lidx) ? g1[r] * __builtin_amdgcn_exp2f(A2l - a31[r]) : 0.f; }
                u32x4 mw; mw.x = pk2(m[0], m[1]); mw.y = pk2(m[2], m[3]); mw.z = pk2(m[4], m[5]); mw.w = pk2(m[6], m[7]);
                const bf16x8 mf = __builtin_bit_cast(bf16x8, mw);
#pragma unroll
                for (int pt = 0; pt < 4; ++pt) { const u32x2 lo = *(const LAS u32x2*)(XT + (16 * pt + i) * SI_STR + (32 * sp + 4 * g) * 2), hi = *(const LAS u32x2*)(XT + (16 * pt + i) * SI_STR + (32 * sp + 16 + 4 * g) * 2);
                    const u32x4 xw = (u32x4){lo.x, lo.y, hi.x, hi.y}; yd[pt] = MFMA16(__builtin_bit_cast(bf16x8, xw), mf, yd[pt]); }
            }
        }
        if (c > 0) {
#pragma unroll
            for (int ks = 0; ks < 4; ++ks)
#pragma unroll
                for (int pt = 0; pt < 4; ++pt) { const bf16x8 pf = *(const LAS bf16x8*)(PV + (16 * pt + i) * SI_STR + (32 * ks + 8 * g) * 2); yo[pt] = MFMA16(pf, cf[ks], yo[pt]); }
        }
        {
            const float el = EL[lidx]; float ss = 0.f; bf16_t* yrow = Y0 + (tok0 + lidx) * 2048 + h * 64 + 4 * g;
#pragma unroll
            for (int pt = 0; pt < 4; ++pt) {
                const s16x4 xs = __builtin_amdgcn_ds_read_tr16_b64_v4i16((LAS s16x4*)(XT + (16 * pt + 4 * g + (i >> 2)) * SI_STR + (16 * w + 4 * (i & 3)) * 2));
                const u32x2 zw = *(const u32x2*)(yrow + 16 * pt); const float zf[4] = {bf_lo(zw.x), bf_hi(zw.x), bf_lo(zw.y), bf_hi(zw.y)}; float u[4];
#pragma unroll
                for (int r = 0; r < 4; ++r) { u[r] = (yd[pt][r] + el * yo[pt][r] + Dh * bf2f((bf16_t)xs[r])) * zf[r]; ss += u[r] * u[r]; }
                u32x2 uw; uw.x = pk2(u[0], u[1]); uw.y = pk2(u[2], u[3]); *(u32x2*)(yrow + 16 * pt) = uw;
            }
            ss += __shfl_xor(ss, 16); ss += __shfl_xor(ss, 32);
            if (g == 0) ssq[(tok0 + lidx) * 16 + h] = ss;
        }
        {
            f32x4 st[4];
#pragma unroll
            for (int pt = 0; pt < 4; ++pt) st[pt] = (f32x4){0.f, 0.f, 0.f, 0.f};
#pragma unroll
            for (int ks = 0; ks < 4; ++ks) {
                const s16x4 lo = __builtin_amdgcn_ds_read_tr16_b64_v4i16((LAS s16x4*)(Bi + (32 * ks + 8 * g + (i >> 2)) * SI_STR + (16 * w + 4 * (i & 3)) * 2));
                const s16x4 hi = __builtin_amdgcn_ds_read_tr16_b64_v4i16((LAS s16x4*)(Bi + (32 * ks + 8 * g + 4 + (i >> 2)) * SI_STR + (16 * w + 4 * (i & 3)) * 2));
                const f32x4 w0 = *(const LAS f32x4*)(WL + 32 * ks + 8 * g), w1 = *(const LAS f32x4*)(WL + 32 * ks + 8 * g + 4);
                u32x4 bw; bw.x = pk2(bf2f((bf16_t)lo[0]) * w0[0], bf2f((bf16_t)lo[1]) * w0[1]); bw.y = pk2(bf2f((bf16_t)lo[2]) * w0[2], bf2f((bf16_t)lo[3]) * w0[3]);
                bw.z = pk2(bf2f((bf16_t)hi[0]) * w1[0], bf2f((bf16_t)hi[1]) * w1[1]); bw.w = pk2(bf2f((bf16_t)hi[2]) * w1[2], bf2f((bf16_t)hi[3]) * w1[3]);
                const bf16x8 btf = __builtin_bit_cast(bf16x8, bw);
#pragma unroll
                for (int pt = 0; pt < 4; ++pt) { const bf16x8 xb = *(const LAS bf16x8*)(XT + (16 * pt + i) * SI_STR + (32 * ks + 8 * g) * 2); st[pt] = MFMA16(btf, xb, st[pt]); }
            }
            const float cd = CD[0];
#pragma unroll
            for (int pt = 0; pt < 4; ++pt) { carry[pt] = carry[pt] * cd + st[pt];
                u32x2 cwv; cwv.x = pk2(carry[pt][0], carry[pt][1]); cwv.y = pk2(carry[pt][2], carry[pt][3]); *(LAS u32x2*)(PN + (16 * pt + i) * SI_STR + (16 * w + 4 * g) * 2) = cwv; }
        }
        __syncthreads();
    }
}

__device__ __forceinline__ void wt_qk_lds64(const WTile& w, const LAS unsigned char* Kb, int lane, f32x4 (&s)[4]) {
    const LAS unsigned char* p = Kb + (lane & 15) * KSTR + (lane >> 4) * 16;
#pragma unroll
    for (int t = 0; t < 4; ++t) s[t] = (f32x4){0.f, 0.f, 0.f, 0.f};
#pragma unroll
    for (int ks = 0; ks < 4; ++ks)
#pragma unroll
        for (int t = 0; t < 4; ++t) { const bf16x8 a = *(const LAS bf16x8*)(p + t * 16 * KSTR + ks * 64); s[t] = MFMA16(a, w.qf[ks], s[t]); }
}
__device__ __forceinline__ void wt_softmax_pv64(WTile& w, const f32x4 (&s)[4], const LAS unsigned char* Vb, int lane) {
    float mx = fmaxf(fmaxf(s[0][0], s[0][1]), fmaxf(s[0][2], s[0][3]));
#pragma unroll
    for (int t = 1; t < 4; ++t) mx = fmaxf(mx, fmaxf(fmaxf(s[t][0], s[t][1]), fmaxf(s[t][2], s[t][3])));
    mx = fmaxf(mx, __shfl_xor(mx, 16)); mx = fmaxf(mx, __shfl_xor(mx, 32));
    const float mn = fmaxf(w.m, mx), alpha = __builtin_amdgcn_exp2f(w.m - mn);
    w.m = mn;
    float p[16]; float ps = 0.f;
#pragma unroll
    for (int t = 0; t < 4; ++t)
#pragma unroll
        for (int r = 0; r < 4; ++r) { p[4 * t + r] = __builtin_amdgcn_exp2f(s[t][r] - mn); ps += p[4 * t + r]; }
    w.l = w.l * alpha + ps;
    u32x4 pw0, pw1; pw0.x = pk2(p[0], p[1]); pw0.y = pk2(p[2], p[3]); pw0.z = pk2(p[4], p[5]); pw0.w = pk2(p[6], p[7]);
    pw1.x = pk2(p[8], p[9]); pw1.y = pk2(p[10], p[11]); pw1.z = pk2(p[12], p[13]); pw1.w = pk2(p[14], p[15]);
    const bf16x8 pf0 = __builtin_bit_cast(bf16x8, pw0), pf1 = __builtin_bit_cast(bf16x8, pw1);
    const int i = lane & 15, g = lane >> 4;
    const LAS unsigned char* vp = Vb + (4 * g + (i >> 2)) * VSTR + (i & 3) * 8;
#pragma unroll
    for (int dt = 0; dt < 8; ++dt) {
        const s16x4 l0 = __builtin_amdgcn_ds_read_tr16_b64_v4i16((LAS s16x4*)(vp + dt * 32));
        const s16x4 h0 = __builtin_amdgcn_ds_read_tr16_b64_v4i16((LAS s16x4*)(vp + 16 * VSTR + dt * 32));
        const s16x4 l1 = __builtin_amdgcn_ds_read_tr16_b64_v4i16((LAS s16x4*)(vp + 32 * VSTR + dt * 32));
        const s16x4 h1 = __builtin_amdgcn_ds_read_tr16_b64_v4i16((LAS s16x4*)(vp + 48 * VSTR + dt * 32));
        f32x4 acc = MFMA16(__builtin_shufflevector(l0, h0, 0, 1, 2, 3, 4, 5, 6, 7), pf0, w.o[dt] * alpha);
        w.o[dt] = MFMA16(__builtin_shufflevector(l1, h1, 0, 1, 2, 3, 4, 5, 6, 7), pf1, acc);
    }
}
constexpr int MB_TILE = 64 * KSTR + 64 * VSTR;
constexpr int MB_MISC = 3 * MB_TILE;
__device__ __forceinline__ void moba_item_mfma(const Params& P, LAS unsigned char* lds, int b, int h, int qt) {
    unsigned char* ws = P.ws; int tid_ = threadIdx.x; asm volatile("" : "+v"(tid_)); const int tid = tid_, lane = tid & 63, wave = __builtin_amdgcn_readfirstlane(tid >> 6);
    const bf16_t* Q0 = (const bf16_t*)(ws + WS_Q0) + (size_t)b * SEQ * 1024 + h * 128; const bf16_t* K0 = (const bf16_t*)(ws + WS_K0) + (size_t)b * SEQ * 1024 + h * 128;
    const bf16_t* V0 = (const bf16_t*)(ws + WS_V0) + (size_t)b * SEQ * 1024 + h * 128; bf16_t* Y0 = (bf16_t*)(ws + WS_Y0) + (size_t)b * SEQ * 2048 + 1024 + h * 128;
    const float* kpart = (const float*)(ws + WS_KPART);
    LAS float* ksum = (LAS float*)(lds + MB_MISC);
    LAS float* gts = ksum + 8 * 128;
    LAS int* selm = (LAS int*)(gts + 128 * 8);
    LAS int* tiles = selm + 128;
    LAS int* bmask = tiles + 48;
    const int q0 = qt * 128, qb = q0 >> 8;
    __syncthreads();
    for (int i = tid; i < qb * 128; i += NTHREADS) { const int n = i >> 7, d = i & 127; const float* kp = kpart + ((size_t)(b * 8 + n) * 2) * 1024 + h * 128 + d; ksum[i] = kp[0] + kp[1024]; }
    if (tid == 0) bmask[0] = 0;
    __syncthreads();
    { const int q = tid >> 2, nn = tid & 3; const u32x4* qr = (const u32x4*)(Q0 + (size_t)(q0 + q) * 1024);
        float a0 = 0.f, a1 = 0.f; const LAS float* k0p = ksum + nn * 128; const LAS float* k1p = ksum + (nn + 4) * 128;
        const bool d0 = nn < qb, d1 = nn + 4 < qb;
        if (d0) {
#pragma unroll 4
            for (int c = 0; c < 16; ++c) { const u32x4 w = qr[c]; const float qv[8] = {bf_lo(w.x), bf_hi(w.x), bf_lo(w.y), bf_hi(w.y), bf_lo(w.z), bf_hi(w.z), bf_lo(w.w), bf_hi(w.w)};
#pragma unroll
                for (int e = 0; e < 8; ++e) { a0 += qv[e] * k0p[8 * c + e]; if (d1) a1 += qv[e] * k1p[8 * c + e]; } }
            gts[q * 8 + nn] = a0; if (d1) gts[q * 8 + nn + 4] = a1; }
    }
    __syncthreads();
    if (tid < 128) { int s0 = -1, s1 = -1, s2 = -1; float g0 = -__builtin_inff(), g1 = g0, g2 = g0;
        for (int n = 0; n < qb; ++n) { const float gv = gts[tid * 8 + n];
            if (gv > g0) { g2 = g1; s2 = s1; g1 = g0; s1 = s0; g0 = gv; s0 = n; } else if (gv > g1) { g2 = g1; s2 = s1; g1 = gv; s1 = n; } else if (gv > g2) { g2 = gv; s2 = n; } }
        int mk = 0; if (s0 >= 0) mk |= 1 << s0; if (s1 >= 0) mk |= 1 << s1; if (s2 >= 0) mk |= 1 << s2;
        selm[tid] = mk; atomicOr((int*)bmask, mk); }
    __syncthreads();
    if (tid == 0) { const int bm = bmask[0]; int c = 0;
        for (int n = 0; n < qb; ++n) if ((bm >> n) & 1) for (int j = 0; j < 4; ++j) tiles[c++] = n * 256 + 64 * j;
        for (int kb = qb * 256; kb < q0 + 128; kb += 64) tiles[c++] = kb;
        tiles[40] = c; }
    __syncthreads();
    const int ntiles = tiles[40];
    const int qi = lane & 15, g = lane >> 4, myq = q0 + wave * 16 + qi, mymask = selm[wave * 16 + qi];
    WTile w; wt_reset(w); wt_load_q(w, Q0 + (size_t)myq * 1024, lane);
    const int srow = tid >> 4, sch = tid & 15;
    u32x4 kA0, kA1, vA0, vA1, kB0, kB1, vB0, vB1;
#define MB_LOAD(S, kb_) do { const bf16_t* kp_ = K0 + (size_t)((kb_) + srow) * 1024 + 8 * sch; const bf16_t* vp_ = V0 + (size_t)((kb_) + srow) * 1024 + 8 * sch; \
        k##S##0 = *(const u32x4*)kp_; k##S##1 = *(const u32x4*)(kp_ + 32 * 1024); v##S##0 = *(const u32x4*)vp_; v##S##1 = *(const u32x4*)(vp_ + 32 * 1024); } while (0)
#define MB_WRITE(S, buf_) do { LAS unsigned char* kb_ = lds + (buf_) * MB_TILE; LAS unsigned char* vb_ = kb_ + 64 * KSTR; \
        *(LAS u32x4*)(kb_ + srow * KSTR + sch * 16) = k##S##0; *(LAS u32x4*)(kb_ + (srow + 32) * KSTR + sch * 16) = k##S##1; \
        *(LAS u32x4*)(vb_ + srow * VSTR + sch * 16) = v##S##0; *(LAS u32x4*)(vb_ + (srow + 32) * VSTR + sch * 16) = v##S##1; } while (0)
#define MB_COMPUTE(t_) do { const int kb = tiles[t_]; const int n = kb >> 8; const LAS unsigned char* kbuf = lds + ((t_) % 3) * MB_TILE; bool active; \
        if (n < qb) active = __ballot((mymask >> n) & 1) != 0ull; else active = kb <= q0 + wave * 16 + 15; \
        if (active) { f32x4 sc[4]; wt_qk_lds64(w, kbuf, lane, sc); const float NEG = -__builtin_inff(); \
            if (n < qb) { if (!((mymask >> n) & 1)) { _Pragma("unroll") for (int t2 = 0; t2 < 4; ++t2) sc[t2] = (f32x4){NEG, NEG, NEG, NEG}; } } \
            else { _Pragma("unroll") for (int t2 = 0; t2 < 4; ++t2) _Pragma("unroll") for (int r = 0; r < 4; ++r) if (kb + 16 * t2 + 4 * g + r > myq) sc[t2][r] = NEG; } \
            wt_softmax_pv64(w, sc, kbuf + 64 * KSTR, lane); } } while (0)
    MB_LOAD(A, tiles[0]);
    if (ntiles > 1) MB_LOAD(B, tiles[1]);
    MB_WRITE(A, 0);
    __syncthreads();
    for (int t = 0; t < ntiles; t += 2) {
        if (t + 2 < ntiles) MB_LOAD(A, tiles[t + 2]);
        MB_COMPUTE(t);
        if (t + 1 < ntiles) MB_WRITE(B, (t + 1) % 3);
        __syncthreads();
        if (t + 1 >= ntiles) break;
        if (t + 3 < ntiles) MB_LOAD(B, tiles[t + 3]);
        MB_COMPUTE(t + 1);
        if (t + 2 < ntiles) MB_WRITE(A, (t + 2) % 3);
        __syncthreads();
    }
#undef MB_LOAD
#undef MB_WRITE
#undef MB_COMPUTE
    float l = w.l; l += __shfl_xor(l, 16); l += __shfl_xor(l, 32); const float inv = 1.0f / l;
    bf16_t* yp = Y0 + (size_t)myq * 2048 + 4 * g;
#pragma unroll
    for (int dt = 0; dt < 8; ++dt) { const u32x2 gw = *(const u32x2*)(yp + 16 * dt);
        u32x2 o; o.x = pk2(w.o[dt][0] * inv * bf_lo(gw.x), w.o[dt][1] * inv * bf_hi(gw.x)); o.y = pk2(w.o[dt][2] * inv * bf_lo(gw.y), w.o[dt][3] * inv * bf_hi(gw.y));
        *(u32x2*)(yp + 16 * dt) = o; }
}

constexpr int DL_OACC = 0, DL_LSE = 65536, DL_V = 66560;
__device__ __forceinline__ void dilated_item_mfma(const Params& P, LAS unsigned char* lds, int b, int h, int blk) {
    unsigned char* ws = P.ws; int tid_ = threadIdx.x; asm volatile("" : "+v"(tid_)); const int tid = tid_, lane = tid & 63, wave = __builtin_amdgcn_readfirstlane(tid >> 6);
    bf16_t* Q1 = (bf16_t*)(ws + WS_QO1) + (size_t)b * SEQ * 2048 + h * 128; const bf16_t* K1 = (const bf16_t*)(ws + WS_K1) + (size_t)b * SEQ * 2048 + h * 128;
    const bf16_t* V1 = (const bf16_t*)(ws + WS_V1) + (size_t)b * SEQ * 2048 + h * 128;
    LAS unsigned char* Vw = lds + DL_V + wave * (32 * VSTR); LAS float* lse = (LAS float*)(lds + DL_LSE);
    const int T0 = blk * 256, qi = lane & 15, g = lane >> 4;
    __syncthreads();
#pragma unroll 1
    for (int pt = 0; pt < 3; ++pt) {
        const int r = 1 << (2 * pt);
#pragma unroll 1
        for (int half = 0; half < 2; ++half) {
            const int wt = wave + 8 * half;
            const int t0 = T0 + (pt == 0 ? 16 * wt : (pt == 1 ? (wt & 3) + 64 * (wt >> 2) : wt));
            const int myq = t0 + r * qi;
            WTile w; wt_reset(w); wt_load_q(w, Q1 + (size_t)myq * 2048, lane);
            const int kp0 = t0 - 144 * r;
            int s_lo = 0; while (kp0 + (32 * s_lo + 31) * r < 0) ++s_lo;
            bf16x8 kaA[2][4], kaB[2][4]; u32x4 vrA[8], vrB[8];
#define DL_LOAD(S, s_) do { const int kps_ = kp0 + 32 * (s_) * r; \
                _Pragma("unroll") for (int a = 0; a < 2; ++a) { int pos = kps_ + (16 * a + qi) * r; pos = pos < 0 ? 0 : pos; const bf16_t* kr = K1 + (size_t)pos * 2048 + 8 * g; \
                    _Pragma("unroll") for (int ks = 0; ks < 4; ++ks) ka##S[a][ks] = *(const bf16x8*)(kr + 32 * ks); } \
                _Pragma("unroll") for (int j = 0; j < 8; ++j) { const int c = lane + 64 * j, row = c >> 4, ch = c & 15; int pos = kps_ + row * r; pos = pos < 0 ? 0 : pos; vr##S[j] = *(const u32x4*)(V1 + (size_t)pos * 2048 + 8 * ch); } } while (0)
#define DL_STEP(S, s_) do { const int kps_ = kp0 + 32 * (s_) * r; \
                _Pragma("unroll") for (int j = 0; j < 8; ++j) { const int c = lane + 64 * j, row = c >> 4, ch = c & 15; *(LAS u32x4*)(Vw + row * VSTR + ch * 16) = vr##S[j]; } \
                f32x4 s0 = (f32x4){0.f, 0.f, 0.f, 0.f}, s1 = s0; \
                _Pragma("unroll") for (int ks = 0; ks < 4; ++ks) { s0 = MFMA16(ka##S[0][ks], w.qf[ks], s0); s1 = MFMA16(ka##S[1][ks], w.qf[ks], s1); } \
                const float NEG = -__builtin_inff(); \
                _Pragma("unroll") for (int e = 0; e < 4; ++e) { const int kk0 = 4 * g + e, kk1 = 16 + 4 * g + e; const int d0 = qi + 144 - 32 * (s_) - kk0, d1 = qi + 144 - 32 * (s_) - kk1; \
                    if (d0 < 0 || d0 > 128 || kps_ + kk0 * r < 0) s0[e] = NEG; if (d1 < 0 || d1 > 128 || kps_ + kk1 * r < 0) s1[e] = NEG; } \
                wt_softmax_pv(w, s0, s1, Vw, lane); } while (0)
            DL_LOAD(A, s_lo);
#pragma unroll 1
            for (int s = s_lo; s < 5; s += 2) {
                if (s + 1 < 5) DL_LOAD(B, s + 1);
                DL_STEP(A, s);
                if (s + 1 >= 5) break;
                if (s + 2 < 5) DL_LOAD(A, s + 2);
                DL_STEP(B, s + 1);
            }
#undef DL_LOAD
#undef DL_STEP
            float l = w.l; l += __shfl_xor(l, 16); l += __shfl_xor(l, 32); const float inv = 1.0f / l; const float ls = w.m + __log2f(l);
            const int row = myq - T0;
            LAS unsigned char* orow = lds + DL_OACC + row * 256 + 8 * g;
            if (pt == 0) {
#pragma unroll
                for (int dt = 0; dt < 8; ++dt) { u32x2 o; o.x = pk2(w.o[dt][0] * inv, w.o[dt][1] * inv); o.y = pk2(w.o[dt][2] * inv, w.o[dt][3] * inv); *(LAS u32x2*)(orow + 32 * dt) = o; }
                if (g == 0) lse[row] = ls;
            } else {
                const float lo = lse[row], mxl = fmaxf(lo, ls); const float eo = __builtin_amdgcn_exp2f(lo - mxl), en = __builtin_amdgcn_exp2f(ls - mxl), den = eo + en;
                const float wo = eo / den, wn = en / den * inv;
                bf16_t* gout = Q1 + (size_t)myq * 2048 + 4 * g;
#pragma unroll
                for (int dt = 0; dt < 8; ++dt) { const u32x2 ov = *(const LAS u32x2*)(orow + 32 * dt);
                    u32x2 o; o.x = pk2(wo * bf_lo(ov.x) + wn * w.o[dt][0], wo * bf_hi(ov.x) + wn * w.o[dt][1]); o.y = pk2(wo * bf_lo(ov.y) + wn * w.o[dt][2], wo * bf_hi(ov.y) + wn * w.o[dt][3]);
                    if (pt == 1) *(LAS u32x2*)(orow + 32 * dt) = o; else *(u32x2*)(gout + 16 * dt) = o; }
                if (pt == 1) { asm volatile("s_waitcnt lgkmcnt(0)" ::: "memory"); if (g == 0) lse[row] = mxl + __log2f(den); }
            }
        }
        __syncthreads();
    }
}

__global__ void __launch_bounds__(NTHREADS, 2) fwd_megakernel(Params P) {
    extern __shared__ __attribute__((aligned(16))) unsigned char lds_raw[];
    LAS unsigned char* lds = (LAS unsigned char*)lds_raw;
    cg::grid_group grid = cg::this_grid();
    const int G = gridDim.x, tid = threadIdx.x;
    unsigned char* ws = P.ws;
    LAS int* misc = (LAS int*)(lds + LDS_BYTES - 64);
    unsigned long long pr_t0 = 0, pr_acc = 0;
#define PH_BEGIN(k) do { if (PROBE_PHASE == (k)) pr_t0 = __builtin_amdgcn_s_memrealtime(); } while (0)
#define PH_END(k) do { if (PROBE_PHASE == (k)) pr_acc += __builtin_amdgcn_s_memrealtime() - pr_t0; } while (0)

    PH_BEGIN(0);
    if (PHASE_MASK & 1) phase_prep(P, lds, G);
    grid.sync();
    PH_END(0);
    PH_BEGIN(1);
    if (PHASE_MASK & 2) {
        pg8::Gemm g{(const bf16_t*)P.out, (const bf16_t*)(ws + WS_W0T), MTOK, N0, DM}; pg8::StaticOrder S; S.init(MTOK, N0, G, (int)blockIdx.x);
        EpiIn0 E{(bf16_t*)(ws + WS_Y0), (bf16_t*)(ws + WS_XBC), (bf16_t*)(ws + WS_Q0), (bf16_t*)(ws + WS_K0), (bf16_t*)(ws + WS_V0), (const float*)(ws + WS_RSTD0), (float*)(ws + WS_KPART)};
        pg8::gemm_phase<GEMM_ALIGN, GEMM_SP2>(lds, g, S, E, pg8::NoHook{});
    }
    grid.sync();
    PH_END(1);
    PH_BEGIN(2);
    PH_BEGIN(21);
    if (PHASE_MASK & 4) { conv_prepass(P, G); }
    grid.sync();
    PH_END(21);
    if (PHASE_MASK & 4) {
        const int xcd = blockIdx.x & 7;
        unsigned* ctr = (unsigned*)(ws + WS_CTL) + 16 * xcd;
        for (;;) {
            __syncthreads();
            if (tid == 0) misc[0] = (int)atomicAdd(ctr, 1u);
            __syncthreads();
            const int it = misc[0];
#if MOBA_MFMA
            if (it >= 16 + 128) break;
            if (it < 16) { const int item = it * 8 + xcd; PH_BEGIN(20); if (SSD_MFMA) ssd_item_mfma(P, lds, item >> 4, item & 15); else ssd_item(P, lds, item >> 4, item & 15); PH_END(20); }
            else { const int r = it - 16; const int qt = 15 - (r & 15), bh = 8 * (r >> 4) + xcd; PH_BEGIN(22); moba_item_mfma(P, lds, bh >> 3, bh & 7, qt); PH_END(22); }
#else
            if (it >= 128 + 4096) break;
            if (it < 128) ssd_item(P, lds, it >> 4, it & 15);
            else { const int r = it - 128; const int qt = 63 - (r >> 6), bh = r & 63; moba_item(P, lds, bh >> 3, bh & 7, qt); }
#endif
        }
    }
    grid.sync();
    PH_END(2);
    PH_BEGIN(3);
    if (PHASE_MASK & 8) {
        pg8::Gemm g{(const bf16_t*)(ws + WS_Y0), (const bf16_t*)(ws + WS_WO0T), MTOK, DM, 2048}; pg8::StaticOrder S; S.init(MTOK, DM, G, (int)blockIdx.x);
        EpiRes E{P.x, P.out, (bf16_t*)(ws + WS_X1B), (float*)(ws + WS_RSQ1)};
        HookSsdNorm H{(const float*)(ws + WS_SSQ)};
        pg8::gemm_phase<GEMM_ALIGN, GEMM_SP2>(lds, g, S, E, H);
    }
    grid.sync();
    PH_END(3);
    PH_BEGIN(4);
    if (PHASE_MASK & 16) {
        pg8::Gemm g{(const bf16_t*)(ws + WS_X1B), (const bf16_t*)(ws + WS_W1T), MTOK, 6144, DM}; pg8::StaticOrder S; S.init(MTOK, 6144, G, (int)blockIdx.x);
        EpiQkv1 E{(bf16_t*)(ws + WS_QO1), (size_t)(WS_K1 - WS_QO1) / 2, (const float*)(ws + WS_RSQ1)};
        pg8::gemm_phase<GEMM_ALIGN, GEMM_SP2>(lds, g, S, E, pg8::NoHook{});
    }
    grid.sync();
    PH_END(4);
    PH_BEGIN(5);
#if DIL_MFMA
    if (PHASE_MASK & 32) for (int it = (int)(blockIdx.x & 7) * (G >> 3) + (int)(blockIdx.x >> 3); it < 8 * 16 * 8; it += G) { const int blk = (it ^ (it >> 8)) & 7, bh = it >> 3; dilated_item_mfma(P, lds, bh >> 4, bh & 15, blk); }
#else
    if (PHASE_MASK & 32) for (int it = blockIdx.x; it < 8 * 16 * 64; it += G) { const int qt = it & 63, bh = it >> 6; dilated_item(P, lds, bh >> 4, bh & 15, qt); }
#endif
    grid.sync();
    PH_END(5);
    PH_BEGIN(6);
    if (PHASE_MASK & 64) {
        pg8::Gemm g{(const bf16_t*)(ws + WS_X1B), (const bf16_t*)(ws + WS_W1T) + (size_t)6144 * 1024, MTOK, 2048, DM}; pg8::StaticOrder S; S.init(MTOK, 2048, G, (int)blockIdx.x);
        EpiGate1 E{(bf16_t*)(ws + WS_QO1), (const float*)(ws + WS_RSQ1)};
        pg8::gemm_phase<GEMM_ALIGN, GEMM_SP2>(lds, g, S, E, pg8::NoHook{});
    }
    grid.sync();
    PH_END(6);
    PH_BEGIN(7);
    if (PHASE_MASK & 128) {
        pg8::Gemm g{(const bf16_t*)(ws + WS_QO1), (const bf16_t*)(ws + WS_WO1T), MTOK, DM, 2048}; pg8::StaticOrder S; S.init(MTOK, DM, G, (int)blockIdx.x);
        EpiRes E{P.out, P.out, nullptr, (float*)(ws + WS_RSQ2)};
        pg8::gemm_phase<GEMM_ALIGN, GEMM_SP2>(lds, g, S, E, pg8::NoHook{});
    }
    grid.sync();
    PH_END(7);
    PH_BEGIN(8);
    if (PHASE_MASK & 256) {
        const int lane = tid & 63, wave = tid >> 6; const float* rsq2 = (const float*)(ws + WS_RSQ2);
        for (int m = blockIdx.x * 8 + wave; m < MTOK; m += G * 8) {
            const float rs = rstd_from16(rsq2 + (size_t)m * 16);
            f32x4* xr = (f32x4*)(P.out + (size_t)m * DM) + lane; const f32x4* gr = (const f32x4*)P.final_norm + lane;
#pragma unroll
            for (int j = 0; j < 4; ++j) { const f32x4 v = xr[64 * j], gg = gr[64 * j]; xr[64 * j] = v * rs * gg; }
        }
    }
    if (PROBE_PHASE >= 0) { PH_END(8); if (blockIdx.x == 0 && tid == 0) { const unsigned long long t0 = __builtin_amdgcn_s_memrealtime(), wait = pr_acc * PROBE_MULT;
        while (__builtin_amdgcn_s_memrealtime() - t0 < wait) __builtin_amdgcn_s_sleep(32); } }
}

extern "C" void kernel_launch(void* const* d_in, const int* in_sizes, int n_in, void* d_out, int out_size, void* d_ws, size_t ws_size, hipStream_t stream) {
    static int grid_blocks = 0;
    if (grid_blocks == 0) {
        if (n_in != 14 || ws_size < WS_END) { fprintf(stderr, "kernel_launch: unexpected n_in %d / ws_size %zu\n", n_in, ws_size); grid_blocks = -1; return; }
        int dev = 0, cus = 0, per_cu = 0;
        hipGetDevice(&dev);
        hipDeviceGetAttribute(&cus, hipDeviceAttributeMultiprocessorCount, dev);
        hipFuncSetAttribute((const void*)fwd_megakernel, hipFuncAttributeMaxDynamicSharedMemorySize, LDS_BYTES);
        hipOccupancyMaxActiveBlocksPerMultiprocessor(&per_cu, (const void*)fwd_megakernel, NTHREADS, LDS_BYTES);
        if (per_cu < 1) { fprintf(stderr, "kernel_launch: occupancy query says %d blocks per CU\n", per_cu); per_cu = 1; }
        grid_blocks = cus * 1;
        (void)hipGetLastError();
    }
    if (grid_blocks < 0) return;
    Params p{};
    p.x = (const float*)d_in[0]; p.even_norm = (const float*)d_in[1]; p.w_in0 = (const float*)d_in[2]; p.conv_w = (const float*)d_in[3]; p.conv_b = (const float*)d_in[4];
    p.dt_bias = (const float*)d_in[5]; p.a_log = (const float*)d_in[6]; p.d_skip = (const float*)d_in[7]; p.ssd_norm = (const float*)d_in[8]; p.w_out0 = (const float*)d_in[9];
    p.odd_norm = (const float*)d_in[10]; p.w_in1 = (const float*)d_in[11]; p.w_out1 = (const float*)d_in[12]; p.final_norm = (const float*)d_in[13];
    p.out = (float*)d_out; p.ws = (unsigned char*)d_ws;
    void* args[] = {&p};
    hipError_t e = hipLaunchCooperativeKernel((const void*)fwd_megakernel, dim3(grid_blocks), dim3(NTHREADS), args, LDS_BYTES, stream);
    if (e != hipSuccess) fprintf(stderr, "cooperative launch failed: %s (grid %d)\n", hipGetErrorString(e), grid_blocks);
}
```

```cpp
#include <hip/hip_runtime.h>
#include <hip/hip_cooperative_groups.h>
#include <cstdio>
#include <cstdint>
namespace cg = cooperative_groups;

#define LAS __attribute__((address_space(3)))
typedef unsigned short bf16_t;
typedef short bf16x8 __attribute__((ext_vector_type(8)));
typedef float f32x4 __attribute__((ext_vector_type(4)));
typedef float f32x2 __attribute__((ext_vector_type(2)));
typedef unsigned u32x4 __attribute__((ext_vector_type(4)));
typedef unsigned u32x2 __attribute__((ext_vector_type(2)));

constexpr int BATCH = 8, SEQ = 2048, DM = 1024, MTOK = BATCH * SEQ;
constexpr int EVEN_IN = 6672;
constexpr int N0 = 6656;
constexpr float NORM_EPS = 1e-5f;
constexpr float QSCALE = 0.08838834764831845f * 1.4426950408889634f;
#ifndef PHASE_MASK
#define PHASE_MASK 0x1ff
#endif
#ifndef PROBE_PHASE
#define PROBE_PHASE -1
#endif
#ifndef PROBE_BLOCK
#define PROBE_BLOCK 0
#endif
#ifndef PROBE_MULT
#define PROBE_MULT 4
#endif
#ifndef GEMM_SP2
#define GEMM_SP2 true
#endif
#ifndef GEMM_ALIGN
#define GEMM_ALIGN true
#endif
#ifndef DIL_V2
#define DIL_V2 1
#endif
#ifndef MOBA_M32
#define MOBA_M32 1
#endif
#ifndef SSD_MFMA
#define SSD_MFMA 1
#endif
#ifndef MOBA_MFMA
#define MOBA_MFMA 1
#endif
#ifndef DIL_MFMA
#define DIL_MFMA 1
#endif
constexpr int NTHREADS = 512;
constexpr int LDS_BYTES = 155648;
constexpr int RING_BYTES = 131072;

constexpr size_t MiB = 1u << 20;
constexpr size_t WS_CTL = 0;
constexpr size_t WS_RSTD0 = 64 * 1024;
constexpr size_t WS_KPART = 512 * 1024;
constexpr size_t WS_DT = 1 * MiB;
constexpr size_t WS_SSQ = 2 * MiB;
constexpr size_t WS_RSQ1 = 3 * MiB;
constexpr size_t WS_RSQ2 = 4 * MiB;
constexpr size_t WS_W1T = 5 * MiB;
constexpr size_t WS_WO1T = 21 * MiB;
constexpr size_t WS_W0T = 25 * MiB;
constexpr size_t WS_WO0T = 38 * MiB;
constexpr size_t WS_Y0 = 42 * MiB;
constexpr size_t WS_XBC = 106 * MiB;
constexpr size_t WS_Q0 = 154 * MiB;
constexpr size_t WS_K0 = 186 * MiB;
constexpr size_t WS_V0 = 218 * MiB;
constexpr size_t WS_X1B = 224 * MiB;
constexpr size_t WS_QO1 = 25 * MiB;
constexpr size_t WS_K1 = 89 * MiB;
constexpr size_t WS_V1 = 153 * MiB;
constexpr size_t WS_END = 256 * MiB;

struct Params {
    const float* x; const float* even_norm; const float* w_in0; const float* conv_w; const float* conv_b; const float* dt_bias; const float* a_log;
    const float* d_skip; const float* ssd_norm; const float* w_out0; const float* odd_norm; const float* w_in1; const float* w_out1; const float* final_norm;
    float* out; unsigned char* ws;
};

__device__ __forceinline__ unsigned f2bf(float f) { unsigned u = __builtin_bit_cast(unsigned, f); return (u + 0x7fffu + ((u >> 16) & 1u)) >> 16; }
typedef __bf16 bf16v2_t __attribute__((ext_vector_type(2)));
__device__ __forceinline__ unsigned pk2(float lo, float hi) { const bf16v2_t v = {(__bf16)lo, (__bf16)hi}; return __builtin_bit_cast(unsigned, v); }
__device__ __forceinline__ float bf_lo(unsigned w) { return __builtin_bit_cast(float, w << 16); }
__device__ __forceinline__ float bf_hi(unsigned w) { return __builtin_bit_cast(float, w & 0xffff0000u); }
__device__ __forceinline__ float bf2f(bf16_t h) { return __builtin_bit_cast(float, (unsigned)h << 16); }
__device__ __forceinline__ float silu_f(float v) { return v * __builtin_amdgcn_rcpf(1.0f + __builtin_amdgcn_exp2f(-1.4426950408889634f * v)); }
__device__ __forceinline__ float wave_sum(float v) {
#pragma unroll
    for (int o = 1; o < 64; o <<= 1) v += __shfl_xor(v, o);
    return v;
}

namespace pg8 {
constexpr int BM = 256, BK = 64, HALF = 128, HTB = HALF * BK * 2, NXCD = 8, WGM = 8;
__host__ __device__ __forceinline__ int lds_byte(int r, int c) { const int st = (r >> 4) * 2 + (c >> 5), rr = r & 15, cc = c & 31, ob = rr * 64 + cc * 2; return st * 1024 + (ob ^ (((ob >> 9) & 1) << 5)); }
__host__ __device__ __forceinline__ void stage_rc(int b, int& R, int& C) { const int st = b / 1024, sb = b % 1024, swz = sb ^ (((sb >> 9) & 1) << 5); R = (st >> 1) * 16 + swz / 64; C = (st & 1) * 32 + (swz % 64) / 2; }
__host__ __device__ __forceinline__ int perm32(int rho) { const int n = rho >> 4, i = rho & 15; return 8 * (i >> 2) + 4 * n + (i & 3); }

struct Unit { int pm, pn; };
struct Gemm { const bf16_t* A; const bf16_t* Bt; int M, N, K; };

struct StaticOrder {
    int nM, nN, nwg, G, c;
    __device__ void init(int M, int N, int G_, int c_) { nM = M / BM; nN = N / BM; nwg = nM * nN; G = G_; c = c_; }
    __device__ bool next(int i, Unit& u) const {
        const long L = (long)i * G + c; if (L >= nwg) return false;
        int wgid = (int)L; { const int q = nwg / NXCD, r = nwg % NXCD, xcd = wgid % NXCD, off = wgid / NXCD; wgid = (xcd < r ? xcd * (q + 1) : r * (q + 1) + (xcd - r) * q) + off; }
        const int nig = WGM * nN, gid = wgid / nig, fm = gid * WGM, gsz = (nM - fm) < WGM ? (nM - fm) : WGM;
        u.pm = fm + ((wgid % nig) % gsz); u.pn = (wgid % nig) / gsz; return true;
    }
};
struct NoHook {
    __device__ __forceinline__ void begin(const Unit&, LAS unsigned char*) const {}
    __device__ __forceinline__ void at(f32x4 (&)[2][2][4][2], int, int, int, LAS unsigned char*) const {}
};

template <bool ALIGN_EPI, bool SP2, class Epi, class Sched, class Hook>
__device__ __forceinline__ void gemm_phase(LAS unsigned char* lds, const Gemm g, const Sched& S, const Epi& E, const Hook& H) {
    int tid_ = threadIdx.x; asm volatile("" : "+v"(tid_));
    const int tid = tid_, wid = __builtin_amdgcn_readfirstlane(tid >> 6), lane = tid & 63, wr = wid >> 2, wc = wid & 3, fr = lane & 15, fq = lane >> 4;
    const int K = g.K, nt = K / BK;
    unsigned voffA[2], voffB[2];
#pragma unroll
    for (int i = 0; i < 2; ++i) { int R, C; stage_rc(tid * 16 + i * 8192, R, C); const int Rb = Epi::PERM ? ((R & ~31) + perm32(R & 31)) : R;
        voffA[i] = (unsigned)(R * K + C) * 2u; voffB[i] = (unsigned)(Rb * K + C) * 2u; }
    const size_t kstep = (size_t)(BK * 2);
    const size_t hstep = (size_t)HALF * K * 2;
    const size_t tstep = 2 * hstep;
    const unsigned ldsw = (unsigned)wid * 1024u;
    const int aoff = lds_byte(wr * 64 + fr, fq * 8), boff = lds_byte(wc * 32 + fr, fq * 8);
#define PG8_SA(b, h) (((b) * 2 + (h)) * HTB)
#define PG8_SB(b, h) ((4 + (b) * 2 + (h)) * HTB)
#define PG8_STAGE(bufoff, gbase, voff) do { _Pragma("unroll") for (int _i = 0; _i < 2; ++_i) \
        __builtin_amdgcn_global_load_lds((const unsigned*)((const char*)(gbase) + (voff)[_i]), (LAS unsigned*)(lds + (bufoff) + ldsw + _i * 8192), 16, 0, 0); } while (0)
#define PG8_LDA(dst, b, h) do { _Pragma("unroll") for (int m = 0; m < 4; ++m) _Pragma("unroll") for (int k = 0; k < 2; ++k) dst[m][k] = *(const LAS bf16x8*)(lds + PG8_SA(b, h) + aoff + m * 2048 + k * 1024); } while (0)
#define PG8_LDB(dst, b, h) do { _Pragma("unroll") for (int n = 0; n < 2; ++n) _Pragma("unroll") for (int k = 0; k < 2; ++k) dst[n][k] = *(const LAS bf16x8*)(lds + PG8_SB(b, h) + boff + n * 2048 + k * 1024); } while (0)
#define PG8_MMA(ai, bj, At, Bt) do { __builtin_amdgcn_s_setprio(1); _Pragma("unroll") for (int m = 0; m < 4; ++m) _Pragma("unroll") for (int n = 0; n < 2; ++n) _Pragma("unroll") for (int k = 0; k < 2; ++k) \
        acc[ai][bj][m][n] = __builtin_amdgcn_mfma_f32_16x16x32_bf16(Bt[n][k], At[m][k], acc[ai][bj][m][n], 0, 0, 0); __builtin_amdgcn_s_setprio(0); } while (0)
#define PG8_WAIT_V(n) asm volatile("s_waitcnt vmcnt(" #n ")" ::: "memory")
#define PG8_WAIT_L(n) asm volatile("s_waitcnt lgkmcnt(" #n ")" ::: "memory")
#define PG8_BAR __builtin_amdgcn_s_barrier()
#define PG8_SCHED __builtin_amdgcn_sched_barrier(0)
    Unit cur, nxt; int ui = 0;
    if (!S.next(0, cur)) return;
    f32x4 acc[2][2][4][2];
#pragma unroll
    for (int a = 0; a < 2; ++a)
#pragma unroll
        for (int b = 0; b < 2; ++b)
#pragma unroll
            for (int m = 0; m < 4; ++m)
#pragma unroll
                for (int n = 0; n < 2; ++n) acc[a][b][m][n] = (f32x4){0.f, 0.f, 0.f, 0.f};
    bf16x8 At[4][2], B0[2][2], B1[2][2];
    const char* cA = (const char*)g.A + (size_t)cur.pm * tstep; const char* cB = (const char*)g.Bt + (size_t)cur.pn * tstep;
    H.begin(cur, lds);
    if constexpr (SP2) {
        PG8_STAGE(PG8_SB(0, 0), cB, voffB); PG8_STAGE(PG8_SB(0, 1), cB + hstep, voffB); PG8_STAGE(PG8_SA(0, 0), cA, voffA); PG8_STAGE(PG8_SA(0, 1), cA + hstep, voffA);
        if (wr == 1) PG8_BAR;
        PG8_WAIT_V(2); PG8_BAR;
        PG8_STAGE(PG8_SB(1, 0), cB + kstep, voffB); PG8_STAGE(PG8_SA(1, 0), cA + kstep, voffA); PG8_STAGE(PG8_SB(1, 1), cB + hstep + kstep, voffB);
        PG8_WAIT_V(6); PG8_BAR;
    } else {
        PG8_STAGE(PG8_SB(0, 0), cB, voffB); PG8_STAGE(PG8_SA(0, 0), cA, voffA); PG8_STAGE(PG8_SB(0, 1), cB + hstep, voffB); PG8_STAGE(PG8_SA(0, 1), cA + hstep, voffA);
        if (wr == 1) PG8_BAR;
        PG8_WAIT_V(4); PG8_BAR;
        PG8_STAGE(PG8_SB(1, 0), cB + kstep, voffB); PG8_STAGE(PG8_SA(1, 0), cA + kstep, voffA); PG8_STAGE(PG8_SB(1, 1), cB + hstep + kstep, voffB);
        PG8_WAIT_V(6); PG8_BAR;
    }
    for (;;) {
        const bool has_next = S.next(ui + 1, nxt);
        const char* nA = has_next ? (const char*)g.A + (size_t)nxt.pm * tstep : cA; const char* nB = has_next ? (const char*)g.Bt + (size_t)nxt.pn * tstep : cB;
        for (int t = 0; t < nt; t += 2) {
            const bool last = (t == nt - 2);
            const char* a1 = cA + (size_t)(t + 1) * kstep;
            const char* a2 = last ? nA : cA + (size_t)(t + 2) * kstep; const char* b2 = last ? nB : cB + (size_t)(t + 2) * kstep;
            const char* a3 = a2 + kstep; const char* b3 = b2 + kstep;
            H.at(acc, t, wr, fr, lds);
            if constexpr (SP2) {
            PG8_LDB(B0, 0, 0); PG8_LDB(B1, 0, 1); PG8_SCHED; PG8_LDA(At, 0, 0); PG8_STAGE(PG8_SA(1, 1), a1 + hstep, voffA);
            PG8_WAIT_V(8); PG8_WAIT_L(0); PG8_BAR; PG8_MMA(0, 0, At, B0); PG8_MMA(0, 1, At, B1); PG8_BAR; PG8_SCHED;
            PG8_LDA(At, 0, 1); PG8_STAGE(PG8_SB(0, 0), b2, voffB); PG8_STAGE(PG8_SB(0, 1), b2 + hstep, voffB); PG8_STAGE(PG8_SA(0, 0), a2, voffA);
            PG8_WAIT_V(8); PG8_WAIT_L(0); PG8_BAR; PG8_MMA(1, 0, At, B0); PG8_MMA(1, 1, At, B1); PG8_BAR; PG8_SCHED;
            PG8_LDB(B0, 1, 0); PG8_LDB(B1, 1, 1); PG8_SCHED; PG8_LDA(At, 1, 0); PG8_STAGE(PG8_SA(0, 1), a2 + hstep, voffA);
            PG8_WAIT_V(8); PG8_WAIT_L(0); PG8_BAR; PG8_MMA(0, 0, At, B0); PG8_MMA(0, 1, At, B1); PG8_BAR; PG8_SCHED;
            PG8_LDA(At, 1, 1); PG8_STAGE(PG8_SB(1, 0), b3, voffB); PG8_STAGE(PG8_SB(1, 1), b3 + hstep, voffB); PG8_STAGE(PG8_SA(1, 0), a3, voffA);
            PG8_WAIT_V(8); PG8_WAIT_L(0); PG8_BAR; PG8_MMA(1, 0, At, B0); PG8_MMA(1, 1, At, B1); PG8_BAR; PG8_SCHED;
            } else {
            PG8_LDB(B0, 0, 0); PG8_SCHED; PG8_LDA(At, 0, 0); PG8_STAGE(PG8_SA(1, 1), a1 + hstep, voffA);
            PG8_WAIT_L(8); PG8_BAR; PG8_WAIT_L(0); PG8_MMA(0, 0, At, B0); PG8_BAR; PG8_SCHED;
            PG8_LDB(B1, 0, 1); PG8_STAGE(PG8_SB(0, 0), b2, voffB);
            PG8_BAR; PG8_WAIT_L(0); PG8_MMA(0, 1, At, B1); PG8_BAR;
            PG8_LDA(At, 0, 1); PG8_STAGE(PG8_SA(0, 0), a2, voffA);
            PG8_BAR; PG8_WAIT_L(0); PG8_MMA(1, 0, At, B0); PG8_BAR; PG8_SCHED;
            PG8_STAGE(PG8_SB(0, 1), b2 + hstep, voffB);
            PG8_WAIT_V(6); PG8_BAR; PG8_MMA(1, 1, At, B1); PG8_BAR;
            PG8_LDB(B0, 1, 0); PG8_SCHED; PG8_LDA(At, 1, 0); PG8_STAGE(PG8_SA(0, 1), a2 + hstep, voffA);
            PG8_WAIT_L(8); PG8_BAR; PG8_WAIT_L(0); PG8_MMA(0, 0, At, B0); PG8_BAR; PG8_SCHED;
            PG8_LDB(B1, 1, 1); PG8_STAGE(PG8_SB(1, 0), b3, voffB);
            PG8_BAR; PG8_WAIT_L(0); PG8_MMA(0, 1, At, B1); PG8_BAR;
            PG8_LDA(At, 1, 1); PG8_STAGE(PG8_SA(1, 0), a3, voffA);
            PG8_BAR; PG8_WAIT_L(0); PG8_MMA(1, 0, At, B0); PG8_BAR; PG8_SCHED;
            PG8_STAGE(PG8_SB(1, 1), b3 + hstep, voffB);
            PG8_WAIT_V(6); PG8_BAR; PG8_MMA(1, 1, At, B1); PG8_BAR;
            }
        }
        if constexpr (ALIGN_EPI) { if (wr == 0) PG8_BAR; }
        E(acc, cur, wr, wc, fr, fq);
        if (!has_next) break;
#pragma unroll
        for (int a = 0; a < 2; ++a)
#pragma unroll
            for (int b = 0; b < 2; ++b)
#pragma unroll
                for (int m = 0; m < 4; ++m)
#pragma unroll
                    for (int n = 0; n < 2; ++n) acc[a][b][m][n] = (f32x4){0.f, 0.f, 0.f, 0.f};
        cur = nxt; cA = nA; cB = nB; ++ui;
        H.begin(cur, lds);
        if constexpr (ALIGN_EPI) { if (wr == 1) PG8_BAR; }
    }
    PG8_WAIT_V(0);
    if constexpr (!ALIGN_EPI) { if (wr == 0) PG8_BAR; }
    PG8_BAR;
#undef PG8_SA
#undef PG8_SB
#undef PG8_STAGE
#undef PG8_LDA
#undef PG8_LDB
#undef PG8_MMA
#undef PG8_WAIT_V
#undef PG8_WAIT_L
#undef PG8_BAR
#undef PG8_SCHED
}
}

struct EpiIn0 {
    static constexpr bool PERM = true;
    bf16_t *Y0, *XBC, *Q0, *K0, *V0; const float* rstd; float* kpart;
    __device__ __forceinline__ void operator()(const f32x4 (&acc)[2][2][4][2], const pg8::Unit& u, int wr, int wc, int fr, int fq) const {
        const int pn = u.pn; bf16_t* base; int ld, colt, mode;
        if (pn < 8) { base = Y0; ld = 2048; colt = pn * 256; mode = 1; }
        else if (pn < 14) { base = XBC; ld = 1536; colt = (pn - 8) * 256; mode = 0; }
        else if (pn < 18) { base = Q0; ld = 1024; colt = (pn - 14) * 256; mode = 2; }
        else if (pn < 22) { base = K0; ld = 1024; colt = (pn - 18) * 256; mode = 3; }
        else { base = V0; ld = 1024; colt = (pn - 22) * 256; mode = 0; }
        const int row0 = u.pm * 256 + wr * 64 + fr, col0 = colt + wc * 32 + 8 * fq;
        float cs[2][8];
#pragma unroll
        for (int bj = 0; bj < 2; ++bj)
#pragma unroll
            for (int e = 0; e < 8; ++e) cs[bj][e] = 0.f;
#pragma unroll
        for (int ai = 0; ai < 2; ++ai)
#pragma unroll
            for (int m = 0; m < 4; ++m) {
                const int row = row0 + ai * 128 + m * 16; const float rs = rstd[row]; bf16_t* rowp = base + (size_t)row * ld + col0;
#pragma unroll
                for (int bj = 0; bj < 2; ++bj) {
                    float v[8];
#pragma unroll
                    for (int e = 0; e < 4; ++e) { v[e] = acc[ai][bj][m][0][e] * rs; v[4 + e] = acc[ai][bj][m][1][e] * rs; }
                    if (mode == 1) {
#pragma unroll
                        for (int e = 0; e < 8; ++e) v[e] = silu_f(v[e]);
                    } else if (mode == 2) {
#pragma unroll
                        for (int e = 0; e < 8; ++e) v[e] *= QSCALE;
                    } else if (mode == 3) {
#pragma unroll
                        for (int e = 0; e < 8; ++e) cs[bj][e] += v[e];
                    }
                    u32x4 w; w.x = pk2(v[0], v[1]); w.y = pk2(v[2], v[3]); w.z = pk2(v[4], v[5]); w.w = pk2(v[6], v[7]);
                    *(u32x4*)(rowp + bj * 128) = w;
                }
            }
        if (mode == 3) {
#pragma unroll
            for (int bj = 0; bj < 2; ++bj)
#pragma unroll
                for (int e = 0; e < 8; ++e) { float s = cs[bj][e]; s += __shfl_xor(s, 1); s += __shfl_xor(s, 2); s += __shfl_xor(s, 4); s += __shfl_xor(s, 8); cs[bj][e] = s; }
            if (fr == 0) {
                float* kp = kpart + ((size_t)u.pm * 2 + wr) * 1024 + col0;
#pragma unroll
                for (int bj = 0; bj < 2; ++bj) { *(f32x4*)(kp + bj * 128) = (f32x4){cs[bj][0], cs[bj][1], cs[bj][2], cs[bj][3]}; *(f32x4*)(kp + bj * 128 + 4) = (f32x4){cs[bj][4], cs[bj][5], cs[bj][6], cs[bj][7]}; }
            }
        }
    }
};
struct EpiRes {
    static constexpr bool PERM = false;
    const float* xi; float* xo; bf16_t* xb; float* rsq;
    __device__ __forceinline__ void operator()(const f32x4 (&acc)[2][2][4][2], const pg8::Unit& u, int wr, int wc, int fr, int fq) const {
        const int col0 = u.pn * 256 + wc * 32 + 4 * fq;
#pragma unroll
        for (int ai = 0; ai < 2; ++ai)
#pragma unroll
            for (int m = 0; m < 4; ++m) {
                const int row = u.pm * 256 + ai * 128 + wr * 64 + m * 16 + fr; const size_t off = (size_t)row * DM + col0; float ss = 0.f;
#pragma unroll
                for (int bj = 0; bj < 2; ++bj)
#pragma unroll
                    for (int n = 0; n < 2; ++n) {
                        const f32x4 b = *(const f32x4*)(xi + off + bj * 128 + n * 16); const f32x4 o = b + acc[ai][bj][m][n];
                        *(f32x4*)(xo + off + bj * 128 + n * 16) = o; ss += (o[0] * o[0] + o[1] * o[1]) + (o[2] * o[2] + o[3] * o[3]);
                        if (xb) { u32x2 w; w.x = pk2(o[0], o[1]); w.y = pk2(o[2], o[3]); *(u32x2*)(xb + off + bj * 128 + n * 16) = w; }
                    }
                ss += __shfl_xor(ss, 16); ss += __shfl_xor(ss, 32);
                if (fq == 0) rsq[(size_t)row * 16 + u.pn * 4 + wc] = ss;
            }
    }
};
__device__ __forceinline__ float rstd_from16(const float* p) {
    const f32x4 a = *(const f32x4*)p, b = *(const f32x4*)(p + 4), c = *(const f32x4*)(p + 8), d = *(const f32x4*)(p + 12);
    const float s = ((a[0] + a[1]) + (a[2] + a[3])) + ((b[0] + b[1]) + (b[2] + b[3])) + ((c[0] + c[1]) + (c[2] + c[3])) + ((d[0] + d[1]) + (d[2] + d[3]));
    return 1.0f / sqrtf(s * (1.0f / 1024.0f) + NORM_EPS);
}
struct EpiQkv1 {
    static constexpr bool PERM = true;
    bf16_t* O; size_t split_stride; const float* rsq;
    __device__ __forceinline__ void operator()(const f32x4 (&acc)[2][2][4][2], const pg8::Unit& u, int wr, int wc, int fr, int fq) const {
        const int t = u.pn >> 3; bf16_t* base = O + (size_t)t * split_stride; const int colt = (u.pn & 7) * 256; const float sc = (t == 0) ? QSCALE : 1.0f;
        const int row0 = u.pm * 256 + wr * 64 + fr, col0 = colt + wc * 32 + 8 * fq;
#pragma unroll
        for (int ai = 0; ai < 2; ++ai)
#pragma unroll
            for (int m = 0; m < 4; ++m) {
                const int row = row0 + ai * 128 + m * 16; const float rs = rstd_from16(rsq + (size_t)row * 16) * sc; bf16_t* rowp = base + (size_t)row * 2048 + col0;
#pragma unroll
                for (int bj = 0; bj < 2; ++bj) { const f32x4 v0 = acc[ai][bj][m][0] * rs, v1 = acc[ai][bj][m][1] * rs;
                    u32x4 w; w.x = pk2(v0[0], v0[1]); w.y = pk2(v0[2], v0[3]); w.z = pk2(v1[0], v1[1]); w.w = pk2(v1[2], v1[3]); *(u32x4*)(rowp + bj * 128) = w; }
            }
    }
};
struct EpiGate1 {
    static constexpr bool PERM = true;
    bf16_t* O; const float* rsq;
    __device__ __forceinline__ void operator()(const f32x4 (&acc)[2][2][4][2], const pg8::Unit& u, int wr, int wc, int fr, int fq) const {
        const int row0 = u.pm * 256 + wr * 64 + fr, col0 = u.pn * 256 + wc * 32 + 8 * fq;
#pragma unroll
        for (int ai = 0; ai < 2; ++ai)
#pragma unroll
            for (int m = 0; m < 4; ++m) {
                const int row = row0 + ai * 128 + m * 16; const float rs = rstd_from16(rsq + (size_t)row * 16); bf16_t* rowp = O + (size_t)row * 2048 + col0;
#pragma unroll
                for (int bj = 0; bj < 2; ++bj) { const f32x4 v0 = acc[ai][bj][m][0] * rs, v1 = acc[ai][bj][m][1] * rs; const u32x4 o = *(const u32x4*)(rowp + bj * 128);
                    u32x4 w; w.x = pk2(bf_lo(o.x) * silu_f(v0[0]), bf_hi(o.x) * silu_f(v0[1])); w.y = pk2(bf_lo(o.y) * silu_f(v0[2]), bf_hi(o.y) * silu_f(v0[3]));
                    w.z = pk2(bf_lo(o.z) * silu_f(v1[0]), bf_hi(o.z) * silu_f(v1[1])); w.w = pk2(bf_lo(o.w) * silu_f(v1[2]), bf_hi(o.w) * silu_f(v1[3])); *(u32x4*)(rowp + bj * 128) = w; }
            }
    }
};
struct HookSsdNorm {
    const float* ssq;
    __device__ __forceinline__ void begin(const pg8::Unit& u, LAS unsigned char* lds) const {
        LAS float* T = (LAS float*)(lds + RING_BYTES);
        const int t = threadIdx.x;
        if (t < 256) { const float* p = ssq + (size_t)(u.pm * 256 + t) * 16; const f32x4 a = *(const f32x4*)p, b = *(const f32x4*)(p + 4), c = *(const f32x4*)(p + 8), d = *(const f32x4*)(p + 12);
            const float g0 = ((a[0] + a[1]) + (a[2] + a[3])) + ((b[0] + b[1]) + (b[2] + b[3])), g1 = ((c[0] + c[1]) + (c[2] + c[3])) + ((d[0] + d[1]) + (d[2] + d[3]));
            const float r0 = 1.0f / sqrtf(g0 * (1.0f / 512.0f) + NORM_EPS), r1 = 1.0f / sqrtf(g1 * (1.0f / 512.0f) + NORM_EPS);
            T[2 * t] = r0 / r1; T[2 * t + 1] = r1; }
    }
    __device__ __forceinline__ void at(f32x4 (&acc)[2][2][4][2], int t, int wr, int fr, LAS unsigned char* lds) const {
        if (t == 8 || t == 16) {
            const LAS float* T = (const LAS float*)(lds + RING_BYTES); const int sel = (t == 16);
#pragma unroll
            for (int ai = 0; ai < 2; ++ai)
#pragma unroll
                for (int m = 0; m < 4; ++m) { const float f = T[2 * (ai * 128 + wr * 64 + m * 16 + fr) + sel];
#pragma unroll
                    for (int bj = 0; bj < 2; ++bj)
#pragma unroll
                        for (int n = 0; n < 2; ++n) acc[ai][bj][m][n] = acc[ai][bj][m][n] * f; }
        }
    }
};

__device__ __forceinline__ void transpose_item(const float* W, int K, int Nsrc, int src_col0, bf16_t* WT, int dst_row0, const float* gain, int gain_n, LAS float* scr, int kb, int nb, int lane) {
    const int k0 = 64 * kb, n0 = 32 * nb;
    float wv[32];
#pragma unroll
    for (int i = 0; i < 32; ++i) wv[i] = W[(size_t)(k0 + 2 * i + (lane >> 5)) * Nsrc + src_col0 + n0 + (lane & 31)];
#pragma unroll
    for (int i = 0; i < 32; ++i) { const int kk = 2 * i + (lane >> 5); const int k = k0 + kk; const float gsc = (gain && k < gain_n) ? gain[k] : 1.0f;
        scr[kk * 33 + (lane & 31)] = wv[i] * gsc; }
    asm volatile("s_waitcnt lgkmcnt(0)" ::: "memory");
    const int c = lane & 7;
#pragma unroll
    for (int j = 0; j < 4; ++j) { const int n = (lane >> 3) + 8 * j; const LAS float* s = scr + (8 * c) * 33 + n;
        u32x4 o; o.x = pk2(s[0 * 33], s[1 * 33]); o.y = pk2(s[2 * 33], s[3 * 33]); o.z = pk2(s[4 * 33], s[5 * 33]); o.w = pk2(s[6 * 33], s[7 * 33]);
        *(u32x4*)(WT + (size_t)(dst_row0 + n0 + n) * K + k0 + 8 * c) = o; }
    asm volatile("s_waitcnt lgkmcnt(0)" ::: "memory");
}
__device__ __forceinline__ float softplus_f(float v) { return v > 20.f ? v : log1pf(expf(v)); }

__device__ __forceinline__ void phase_prep(const Params& P, LAS unsigned char* lds, int G) {
    const int tid = threadIdx.x, lane = tid & 63, wave = tid >> 6;
    const int gw = blockIdx.x * 8 + wave, NGW = G * 8;
    unsigned char* ws = P.ws;
    if (blockIdx.x == 0 && tid < 256) ((unsigned*)(ws + WS_CTL))[tid] = 0u;
    {
        LAS float* scr = (LAS float*)(lds + wave * 16384);
        bf16_t* W0T = (bf16_t*)(ws + WS_W0T); bf16_t* WO0T = (bf16_t*)(ws + WS_WO0T); bf16_t* W1T = (bf16_t*)(ws + WS_W1T); bf16_t* WO1T = (bf16_t*)(ws + WS_WO1T);
        constexpr int I0 = 16 * 208, IO0 = 32 * 32, I1 = 16 * 256, IO1 = 32 * 32;
        for (int it = gw; it < I0 + IO0 + I1 + IO1; it += NGW) {
            int r = it;
            if (r < I0) { const int kb = r / 208, nb = r % 208; const int n0 = nb * 32;
                int src; if (n0 < 1024) src = n0; else if (n0 < 2048) src = n0 - 1024 + 5648; else if (n0 < 3584) src = n0 - 2048 + 1024; else src = n0 - 3584 + 2576;
                transpose_item(P.w_in0, 1024, EVEN_IN, src - n0, W0T, 0, P.even_norm, 1024, scr, kb, nb, lane); continue; }
            r -= I0;
            if (r < IO0) { transpose_item(P.w_out0, 2048, 1024, 0, WO0T, 0, P.ssd_norm, 1024, scr, r / 32, r % 32, lane); continue; }
            r -= IO0;
            if (r < I1) { transpose_item(P.w_in1, 1024, 8192, 0, W1T, 0, P.odd_norm, 1024, scr, r / 256, r % 256, lane); continue; }
            r -= I1;
            transpose_item(P.w_out1, 2048, 1024, 0, WO1T, 0, nullptr, 0, scr, r / 32, r % 32, lane);
        }
    }
    __syncthreads();
    {
        LAS float* Wd = (LAS float*)lds;
        for (int i = tid; i < 16 * 1024; i += NTHREADS) { const int k = i >> 4, h = i & 15; Wd[h * 1024 + k] = P.w_in0[(size_t)k * EVEN_IN + 2560 + h] * P.even_norm[k]; }
        __syncthreads();
        bf16_t* xb = (bf16_t*)P.out; float* rstd0 = (float*)(ws + WS_RSTD0); float* dt = (float*)(ws + WS_DT);
        for (int m = gw; m < MTOK; m += NGW) {
            const f32x4* xr = (const f32x4*)(P.x + (size_t)m * DM) + lane;
            f32x4 v[4]; float s = 0.f;
#pragma unroll
            for (int j = 0; j < 4; ++j) { v[j] = xr[64 * j]; s += (v[j][0] * v[j][0] + v[j][1] * v[j][1]) + (v[j][2] * v[j][2] + v[j][3] * v[j][3]); }
            const float rs = 1.0f / sqrtf(wave_sum(s) * (1.0f / DM) + NORM_EPS);
            unsigned long long* o8 = (unsigned long long*)(xb + (size_t)m * DM) + lane;
#pragma unroll
            for (int j = 0; j < 4; ++j) o8[64 * j] = (unsigned long long)pk2(v[j][0], v[j][1]) | ((unsigned long long)pk2(v[j][2], v[j][3]) << 32);
            float mine = 0.f;
#pragma unroll 1
            for (int h = 0; h < 16; ++h) { float a = 0.f;
#pragma unroll
                for (int j = 0; j < 4; ++j) { const f32x4 w = *(const LAS f32x4*)(Wd + h * 1024 + 256 * j + 4 * lane); a += (v[j][0] * w[0] + v[j][1] * w[1]) + (v[j][2] * w[2] + v[j][3] * w[3]); }
                a = wave_sum(a); if (lane == h) mine = a; }
            if (lane == 0) rstd0[m] = rs;
            if (lane < 16) dt[(size_t)m * 16 + lane] = softplus_f(mine * rs + P.dt_bias[lane]);
        }
    }
}

__device__ __forceinline__ void ssd_item(const Params& P, LAS unsigned char* lds, int b, int h) {
    constexpr int TT = 64;
    const int tid = threadIdx.x;
    unsigned char* ws = P.ws;
    const bf16_t* XBC = (const bf16_t*)(ws + WS_XBC); bf16_t* Y0 = (bf16_t*)(ws + WS_Y0); const float* dt = (const float*)(ws + WS_DT); float* ssq = (float*)(ws + WS_SSQ);
    LAS float* xc = (LAS float*)lds;
    LAS float* Bc = xc + TT * 64;
    LAS float* Cc = Bc + TT * 128;
    LAS float* zs = Cc + TT * 128;
    LAS float* uo = zs + TT * 64;
    LAS float* dtv = uo + TT * 64;
    LAS float* dec = dtv + TT;
    const int g = h >> 3;
    const float a = -expf(P.a_log[h]), Dh = P.d_skip[h];
    const int p = tid >> 3, ng = tid & 7;
    float st[16];
#pragma unroll
    for (int i = 0; i < 16; ++i) st[i] = 0.f;
    int ch = 0; float cw0 = 0.f, cw1 = 0.f, cw2 = 0.f, cw3 = 0.f, cb = 0.f;
    if (tid < 320) { ch = tid < 64 ? h * 64 + tid : (tid < 192 ? 1024 + g * 128 + (tid - 64) : 1280 + g * 128 + (tid - 192));
        cw0 = P.conv_w[ch]; cw1 = P.conv_w[1536 + ch]; cw2 = P.conv_w[2 * 1536 + ch]; cw3 = P.conv_w[3 * 1536 + ch]; cb = P.conv_b[ch]; }
    for (int t0 = 0; t0 < SEQ; t0 += TT) {
        const size_t tok0 = (size_t)b * SEQ + t0;
        if (tid < 320) {
            float w0 = 0.f, w1 = 0.f, w2 = 0.f;
            if (t0 > 0) { w0 = bf2f(XBC[(tok0 - 3) * 1536 + ch]); w1 = bf2f(XBC[(tok0 - 2) * 1536 + ch]); w2 = bf2f(XBC[(tok0 - 1) * 1536 + ch]); }
            LAS float* dst = tid < 64 ? xc + tid : (tid < 192 ? Bc + (tid - 64) : Cc + (tid - 192)); const int dstride = tid < 64 ? 64 : 128;
            for (int tt = 0; tt < TT; ++tt) { const float w3 = bf2f(XBC[(tok0 + tt) * 1536 + ch]);
                const float v = cb + cw0 * w0 + cw1 * w1 + cw2 * w2 + cw3 * w3; dst[tt * dstride] = silu_f(v); w0 = w1; w1 = w2; w2 = w3; }
        } else if (tid < 320 + TT) { const int tt = tid - 320; const float d = dt[(tok0 + tt) * 16 + h]; dtv[tt] = d; dec[tt] = expf(d * a); }
        for (int i = tid; i < TT * 64; i += NTHREADS) { const int tt = i >> 6, pp = i & 63; zs[i] = bf2f(Y0[(tok0 + tt) * 2048 + h * 64 + pp]); }
        __syncthreads();
        for (int tt = 0; tt < TT; ++tt) {
            const float xv = xc[tt * 64 + p], xdt = xv * dtv[tt], dc = dec[tt];
            const LAS float* Bp = Bc + tt * 128 + 16 * ng; const LAS float* Cp = Cc + tt * 128 + 16 * ng;
            float yp = 0.f;
#pragma unroll
            for (int i = 0; i < 16; ++i) { st[i] = st[i] * dc + xdt * Bp[i]; yp += st[i] * Cp[i]; }
            yp += __shfl_xor(yp, 1); yp += __shfl_xor(yp, 2); yp += __shfl_xor(yp, 4);
            if (ng == 0) uo[tt * 64 + p] = (yp + Dh * xv) * zs[tt * 64 + p];
        }
        __syncthreads();
        { const int tt = tid >> 3, part = tid & 7; const LAS float* up = uo + tt * 64 + part * 8; float v[8]; float ss = 0.f;
#pragma unroll
            for (int e = 0; e < 8; ++e) { v[e] = up[e]; ss += v[e] * v[e]; }
            u32x4 w; w.x = pk2(v[0], v[1]); w.y = pk2(v[2], v[3]); w.z = pk2(v[4], v[5]); w.w = pk2(v[6], v[7]);
            *(u32x4*)(Y0 + (tok0 + tt) * 2048 + h * 64 + part * 8) = w;
            ss += __shfl_xor(ss, 1); ss += __shfl_xor(ss, 2); ss += __shfl_xor(ss, 4);
            if (part == 0) ssq[(tok0 + tt) * 16 + h] = ss; }
        __syncthreads();
    }
}

struct KeysDilated {
    __device__ __forceinline__ int nkeys(int) const { return 387; }
    __device__ __forceinline__ int keypos(int qpos, int idx) const { const int pt = idx / 129, j = idx - pt * 129; return qpos - (j << (2 * pt)); }
};
struct KeysMoba {
    const LAS int* sel;
    int q0;
    __device__ __forceinline__ int nkeys(int qpos) const { return sel[(qpos - q0) * 4] * 256 + (qpos & 255) + 1; }
    __device__ __forceinline__ int keypos(int qpos, int idx) const { const LAS int* s = sel + (qpos - q0) * 4; const int ns = s[0];
        if (idx < ns * 256) return s[1 + (idx >> 8)] * 256 + (idx & 255);
        return (qpos & ~255) + (idx - ns * 256); }
};
template <class KS>
__device__ __forceinline__ void attn_simple_core(const KS& ks, LAS float* qs, LAS float* Ssc, const bf16_t* Kp, const bf16_t* Vp, int ld, int q0, float (&o)[8], float& lsum) {
    const int tid = threadIdx.x, qi = tid >> 4, part = tid & 15;
    const int qpos = q0 + qi, nk = ks.nkeys(qpos);
    LAS float* Sr = Ssc + qi * 1024; const LAS float* qr = qs + qi * 128;
    float mx = -3.0e38f;
    for (int idx = part; idx < nk; idx += 16) {
        const int pos = ks.keypos(qpos, idx); float s = -__builtin_inff();
        if (pos >= 0) { const u32x4* kr = (const u32x4*)(Kp + (size_t)pos * ld); float a = 0.f;
#pragma unroll
            for (int c = 0; c < 16; ++c) { const u32x4 w = kr[c]; const f32x4 q0v = *(const LAS f32x4*)(qr + 8 * c), q1v = *(const LAS f32x4*)(qr + 8 * c + 4);
                a += (bf_lo(w.x) * q0v[0] + bf_hi(w.x) * q0v[1]) + (bf_lo(w.y) * q0v[2] + bf_hi(w.y) * q0v[3]) + (bf_lo(w.z) * q1v[0] + bf_hi(w.z) * q1v[1]) + (bf_lo(w.w) * q1v[2] + bf_hi(w.w) * q1v[3]); }
            s = a; }
        Sr[idx] = s; mx = fmaxf(mx, s);
    }
    mx = fmaxf(mx, __shfl_xor(mx, 1)); mx = fmaxf(mx, __shfl_xor(mx, 2)); mx = fmaxf(mx, __shfl_xor(mx, 4)); mx = fmaxf(mx, __shfl_xor(mx, 8));
    float l = 0.f;
    for (int idx = part; idx < nk; idx += 16) { const float pv = exp2f(Sr[idx] - mx); Sr[idx] = pv; l += pv; }
    l += __shfl_xor(l, 1); l += __shfl_xor(l, 2); l += __shfl_xor(l, 4); l += __shfl_xor(l, 8);
    lsum = l;
    asm volatile("s_waitcnt lgkmcnt(0)" ::: "memory");
    __syncthreads();
#pragma unroll
    for (int e = 0; e < 8; ++e) o[e] = 0.f;
    for (int idx = 0; idx < nk; ++idx) {
        const float pv = Sr[idx];
        if (pv != 0.f) { const int pos = ks.keypos(qpos, idx); const u32x4 w = *(const u32x4*)(Vp + (size_t)pos * ld + 8 * part);
            o[0] += pv * bf_lo(w.x); o[1] += pv * bf_hi(w.x); o[2] += pv * bf_lo(w.y); o[3] += pv * bf_hi(w.y); o[4] += pv * bf_lo(w.z); o[5] += pv * bf_hi(w.z); o[6] += pv * bf_lo(w.w); o[7] += pv * bf_hi(w.w); }
    }
}
__device__ __forceinline__ void load_q_tile(LAS float* qs, const bf16_t* Qp, int ld) {
    const int tid = threadIdx.x, r = tid >> 4, c = tid & 15;
    const u32x4 w = *(const u32x4*)(Qp + (size_t)r * ld + 8 * c); LAS float* d = qs + r * 128 + 8 * c;
    d[0] = bf_lo(w.x); d[1] = bf_hi(w.x); d[2] = bf_lo(w.y); d[3] = bf_hi(w.y); d[4] = bf_lo(w.z); d[5] = bf_hi(w.z); d[6] = bf_lo(w.w); d[7] = bf_hi(w.w);
}
__device__ __forceinline__ void moba_item(const Params& P, LAS unsigned char* lds, int b, int h, int qt) {
    unsigned char* ws = P.ws; const int tid = threadIdx.x;
    LAS float* Ssc = (LAS float*)lds; LAS float* qs = (LAS float*)(lds + 131072); LAS float* gts = (LAS float*)(lds + 131072 + 16384); LAS int* sel = (LAS int*)(lds + 131072 + 16384 + 1024);
    const bf16_t* Q0 = (const bf16_t*)(ws + WS_Q0) + (size_t)b * SEQ * 1024 + h * 128; const bf16_t* K0 = (const bf16_t*)(ws + WS_K0) + (size_t)b * SEQ * 1024 + h * 128;
    const bf16_t* V0 = (const bf16_t*)(ws + WS_V0) + (size_t)b * SEQ * 1024 + h * 128; bf16_t* Y0 = (bf16_t*)(ws + WS_Y0) + (size_t)b * SEQ * 2048 + 1024 + h * 128;
    const float* kpart = (const float*)(ws + WS_KPART);
    const int q0 = qt * 32, qb = q0 >> 8;
    __syncthreads();
    load_q_tile(qs, Q0 + (size_t)q0 * 1024, 1024);
    __syncthreads();
    { const int qi = tid >> 4, n = tid & 15;
        if (n < qb) { const float* k0p = kpart + ((size_t)(b * 8 + n) * 2) * 1024 + h * 128; const float* k1p = k0p + 1024; float a = 0.f;
            for (int d = 0; d < 128; ++d) a += qs[qi * 128 + d] * (k0p[d] + k1p[d]);
            gts[qi * 8 + n] = a; } }
    __syncthreads();
    if (tid < 32) { const int ns = qb < 3 ? qb : 3; int s0 = -1, s1 = -1, s2 = -1; float g0 = -__builtin_inff(), g1 = g0, g2 = g0;
        for (int n = 0; n < qb; ++n) { const float gv = gts[tid * 8 + n];
            if (gv > g0) { g2 = g1; s2 = s1; g1 = g0; s1 = s0; g0 = gv; s0 = n; } else if (gv > g1) { g2 = g1; s2 = s1; g1 = gv; s1 = n; } else if (gv > g2) { g2 = gv; s2 = n; } }
        sel[tid * 4] = ns; sel[tid * 4 + 1] = s0 < 0 ? 0 : s0; sel[tid * 4 + 2] = s1 < 0 ? 0 : s1; sel[tid * 4 + 3] = s2 < 0 ? 0 : s2; }
    __syncthreads();
    KeysMoba ks{sel, q0}; float o[8]; float l;
    attn_simple_core(ks, qs, Ssc, K0, V0, 1024, q0, o, l);
    const int qi = tid >> 4, part = tid & 15; const float inv = 1.0f / l;
    bf16_t* yp = Y0 + (size_t)(q0 + qi) * 2048 + 8 * part; const u32x4 gw = *(const u32x4*)yp;
    u32x4 w; w.x = pk2(o[0] * inv * bf_lo(gw.x), o[1] * inv * bf_hi(gw.x)); w.y = pk2(o[2] * inv * bf_lo(gw.y), o[3] * inv * bf_hi(gw.y));
    w.z = pk2(o[4] * inv * bf_lo(gw.z), o[5] * inv * bf_hi(gw.z)); w.w = pk2(o[6] * inv * bf_lo(gw.w), o[7] * inv * bf_hi(gw.w));
    *(u32x4*)yp = w;
}
__device__ __forceinline__ void dilated_item(const Params& P, LAS unsigned char* lds, int b, int h, int qt) {
    unsigned char* ws = P.ws; const int tid = threadIdx.x;
    LAS float* Ssc = (LAS float*)lds; LAS float* qs = (LAS float*)(lds + 131072);
    bf16_t* Q1 = (bf16_t*)(ws + WS_QO1) + (size_t)b * SEQ * 2048 + h * 128; const bf16_t* K1 = (const bf16_t*)(ws + WS_K1) + (size_t)b * SEQ * 2048 + h * 128;
    const bf16_t* V1 = (const bf16_t*)(ws + WS_V1) + (size_t)b * SEQ * 2048 + h * 128;
    const int q0 = qt * 32;
    __syncthreads();
    load_q_tile(qs, Q1 + (size_t)q0 * 2048, 2048);
    __syncthreads();
    KeysDilated ks; float o[8]; float l;
    attn_simple_core(ks, qs, Ssc, K1, V1, 2048, q0, o, l);
    const int qi = tid >> 4, part = tid & 15; const float inv = 1.0f / l;
    u32x4 w; w.x = pk2(o[0] * inv, o[1] * inv); w.y = pk2(o[2] * inv, o[3] * inv); w.z = pk2(o[4] * inv, o[5] * inv); w.w = pk2(o[6] * inv, o[7] * inv);
    *(u32x4*)(Q1 + (size_t)(q0 + qi) * 2048 + 8 * part) = w;
}

typedef short s16x4 __attribute__((ext_vector_type(4)));
constexpr int KSTR = 272, VSTR = 288;
#define MFMA16(a, b, c) __builtin_amdgcn_mfma_f32_16x16x32_bf16((a), (b), (c), 0, 0, 0)
struct WTile { bf16x8 qf[4]; f32x4 o[8]; float m, l; };
__device__ __forceinline__ void wt_reset(WTile& w) {
#pragma unroll
    for (int d = 0; d < 8; ++d) w.o[d] = (f32x4){0.f, 0.f, 0.f, 0.f};
    w.m = -1.0e30f; w.l = 0.f;
}
__device__ __forceinline__ void wt_load_q(WTile& w, const bf16_t* qrow, int lane) {
    const int g = lane >> 4;
#pragma unroll
    for (int ks = 0; ks < 4; ++ks) w.qf[ks] = *(const bf16x8*)(qrow + 32 * ks + 8 * g);
}
__device__ __forceinline__ void wt_qk_lds(const WTile& w, const LAS unsigned char* Kb, int lane, f32x4& s0, f32x4& s1) {
    const LAS unsigned char* p = Kb + (lane & 15) * KSTR + (lane >> 4) * 16;
    s0 = (f32x4){0.f, 0.f, 0.f, 0.f}; s1 = s0;
#pragma unroll
    for (int ks = 0; ks < 4; ++ks) { const bf16x8 a0 = *(const LAS bf16x8*)(p + ks * 64), a1 = *(const LAS bf16x8*)(p + 16 * KSTR + ks * 64);
        s0 = MFMA16(a0, w.qf[ks], s0); s1 = MFMA16(a1, w.qf[ks], s1); }
}
__device__ __forceinline__ void wt_softmax_pv(WTile& w, f32x4 s0, f32x4 s1, const LAS unsigned char* Vb, int lane) {
    float mx = fmaxf(fmaxf(fmaxf(s0[0], s0[1]), fmaxf(s0[2], s0[3])), fmaxf(fmaxf(s1[0], s1[1]), fmaxf(s1[2], s1[3])));
    mx = fmaxf(mx, __shfl_xor(mx, 16)); mx = fmaxf(mx, __shfl_xor(mx, 32));
    const float mn = fmaxf(w.m, mx), alpha = __builtin_amdgcn_exp2f(w.m - mn);
    w.m = mn;
    float p[8];
#pragma unroll
    for (int r = 0; r < 4; ++r) { p[r] = __builtin_amdgcn_exp2f(s0[r] - mn); p[4 + r] = __builtin_amdgcn_exp2f(s1[r] - mn); }
    w.l = w.l * alpha + (((p[0] + p[1]) + (p[2] + p[3])) + ((p[4] + p[5]) + (p[6] + p[7])));
    u32x4 pw; pw.x = pk2(p[0], p[1]); pw.y = pk2(p[2], p[3]); pw.z = pk2(p[4], p[5]); pw.w = pk2(p[6], p[7]);
    const bf16x8 pf = __builtin_bit_cast(bf16x8, pw);
    const int i = lane & 15, g = lane >> 4;
    const LAS unsigned char* vp = Vb + (4 * g + (i >> 2)) * VSTR + (i & 3) * 8;
#pragma unroll
    for (int dt = 0; dt < 8; ++dt) {
        const s16x4 lo = __builtin_amdgcn_ds_read_tr16_b64_v4i16((LAS s16x4*)(vp + dt * 32));
        const s16x4 hi = __builtin_amdgcn_ds_read_tr16_b64_v4i16((LAS s16x4*)(vp + 16 * VSTR + dt * 32));
        const bf16x8 vf = __builtin_shufflevector(lo, hi, 0, 1, 2, 3, 4, 5, 6, 7);
        w.o[dt] = MFMA16(vf, pf, w.o[dt] * alpha);
    }
}

__device__ __forceinline__ void conv_prepass(const Params& P, int G) {
    const bf16_t* XBC = (const bf16_t*)(P.ws + WS_XBC); bf16_t* XC = (bf16_t*)P.out;
    const int ntask = 192 * 1024;
    for (int task = blockIdx.x * NTHREADS + threadIdx.x; task < ntask; task += G * NTHREADS) {
        const int cg8 = task % 192, run = task / 192, ch = 8 * cg8; const size_t tok0 = (size_t)run * 16; const bool first = (run & 127) == 0;
        u32x4 raw[19];
#pragma unroll
        for (int j = 0; j < 19; ++j) { raw[j] = (u32x4){0u, 0u, 0u, 0u}; if (j >= 3 || !first) raw[j] = *(const u32x4*)(XBC + (tok0 + j - 3) * 1536 + ch); }
        float cw[4][8], cb[8];
#pragma unroll
        for (int j = 0; j < 4; ++j) { const f32x4 a = *(const f32x4*)(P.conv_w + j * 1536 + ch), b2 = *(const f32x4*)(P.conv_w + j * 1536 + ch + 4);
#pragma unroll
            for (int e = 0; e < 4; ++e) { cw[j][e] = a[e]; cw[j][4 + e] = b2[e]; } }
        { const f32x4 a = *(const f32x4*)(P.conv_b + ch), b2 = *(const f32x4*)(P.conv_b + ch + 4);
#pragma unroll
            for (int e = 0; e < 4; ++e) { cb[e] = a[e]; cb[4 + e] = b2[e]; } }
#pragma unroll
        for (int tt = 0; tt < 16; ++tt) { float o[8];
#pragma unroll
            for (int e = 0; e < 8; ++e) { float acc = cb[e];
#pragma unroll
                for (int j = 0; j < 4; ++j) { const unsigned wq = (e < 2) ? raw[tt + j].x : (e < 4 ? raw[tt + j].y : (e < 6 ? raw[tt + j].z : raw[tt + j].w)); acc += cw[j][e] * ((e & 1) ? bf_hi(wq) : bf_lo(wq)); }
                o[e] = silu_f(acc); }
            u32x4 w; w.x = pk2(o[0], o[1]); w.y = pk2(o[2], o[3]); w.z = pk2(o[4], o[5]); w.w = pk2(o[6], o[7]);
            *(u32x4*)(XC + (tok0 + tt) * 1536 + ch) = w; }
    }
}

constexpr int SI_B = 0, SI_C = 34816, SI_XT = 69632, SI_PREV = 87040, SI_ARR = 121856, SI_STR = 272;
__device__ __forceinline__ void ssd_item_mfma(const Params& P, LAS unsigned char* lds, int b, int h) {
    int tid_ = threadIdx.x; asm volatile("" : "+v"(tid_));
    const int tid = tid_, lane = tid & 63, w = __builtin_amdgcn_readfirstlane(tid >> 6), i = lane & 15, g = lane >> 4;
    unsigned char* ws = P.ws;
    const bf16_t* XBC = (const bf16_t*)(ws + WS_XBC); bf16_t* Y0 = (bf16_t*)(ws + WS_Y0); const float* dtg = (const float*)(ws + WS_DT); float* ssq = (float*)(ws + WS_SSQ);
    LAS unsigned char* Bi = lds + SI_B; LAS unsigned char* Ci = lds + SI_C; LAS unsigned char* XT = lds + SI_XT;
    LAS float* A2 = (LAS float*)(lds + SI_ARR); LAS float* A3 = A2 + 128; LAS float* WL = A2 + 256; LAS float* EL = A2 + 384; LAS float* CD = A2 + 512;
    const int grp = h >> 3;
    const float a2 = -expf(P.a_log[h]) * 1.4426950408889634f, Dh = P.d_skip[h];
    const bf16_t* XC = (const bf16_t*)P.out;
    f32x4 carry[4];
#pragma unroll
    for (int pt = 0; pt < 4; ++pt) carry[pt] = (f32x4){0.f, 0.f, 0.f, 0.f};
    __syncthreads();
#pragma unroll 1
    for (int c = 0; c < 16; ++c) {
        const size_t tok0 = (size_t)b * SEQ + c * 128;
        {
            const int r0 = tid >> 4, c16 = tid & 15;
            u32x4 bq[4], cq[4], xq[2];
#pragma unroll
            for (int j = 0; j < 4; ++j) { const bf16_t* rp = XC + (tok0 + r0 + 32 * j) * 1536 + 1024 + grp * 128 + 8 * c16; bq[j] = *(const u32x4*)rp; cq[j] = *(const u32x4*)(rp + 256); }
            const int xr0 = tid >> 3, xc = tid & 7;
#pragma unroll
            for (int j = 0; j < 2; ++j) xq[j] = *(const u32x4*)(XC + (tok0 + xr0 + 64 * j) * 1536 + h * 64 + 8 * xc);
#pragma unroll
            for (int j = 0; j < 4; ++j) { *(LAS u32x4*)(Bi + (r0 + 32 * j) * SI_STR + c16 * 16) = bq[j]; *(LAS u32x4*)(Ci + (r0 + 32 * j) * SI_STR + c16 * 16) = cq[j]; }
#pragma unroll
            for (int j = 0; j < 2; ++j) { const int l = xr0 + 64 * j; LAS unsigned char* xp = XT + (8 * xc) * SI_STR + l * 2; const u32x4 v = xq[j];
                *(LAS bf16_t*)(xp) = (bf16_t)(v.x & 0xffffu); *(LAS bf16_t*)(xp + SI_STR) = (bf16_t)(v.x >> 16); *(LAS bf16_t*)(xp + 2 * SI_STR) = (bf16_t)(v.y & 0xffffu); *(LAS bf16_t*)(xp + 3 * SI_STR) = (bf16_t)(v.y >> 16);
                *(LAS bf16_t*)(xp + 4 * SI_STR) = (bf16_t)(v.z & 0xffffu); *(LAS bf16_t*)(xp + 5 * SI_STR) = (bf16_t)(v.z >> 16); *(LAS bf16_t*)(xp + 6 * SI_STR) = (bf16_t)(v.w & 0xffffu); *(LAS bf16_t*)(xp + 7 * SI_STR) = (bf16_t)(v.w >> 16); }
        }
        if (w == 7) {
            const float d0 = dtg[(tok0 + lane) * 16 + h], d1 = dtg[(tok0 + 64 + lane) * 16 + h];
            float v0 = d0 * a2, v1 = d1 * a2;
#pragma unroll
            for (int o = 1; o < 64; o <<= 1) { const float t0 = __shfl_up(v0, o), t1 = __shfl_up(v1, o); if (lane >= o) { v0 += t0; v1 += t1; } }
            v1 += __shfl(v0, 63);
            const float aend = __shfl(v1, 63);
            A2[lane] = v0; A2[64 + lane] = v1; A3[lane] = v0 - __log2f(d0); A3[64 + lane] = v1 - __log2f(d1);
            WL[lane] = d0 * __builtin_amdgcn_exp2f(aend - v0); WL[64 + lane] = d1 * __builtin_amdgcn_exp2f(aend - v1);
            EL[lane] = __builtin_amdgcn_exp2f(v0); EL[64 + lane] = __builtin_amdgcn_exp2f(v1);
            if (lane == 0) CD[0] = __builtin_amdgcn_exp2f(aend);
        }
        __syncthreads();
        const LAS unsigned char* PV = lds + SI_PREV + (c & 1) * 17408; LAS unsigned char* PN = lds + SI_PREV + ((c & 1) ^ 1) * 17408;
        const int lidx = 16 * w + i;
        bf16x8 cf[4];
#pragma unroll
        for (int ks = 0; ks < 4; ++ks) cf[ks] = *(const LAS bf16x8*)(Ci + lidx * SI_STR + (32 * ks + 8 * g) * 2);
        f32x4 yd[4], yo[4];
#pragma unroll
        for (int pt = 0; pt < 4; ++pt) { yd[pt] = (f32x4){0.f, 0.f, 0.f, 0.f}; yo[pt] = yd[pt]; }
        const float A2l = A2[lidx];
#pragma unroll
        for (int sp = 0; sp < 4; ++sp) {
            if (2 * sp <= w) {
                f32x4 g0 = (f32x4){0.f, 0.f, 0.f, 0.f}, g1 = g0;
#pragma unroll
                for (int ks = 0; ks < 4; ++ks) { const bf16x8 b0 = *(const LAS bf16x8*)(Bi + (32 * sp + i) * SI_STR + (32 * ks + 8 * g) * 2), b1 = *(const LAS bf16x8*)(Bi + (32 * sp + 16 + i) * SI_STR + (32 * ks + 8 * g) * 2);
                    g0 = MFMA16(b0, cf[ks], g0); g1 = MFMA16(b1, cf[ks], g1); }
                const f32x4 a30 = *(const LAS f32x4*)(A3 + 32 * sp + 4 * g), a31 = *(const LAS f32x4*)(A3 + 32 * sp + 16 + 4 * g);
                float m[8];
#pragma unroll
                for (int r = 0; r < 4; ++r) { const int s0i = 32 * sp + 4 * g + r, s1i = s0i + 16;
                    m[r] = (s0i <= lidx) ? g0[r] * __builtin_amdgcn_exp2f(A2l - a30[r]) : 0.f; m[4 + r] = (s1i <= lidx) ? g1[r] * __builtin_amdgcn_exp2f(A2l - a31[r]) : 0.f; }
                u32x4 mw; mw.x = pk2(m[0], m[1]); mw.y = pk2(m[2], m[3]); mw.z = pk2(m[4], m[5]); mw.w = pk2(m[6], m[7]);
                const bf16x8 mf = __builtin_bit_cast(bf16x8, mw);
#pragma unroll
                for (int pt = 0; pt < 4; ++pt) { const u32x2 lo = *(const LAS u32x2*)(XT + (16 * pt + i) * SI_STR + (32 * sp + 4 * g) * 2), hi = *(const LAS u32x2*)(XT + (16 * pt + i) * SI_STR + (32 * sp + 16 + 4 * g) * 2);
                    const u32x4 xw = (u32x4){lo.x, lo.y, hi.x, hi.y}; yd[pt] = MFMA16(__builtin_bit_cast(bf16x8, xw), mf, yd[pt]); }
            }
        }
        if (c > 0) {
#pragma unroll
            for (int ks = 0; ks < 4; ++ks)
#pragma unroll
                for (int pt = 0; pt < 4; ++pt) { const bf16x8 pf = *(const LAS bf16x8*)(PV + (16 * pt + i) * SI_STR + (32 * ks + 8 * g) * 2); yo[pt] = MFMA16(pf, cf[ks], yo[pt]); }
        }
        {
            const float el = EL[lidx]; float ss = 0.f; bf16_t* yrow = Y0 + (tok0 + lidx) * 2048 + h * 64 + 4 * g;
#pragma unroll
            for (int pt = 0; pt < 4; ++pt) {
                const s16x4 xs = __builtin_amdgcn_ds_read_tr16_b64_v4i16((LAS s16x4*)(XT + (16 * pt + 4 * g + (i >> 2)) * SI_STR + (16 * w + 4 * (i & 3)) * 2));
                const u32x2 zw = *(const u32x2*)(yrow + 16 * pt); const float zf[4] = {bf_lo(zw.x), bf_hi(zw.x), bf_lo(zw.y), bf_hi(zw.y)}; float u[4];
#pragma unroll
                for (int r = 0; r < 4; ++r) { u[r] = (yd[pt][r] + el * yo[pt][r] + Dh * bf2f((bf16_t)xs[r])) * zf[r]; ss += u[r] * u[r]; }
                u32x2 uw; uw.x = pk2(u[0], u[1]); uw.y = pk2(u[2], u[3]); *(u32x2*)(yrow + 16 * pt) = uw;
            }
            ss += __shfl_xor(ss, 16); ss += __shfl_xor(ss, 32);
            if (g == 0) ssq[(tok0 + lidx) * 16 + h] = ss;
        }
        {
            f32x4 st[4];
#pragma unroll
            for (int pt = 0; pt < 4; ++pt) st[pt] = (f32x4){0.f, 0.f, 0.f, 0.f};
#pragma unroll
            for (int ks = 0; ks < 4; ++ks) {
                const s16x4 lo = __builtin_amdgcn_ds_read_tr16_b64_v4i16((LAS s16x4*)(Bi + (32 * ks + 8 * g + (i >> 2)) * SI_STR + (16 * w + 4 * (i & 3)) * 2));
                const s16x4 hi = __builtin_amdgcn_ds_read_tr16_b64_v4i16((LAS s16x4*)(Bi + (32 * ks + 8 * g + 4 + (i >> 2)) * SI_STR + (16 * w + 4 * (i & 3)) * 2));
                const f32x4 w0 = *(const LAS f32x4*)(WL + 32 * ks + 8 * g), w1 = *(const LAS f32x4*)(WL + 32 * ks + 8 * g + 4);
                u32x4 bw; bw.x = pk2(bf2f((bf16_t)lo[0]) * w0[0], bf2f((bf16_t)lo[1]) * w0[1]); bw.y = pk2(bf2f((bf16_t)lo[2]) * w0[2], bf2f((bf16_t)lo[3]) * w0[3]);
                bw.z = pk2(bf2f((bf16_t)hi[0]) * w1[0], bf2f((bf16_t)hi[1]) * w1[1]); bw.w = pk2(bf2f((bf16_t)hi[2]) * w1[2], bf2f((bf16_t)hi[3]) * w1[3]);
                const bf16x8 btf = __builtin_bit_cast(bf16x8, bw);
#pragma unroll
                for (int pt = 0; pt < 4; ++pt) { const bf16x8 xb = *(const LAS bf16x8*)(XT + (16 * pt + i) * SI_STR + (32 * ks + 8 * g) * 2); st[pt] = MFMA16(btf, xb, st[pt]); }
            }
            const float cd = CD[0];
#pragma unroll
            for (int pt = 0; pt < 4; ++pt) { carry[pt] = carry[pt] * cd + st[pt];
                u32x2 cwv; cwv.x = pk2(carry[pt][0], carry[pt][1]); cwv.y = pk2(carry[pt][2], carry[pt][3]); *(LAS u32x2*)(PN + (16 * pt + i) * SI_STR + (16 * w + 4 * g) * 2) = cwv; }
        }
        __syncthreads();
    }
}

__device__ __forceinline__ void wt_qk_lds64(const WTile& w, const LAS unsigned char* Kb, int lane, f32x4 (&s)[4]) {
    const LAS unsigned char* p = Kb + (lane & 15) * KSTR + (lane >> 4) * 16;
#pragma unroll
    for (int t = 0; t < 4; ++t) s[t] = (f32x4){0.f, 0.f, 0.f, 0.f};
#pragma unroll
    for (int ks = 0; ks < 4; ++ks)
#pragma unroll
        for (int t = 0; t < 4; ++t) { const bf16x8 a = *(const LAS bf16x8*)(p + t * 16 * KSTR + ks * 64); s[t] = MFMA16(a, w.qf[ks], s[t]); }
}
__device__ __forceinline__ void wt_softmax_pv64(WTile& w, const f32x4 (&s)[4], const LAS unsigned char* Vb, int lane) {
    float mx = fmaxf(fmaxf(s[0][0], s[0][1]), fmaxf(s[0][2], s[0][3]));
#pragma unroll
    for (int t = 1; t < 4; ++t) mx = fmaxf(mx, fmaxf(fmaxf(s[t][0], s[t][1]), fmaxf(s[t][2], s[t][3])));
    mx = fmaxf(mx, __shfl_xor(mx, 16)); mx = fmaxf(mx, __shfl_xor(mx, 32));
    const float mn = fmaxf(w.m, mx), alpha = __builtin_amdgcn_exp2f(w.m - mn);
    w.m = mn;
    float p[16]; float ps = 0.f;
#pragma unroll
    for (int t = 0; t < 4; ++t)
#pragma unroll
        for (int r = 0; r < 4; ++r) { p[4 * t + r] = __builtin_amdgcn_exp2f(s[t][r] - mn); ps += p[4 * t + r]; }
    w.l = w.l * alpha + ps;
    u32x4 pw0, pw1; pw0.x = pk2(p[0], p[1]); pw0.y = pk2(p[2], p[3]); pw0.z = pk2(p[4], p[5]); pw0.w = pk2(p[6], p[7]);
    pw1.x = pk2(p[8], p[9]); pw1.y = pk2(p[10], p[11]); pw1.z = pk2(p[12], p[13]); pw1.w = pk2(p[14], p[15]);
    const bf16x8 pf0 = __builtin_bit_cast(bf16x8, pw0), pf1 = __builtin_bit_cast(bf16x8, pw1);
    const int i = lane & 15, g = lane >> 4;
    const LAS unsigned char* vp = Vb + (4 * g + (i >> 2)) * VSTR + (i & 3) * 8;
#pragma unroll
    for (int dt = 0; dt < 8; ++dt) {
        const s16x4 l0 = __builtin_amdgcn_ds_read_tr16_b64_v4i16((LAS s16x4*)(vp + dt * 32));
        const s16x4 h0 = __builtin_amdgcn_ds_read_tr16_b64_v4i16((LAS s16x4*)(vp + 16 * VSTR + dt * 32));
        const s16x4 l1 = __builtin_amdgcn_ds_read_tr16_b64_v4i16((LAS s16x4*)(vp + 32 * VSTR + dt * 32));
        const s16x4 h1 = __builtin_amdgcn_ds_read_tr16_b64_v4i16((LAS s16x4*)(vp + 48 * VSTR + dt * 32));
        f32x4 acc = MFMA16(__builtin_shufflevector(l0, h0, 0, 1, 2, 3, 4, 5, 6, 7), pf0, w.o[dt] * alpha);
        w.o[dt] = MFMA16(__builtin_shufflevector(l1, h1, 0, 1, 2, 3, 4, 5, 6, 7), pf1, acc);
    }
}
constexpr int MB_TILE = 64 * KSTR + 64 * VSTR;
constexpr int MB_MISC = 3 * MB_TILE;
__device__ __forceinline__ void moba_item_mfma(const Params& P, LAS unsigned char* lds, int b, int h, int qt) {
    unsigned char* ws = P.ws; int tid_ = threadIdx.x; asm volatile("" : "+v"(tid_)); const int tid = tid_, lane = tid & 63, wave = __builtin_amdgcn_readfirstlane(tid >> 6);
    const bf16_t* Q0 = (const bf16_t*)(ws + WS_Q0) + (size_t)b * SEQ * 1024 + h * 128; const bf16_t* K0 = (const bf16_t*)(ws + WS_K0) + (size_t)b * SEQ * 1024 + h * 128;
    const bf16_t* V0 = (const bf16_t*)(ws + WS_V0) + (size_t)b * SEQ * 1024 + h * 128; bf16_t* Y0 = (bf16_t*)(ws + WS_Y0) + (size_t)b * SEQ * 2048 + 1024 + h * 128;
    const float* kpart = (const float*)(ws + WS_KPART);
    LAS float* ksum = (LAS float*)(lds + MB_MISC);
    LAS float* gts = ksum + 8 * 128;
    LAS int* selm = (LAS int*)(gts + 128 * 8);
    LAS int* tiles = selm + 128;
    LAS int* bmask = tiles + 48;
    const int q0 = qt * 128, qb = q0 >> 8;
    __syncthreads();
    for (int i = tid; i < qb * 128; i += NTHREADS) { const int n = i >> 7, d = i & 127; const float* kp = kpart + ((size_t)(b * 8 + n) * 2) * 1024 + h * 128 + d; ksum[i] = kp[0] + kp[1024]; }
    if (tid == 0) bmask[0] = 0;
    __syncthreads();
    { const int q = tid >> 2, nn = tid & 3; const u32x4* qr = (const u32x4*)(Q0 + (size_t)(q0 + q) * 1024);
        float a0 = 0.f, a1 = 0.f; const LAS float* k0p = ksum + nn * 128; const LAS float* k1p = ksum + (nn + 4) * 128;
        const bool d0 = nn < qb, d1 = nn + 4 < qb;
        if (d0) {
#pragma unroll 4
            for (int c = 0; c < 16; ++c) { const u32x4 w = qr[c]; const float qv[8] = {bf_lo(w.x), bf_hi(w.x), bf_lo(w.y), bf_hi(w.y), bf_lo(w.z), bf_hi(w.z), bf_lo(w.w), bf_hi(w.w)};
#pragma unroll
                for (int e = 0; e < 8; ++e) { a0 += qv[e] * k0p[8 * c + e]; if (d1) a1 += qv[e] * k1p[8 * c + e]; } }
            gts[q * 8 + nn] = a0; if (d1) gts[q * 8 + nn + 4] = a1; }
    }
    __syncthreads();
    if (tid < 128) { int s0 = -1, s1 = -1, s2 = -1; float g0 = -__builtin_inff(), g1 = g0, g2 = g0;
        for (int n = 0; n < qb; ++n) { const float gv = gts[tid * 8 + n];
            if (gv > g0) { g2 = g1; s2 = s1; g1 = g0; s1 = s0; g0 = gv; s0 = n; } else if (gv > g1) { g2 = g1; s2 = s1; g1 = gv; s1 = n; } else if (gv > g2) { g2 = gv; s2 = n; } }
        int mk = 0; if (s0 >= 0) mk |= 1 << s0; if (s1 >= 0) mk |= 1 << s1; if (s2 >= 0) mk |= 1 << s2;
        selm[tid] = mk; atomicOr((int*)bmask, mk); }
    __syncthreads();
    if (tid == 0) { const int bm = bmask[0]; int c = 0;
        for (int n = 0; n < qb; ++n) if ((bm >> n) & 1) for (int j = 0; j < 4; ++j) tiles[c++] = n * 256 + 64 * j;
        for (int kb = qb * 256; kb < q0 + 128; kb += 64) tiles[c++] = kb;
        tiles[40] = c; }
    __syncthreads();
    const int ntiles = tiles[40];
    const int qi = lane & 15, g = lane >> 4, myq = q0 + wave * 16 + qi, mymask = selm[wave * 16 + qi];
    WTile w; wt_reset(w); wt_load_q(w, Q0 + (size_t)myq * 1024, lane);
    const int srow = tid >> 4, sch = tid & 15;
    u32x4 kA0, kA1, vA0, vA1, kB0, kB1, vB0, vB1;
#define MB_LOAD(S, kb_) do { const bf16_t* kp_ = K0 + (size_t)((kb_) + srow) * 1024 + 8 * sch; const bf16_t* vp_ = V0 + (size_t)((kb_) + srow) * 1024 + 8 * sch; \
        k##S##0 = *(const u32x4*)kp_; k##S##1 = *(const u32x4*)(kp_ + 32 * 1024); v##S##0 = *(const u32x4*)vp_; v##S##1 = *(const u32x4*)(vp_ + 32 * 1024); } while (0)
#define MB_WRITE(S, buf_) do { LAS unsigned char* kb_ = lds + (buf_) * MB_TILE; LAS unsigned char* vb_ = kb_ + 64 * KSTR; \
        *(LAS u32x4*)(kb_ + srow * KSTR + sch * 16) = k##S##0; *(LAS u32x4*)(kb_ + (srow + 32) * KSTR + sch * 16) = k##S##1; \
        *(LAS u32x4*)(vb_ + srow * VSTR + sch * 16) = v##S##0; *(LAS u32x4*)(vb_ + (srow + 32) * VSTR + sch * 16) = v##S##1; } while (0)
#define MB_COMPUTE(t_) do { const int kb = tiles[t_]; const int n = kb >> 8; const LAS unsigned char* kbuf = lds + ((t_) % 3) * MB_TILE; bool active; \
        if (n < qb) active = __ballot((mymask >> n) & 1) != 0ull; else active = kb <= q0 + wave * 16 + 15; \
        if (active) { f32x4 sc[4]; wt_qk_lds64(w, kbuf, lane, sc); const float NEG = -__builtin_inff(); \
            if (n < qb) { if (!((mymask >> n) & 1)) { _Pragma("unroll") for (int t2 = 0; t2 < 4; ++t2) sc[t2] = (f32x4){NEG, NEG, NEG, NEG}; } } \
            else { _Pragma("unroll") for (int t2 = 0; t2 < 4; ++t2) _Pragma("unroll") for (int r = 0; r < 4; ++r) if (kb + 16 * t2 + 4 * g + r > myq) sc[t2][r] = NEG; } \
            wt_softmax_pv64(w, sc, kbuf + 64 * KSTR, lane); } } while (0)
    MB_LOAD(A, tiles[0]);
    if (ntiles > 1) MB_LOAD(B, tiles[1]);
    MB_WRITE(A, 0);
    __syncthreads();
    for (int t = 0; t < ntiles; t += 2) {
        if (t + 2 < ntiles) MB_LOAD(A, tiles[t + 2]);
        MB_COMPUTE(t);
        if (t + 1 < ntiles) MB_WRITE(B, (t + 1) % 3);
        __syncthreads();
        if (t + 1 >= ntiles) break;
        if (t + 3 < ntiles) MB_LOAD(B, tiles[t + 3]);
        MB_COMPUTE(t + 1);
        if (t + 2 < ntiles) MB_WRITE(A, (t + 2) % 3);
        __syncthreads();
    }
#undef MB_LOAD
#undef MB_WRITE
#undef MB_COMPUTE
    float l = w.l; l += __shfl_xor(l, 16); l += __shfl_xor(l, 32); const float inv = 1.0f / l;
    bf16_t* yp = Y0 + (size_t)myq * 2048 + 4 * g;
#pragma unroll
    for (int dt = 0; dt < 8; ++dt) { const u32x2 gw = *(const u32x2*)(yp + 16 * dt);
        u32x2 o; o.x = pk2(w.o[dt][0] * inv * bf_lo(gw.x), w.o[dt][1] * inv * bf_hi(gw.x)); o.y = pk2(w.o[dt][2] * inv * bf_lo(gw.y), w.o[dt][3] * inv * bf_hi(gw.y));
        *(u32x2*)(yp + 16 * dt) = o; }
}

typedef float f32x16 __attribute__((ext_vector_type(16)));
constexpr int VSTR2 = 320;
#define MFMA32(a, b, c) __builtin_amdgcn_mfma_f32_32x32x16_bf16((a), (b), (c), 0, 0, 0)
struct WT32 { bf16x8 qf[8]; f32x16 o[4]; float m, l; };
__device__ __forceinline__ void wt32_reset(WT32& w) {
#pragma unroll
    for (int d = 0; d < 4; ++d)
#pragma unroll
        for (int r = 0; r < 16; ++r) w.o[d][r] = 0.f;
    w.m = -1.0e30f; w.l = 0.f;
}
__device__ __forceinline__ void wt32_load_q(WT32& w, const bf16_t* qrow, int lane) {
    const int hi = lane >> 5;
#pragma unroll
    for (int d0 = 0; d0 < 8; ++d0) w.qf[d0] = *(const bf16x8*)(qrow + 16 * d0 + 8 * hi);
}
__device__ __forceinline__ f32x16 wt32_qk(const WT32& w, const LAS unsigned char* Kb, int lane) {
    const LAS unsigned char* p = Kb + (lane & 31) * KSTR + (lane >> 5) * 16;
    f32x16 s;
#pragma unroll
    for (int r = 0; r < 16; ++r) s[r] = 0.f;
#pragma unroll
    for (int d0 = 0; d0 < 8; ++d0) { const bf16x8 a = *(const LAS bf16x8*)(p + d0 * 32); s = MFMA32(a, w.qf[d0], s); }
    return s;
}
__device__ __forceinline__ void wt32_softmax_pv(WT32& w, const f32x16& s, const LAS unsigned char* Vb, int lane) {
    float mx = s[0];
#pragma unroll
    for (int r = 1; r < 16; ++r) mx = fmaxf(mx, s[r]);
    mx = fmaxf(mx, __shfl_xor(mx, 32));
    const float mn = fmaxf(w.m, mx);
    if (__any(mn > w.m)) { const float alpha = __builtin_amdgcn_exp2f(w.m - mn); w.m = mn; w.l *= alpha;
#pragma unroll
        for (int d = 0; d < 4; ++d) w.o[d] = w.o[d] * alpha; }
    float e[16]; float ps = 0.f;
#pragma unroll
    for (int r = 0; r < 16; ++r) { e[r] = __builtin_amdgcn_exp2f(s[r] - w.m); ps += e[r]; }
    w.l += ps;
    u32x4 pw0, pw1; pw0.x = pk2(e[0], e[1]); pw0.y = pk2(e[2], e[3]); pw0.z = pk2(e[4], e[5]); pw0.w = pk2(e[6], e[7]);
    pw1.x = pk2(e[8], e[9]); pw1.y = pk2(e[10], e[11]); pw1.z = pk2(e[12], e[13]); pw1.w = pk2(e[14], e[15]);
    const bf16x8 pf0 = __builtin_bit_cast(bf16x8, pw0), pf1 = __builtin_bit_cast(bf16x8, pw1);
    const int i = lane & 15, gg = (lane >> 4) & 1, hi = lane >> 5;
    const LAS unsigned char* vp = Vb + (4 * hi + (i >> 2)) * VSTR2 + 32 * gg + 8 * (i & 3);
#pragma unroll
    for (int db = 0; db < 4; ++db) {
        const s16x4 l0 = __builtin_amdgcn_ds_read_tr16_b64_v4i16((LAS s16x4*)(vp + db * 64));
        const s16x4 h0 = __builtin_amdgcn_ds_read_tr16_b64_v4i16((LAS s16x4*)(vp + 8 * VSTR2 + db * 64));
        const s16x4 l1 = __builtin_amdgcn_ds_read_tr16_b64_v4i16((LAS s16x4*)(vp + 16 * VSTR2 + db * 64));
        const s16x4 h1 = __builtin_amdgcn_ds_read_tr16_b64_v4i16((LAS s16x4*)(vp + 24 * VSTR2 + db * 64));
        w.o[db] = MFMA32(__builtin_shufflevector(l0, h0, 0, 1, 2, 3, 4, 5, 6, 7), pf0, w.o[db]);
        w.o[db] = MFMA32(__builtin_shufflevector(l1, h1, 0, 1, 2, 3, 4, 5, 6, 7), pf1, w.o[db]);
    }
}
__device__ __forceinline__ int crow32(int r, int hi) { return (r & 3) + 8 * (r >> 2) + 4 * hi; }

constexpr int M3_TILE = 64 * KSTR + 64 * VSTR2;
constexpr int M3_MISC = 3 * M3_TILE;
__device__ __forceinline__ void moba_item_m32(const Params& P, LAS unsigned char* lds, int b, int h, int qb, bool dry = false) {
    unsigned char* ws = P.ws; int tid_ = threadIdx.x; asm volatile("" : "+v"(tid_)); const int tid = tid_, lane = tid & 63, wave = __builtin_amdgcn_readfirstlane(tid >> 6);
    const bf16_t* Q0 = (const bf16_t*)(ws + WS_Q0) + (size_t)b * SEQ * 1024 + h * 128; const bf16_t* K0 = (const bf16_t*)(ws + WS_K0) + (size_t)b * SEQ * 1024 + h * 128;
    const bf16_t* V0 = (const bf16_t*)(ws + WS_V0) + (size_t)b * SEQ * 1024 + h * 128; bf16_t* Y0 = (bf16_t*)(ws + WS_Y0) + (size_t)b * SEQ * 2048 + 1024 + h * 128;
    const float* kpart = (const float*)(ws + WS_KPART);
    LAS float* ksum = (LAS float*)(lds + M3_MISC);
    LAS int* selm = (LAS int*)(ksum + 8 * 128);
    LAS int* tiles = selm + 256;
    LAS int* bmask = tiles + 48;
    const int q0 = qb * 256;
    __syncthreads();
    for (int i = tid; i < qb * 128; i += NTHREADS) { const int n = i >> 7, d = i & 127; const float* kp = kpart + ((size_t)(b * 8 + n) * 2) * 1024 + h * 128 + d; ksum[i] = kp[0] + kp[1024]; }
    if (tid == 0) bmask[0] = 0;
    __syncthreads();
    {
        const int q = tid >> 1, hf = tid & 1; const u32x4* qr = (const u32x4*)(Q0 + (size_t)(q0 + q) * 1024 + 64 * hf);
        float gsum[8];
#pragma unroll
        for (int n = 0; n < 8; ++n) gsum[n] = 0.f;
#pragma unroll 2
        for (int c = 0; c < 8; ++c) { const u32x4 wq = qr[c]; const float qv[8] = {bf_lo(wq.x), bf_hi(wq.x), bf_lo(wq.y), bf_hi(wq.y), bf_lo(wq.z), bf_hi(wq.z), bf_lo(wq.w), bf_hi(wq.w)};
#pragma unroll
            for (int n = 0; n < 8; ++n) if (n < qb) { const LAS float* kp = ksum + n * 128 + 64 * hf + 8 * c;
#pragma unroll
                for (int e = 0; e < 8; ++e) gsum[n] += qv[e] * kp[e]; } }
        int s0 = -1, s1 = -1, s2 = -1; float g0 = -__builtin_inff(), g1 = g0, g2 = g0;
#pragma unroll
        for (int n = 0; n < 8; ++n) { float gv = gsum[n] + __shfl_xor(gsum[n], 1);
            if (n < qb) { if (gv > g0) { g2 = g1; s2 = s1; g1 = g0; s1 = s0; g0 = gv; s0 = n; } else if (gv > g1) { g2 = g1; s2 = s1; g1 = gv; s1 = n; } else if (gv > g2) { g2 = gv; s2 = n; } } }
        int mk = 0; if (s0 >= 0) mk |= 1 << s0; if (s1 >= 0) mk |= 1 << s1; if (s2 >= 0) mk |= 1 << s2;
        if (hf == 0) { selm[q] = mk; atomicOr((int*)bmask, mk); }
    }
    __syncthreads();
    if (tid == 0) { const int bm = bmask[0]; int c = 0;
        for (int n = 0; n < qb; ++n) if ((bm >> n) & 1) for (int j = 0; j < 4; ++j) tiles[c++] = n * 256 + 64 * j;
        for (int j = 0; j < 4; ++j) tiles[c++] = q0 + 64 * j;
        tiles[40] = c; }
    __syncthreads();
    const int ntiles = tiles[40];
    const int r32 = lane & 31, hi = lane >> 5, myq = q0 + wave * 32 + r32, mymask = selm[wave * 32 + r32];
    WT32 w; wt32_reset(w); wt32_load_q(w, Q0 + (size_t)myq * 1024, lane);
    const int srow = tid >> 4, sch = tid & 15;
    u32x4 kA0, kA1, vA0, vA1, kB0, kB1, vB0, vB1;
#define M3_LOAD(S, kb_) do { const bf16_t* kp_ = K0 + (size_t)((kb_) + srow) * 1024 + 8 * sch; const bf16_t* vp_ = V0 + (size_t)((kb_) + srow) * 1024 + 8 * sch; \
        k##S##0 = *(const u32x4*)kp_; k##S##1 = *(const u32x4*)(kp_ + 32 * 1024); v##S##0 = *(const u32x4*)vp_; v##S##1 = *(const u32x4*)(vp_ + 32 * 1024); } while (0)
#define M3_WRITE(S, buf_) do { LAS unsigned char* kb_ = lds + (buf_) * M3_TILE; LAS unsigned char* vb_ = kb_ + 64 * KSTR; \
        *(LAS u32x4*)(kb_ + srow * KSTR + sch * 16) = k##S##0; *(LAS u32x4*)(kb_ + (srow + 32) * KSTR + sch * 16) = k##S##1; \
        *(LAS u32x4*)(vb_ + srow * VSTR2 + sch * 16) = v##S##0; *(LAS u32x4*)(vb_ + (srow + 32) * VSTR2 + sch * 16) = v##S##1; } while (0)
#define M3_COMPUTE(t_) do { const int kb = tiles[t_]; const int n = kb >> 8; const LAS unsigned char* kbuf = lds + ((t_) % 3) * M3_TILE; const float NEG = -__builtin_inff(); \
        const bool past = n < qb; const bool mine = (mymask >> n) & 1; const bool anyw = past ? (__ballot(mine) != 0ull) : true; \
        _Pragma("unroll 1") for (int sub = 0; sub < 2; ++sub) { const int kb2 = kb + 32 * sub; \
            if (past ? anyw : (kb2 <= q0 + wave * 32 + 31)) { f32x16 sc = wt32_qk(w, kbuf + sub * 32 * KSTR, lane); \
                _Pragma("unroll") for (int r = 0; r < 16; ++r) { const bool ok = past ? mine : (kb2 + crow32(r, hi) <= myq); if (!ok) sc[r] = NEG; } \
                wt32_softmax_pv(w, sc, kbuf + 64 * KSTR + sub * 32 * VSTR2, lane); } } } while (0)
    M3_LOAD(A, tiles[0]);
    if (ntiles > 1) M3_LOAD(B, tiles[1]);
    M3_WRITE(A, 0);
    __syncthreads();
    for (int t = 0; t < ntiles; t += 2) {
        if (t + 2 < ntiles) M3_LOAD(A, tiles[t + 2]);
        M3_COMPUTE(t);
        if (t + 1 < ntiles) M3_WRITE(B, (t + 1) % 3);
        __syncthreads();
        if (t + 1 >= ntiles) break;
        if (t + 3 < ntiles) M3_LOAD(B, tiles[t + 3]);
        M3_COMPUTE(t + 1);
        if (t + 2 < ntiles) M3_WRITE(A, (t + 2) % 3);
        __syncthreads();
    }
#undef M3_LOAD
#undef M3_WRITE
#undef M3_COMPUTE
    float l = w.l; l += __shfl_xor(l, 32); const float inv = 1.0f / l;
    bf16_t* yp = Y0 + (size_t)myq * 2048 + 4 * hi;
#pragma unroll
    for (int db = 0; db < 4; ++db)
#pragma unroll
        for (int rq = 0; rq < 4; ++rq) { bf16_t* pp = yp + 32 * db + 8 * rq; const u32x2 gw = *(const u32x2*)pp;
            u32x2 o; o.x = pk2(w.o[db][4 * rq] * inv * bf_lo(gw.x), w.o[db][4 * rq + 1] * inv * bf_hi(gw.x)); o.y = pk2(w.o[db][4 * rq + 2] * inv * bf_lo(gw.y), w.o[db][4 * rq + 3] * inv * bf_hi(gw.y));
            if (!dry) *(u32x2*)pp = o; }
}

constexpr int DL_OACC = 0, DL_LSE = 65536, DL_V = 66560;
__device__ __forceinline__ void dilated_item_mfma(const Params& P, LAS unsigned char* lds, int b, int h, int blk) {
    unsigned char* ws = P.ws; int tid_ = threadIdx.x; asm volatile("" : "+v"(tid_)); const int tid = tid_, lane = tid & 63, wave = __builtin_amdgcn_readfirstlane(tid >> 6);
    bf16_t* Q1 = (bf16_t*)(ws + WS_QO1) + (size_t)b * SEQ * 2048 + h * 128; const bf16_t* K1 = (const bf16_t*)(ws + WS_K1) + (size_t)b * SEQ * 2048 + h * 128;
    const bf16_t* V1 = (const bf16_t*)(ws + WS_V1) + (size_t)b * SEQ * 2048 + h * 128;
    LAS unsigned char* Vw = lds + DL_V + wave * (32 * VSTR); LAS float* lse = (LAS float*)(lds + DL_LSE);
    const int T0 = blk * 256, qi = lane & 15, g = lane >> 4;
    __syncthreads();
#pragma unroll 1
    for (int pt = 0; pt < 3; ++pt) {
        const int r = 1 << (2 * pt);
#pragma unroll 1
        for (int half = 0; half < 2; ++half) {
            const int wt = wave + 8 * half;
            const int t0 = T0 + (pt == 0 ? 16 * wt : (pt == 1 ? (wt & 3) + 64 * (wt >> 2) : wt));
            const int myq = t0 + r * qi;
            WTile w; wt_reset(w); wt_load_q(w, Q1 + (size_t)myq * 2048, lane);
            const int kp0 = t0 - 144 * r;
            int s_lo = 0; while (kp0 + (32 * s_lo + 31) * r < 0) ++s_lo;
            bf16x8 kaA[2][4], kaB[2][4]; u32x4 vrA[8], vrB[8];
#define DL_LOAD(S, s_) do { const int kps_ = kp0 + 32 * (s_) * r; \
                _Pragma("unroll") for (int a = 0; a < 2; ++a) { int pos = kps_ + (16 * a + qi) * r; pos = pos < 0 ? 0 : pos; const bf16_t* kr = K1 + (size_t)pos * 2048 + 8 * g; \
                    _Pragma("unroll") for (int ks = 0; ks < 4; ++ks) ka##S[a][ks] = *(const bf16x8*)(kr + 32 * ks); } \
                _Pragma("unroll") for (int j = 0; j < 8; ++j) { const int c = lane + 64 * j, row = c >> 4, ch = c & 15; int pos = kps_ + row * r; pos = pos < 0 ? 0 : pos; vr##S[j] = *(const u32x4*)(V1 + (size_t)pos * 2048 + 8 * ch); } } while (0)
#define DL_STEP(S, s_) do { const int kps_ = kp0 + 32 * (s_) * r; \
                _Pragma("unroll") for (int j = 0; j < 8; ++j) { const int c = lane + 64 * j, row = c >> 4, ch = c & 15; *(LAS u32x4*)(Vw + row * VSTR + ch * 16) = vr##S[j]; } \
                f32x4 s0 = (f32x4){0.f, 0.f, 0.f, 0.f}, s1 = s0; \
                _Pragma("unroll") for (int ks = 0; ks < 4; ++ks) { s0 = MFMA16(ka##S[0][ks], w.qf[ks], s0); s1 = MFMA16(ka##S[1][ks], w.qf[ks], s1); } \
                const float NEG = -__builtin_inff(); \
                _Pragma("unroll") for (int e = 0; e < 4; ++e) { const int kk0 = 4 * g + e, kk1 = 16 + 4 * g + e; const int d0 = qi + 144 - 32 * (s_) - kk0, d1 = qi + 144 - 32 * (s_) - kk1; \
                    if (d0 < 0 || d0 > 128 || kps_ + kk0 * r < 0) s0[e] = NEG; if (d1 < 0 || d1 > 128 || kps_ + kk1 * r < 0) s1[e] = NEG; } \
                wt_softmax_pv(w, s0, s1, Vw, lane); } while (0)
            DL_LOAD(A, s_lo);
#pragma unroll 1
            for (int s = s_lo; s < 5; s += 2) {
                if (s + 1 < 5) DL_LOAD(B, s + 1);
                DL_STEP(A, s);
                if (s + 1 >= 5) break;
                if (s + 2 < 5) DL_LOAD(A, s + 2);
                DL_STEP(B, s + 1);
            }
#undef DL_LOAD
#undef DL_STEP
            float l = w.l; l += __shfl_xor(l, 16); l += __shfl_xor(l, 32); const float inv = 1.0f / l; const float ls = w.m + __log2f(l);
            const int row = myq - T0;
            LAS unsigned char* orow = lds + DL_OACC + row * 256 + 8 * g;
            if (pt == 0) {
#pragma unroll
                for (int dt = 0; dt < 8; ++dt) { u32x2 o; o.x = pk2(w.o[dt][0] * inv, w.o[dt][1] * inv); o.y = pk2(w.o[dt][2] * inv, w.o[dt][3] * inv); *(LAS u32x2*)(orow + 32 * dt) = o; }
                if (g == 0) lse[row] = ls;
            } else {
                const float lo = lse[row], mxl = fmaxf(lo, ls); const float eo = __builtin_amdgcn_exp2f(lo - mxl), en = __builtin_amdgcn_exp2f(ls - mxl), den = eo + en;
                const float wo = eo / den, wn = en / den * inv;
                bf16_t* gout = Q1 + (size_t)myq * 2048 + 4 * g;
#pragma unroll
                for (int dt = 0; dt < 8; ++dt) { const u32x2 ov = *(const LAS u32x2*)(orow + 32 * dt);
                    u32x2 o; o.x = pk2(wo * bf_lo(ov.x) + wn * w.o[dt][0], wo * bf_hi(ov.x) + wn * w.o[dt][1]); o.y = pk2(wo * bf_lo(ov.y) + wn * w.o[dt][2], wo * bf_hi(ov.y) + wn * w.o[dt][3]);
                    if (pt == 1) *(LAS u32x2*)(orow + 32 * dt) = o; else *(u32x2*)(gout + 16 * dt) = o; }
                if (pt == 1) { asm volatile("s_waitcnt lgkmcnt(0)" ::: "memory"); if (g == 0) lse[row] = mxl + __log2f(den); }
            }
        }
        __syncthreads();
    }
}

constexpr int D2_OACC = 0, D2_LSE = 65536, D2_K = 66560, D2_V = D2_K + 128 * KSTR;
__device__ __forceinline__ void dilated_item_v2(const Params& P, LAS unsigned char* lds, int b, int h, int blk) {
    unsigned char* ws = P.ws; int tid_ = threadIdx.x; asm volatile("" : "+v"(tid_)); const int tid = tid_, lane = tid & 63, wave = __builtin_amdgcn_readfirstlane(tid >> 6);
    bf16_t* Q1 = (bf16_t*)(ws + WS_QO1) + (size_t)b * SEQ * 2048 + h * 128; const bf16_t* K1 = (const bf16_t*)(ws + WS_K1) + (size_t)b * SEQ * 2048 + h * 128;
    const bf16_t* V1 = (const bf16_t*)(ws + WS_V1) + (size_t)b * SEQ * 2048 + h * 128;
    LAS float* lse = (LAS float*)(lds + D2_LSE);
    const int T0 = blk * 256;
    __syncthreads();
#pragma unroll 1
    for (int pt = 0; pt < 2; ++pt) {
        const int r32 = lane & 31, hi = lane >> 5, rho = wave >> 1, hf = wave & 1;
        const int rowl = pt == 0 ? 32 * wave + r32 : rho + 4 * (32 * hf + r32);
        const int myq = T0 + rowl;
        WT32 w; wt32_reset(w); wt32_load_q(w, Q1 + (size_t)myq * 2048, lane);
        const int ntile = pt == 0 ? 3 : 6, base0 = pt == 0 ? T0 - 128 : T0 - 512;
        int u0 = 0; while (base0 + 128 * u0 < 0) ++u0;
        const int srow = tid >> 4, sch = tid & 15;
        u32x4 kq[4], vq[4];
#define D2_LOAD(u_) do { const size_t p0_ = (size_t)(base0 + 128 * (u_) + srow); \
            _Pragma("unroll") for (int j = 0; j < 4; ++j) { kq[j] = *(const u32x4*)(K1 + (p0_ + 32 * j) * 2048 + 8 * sch); vq[j] = *(const u32x4*)(V1 + (p0_ + 32 * j) * 2048 + 8 * sch); } } while (0)
        D2_LOAD(u0);
#pragma unroll 1
        for (int u = u0; u < ntile; ++u) {
            __syncthreads();
#pragma unroll
            for (int j = 0; j < 4; ++j) { const int po = srow + 32 * j; const int lrow = pt == 0 ? po : 32 * (po & 3) + (po >> 2);
                *(LAS u32x4*)(lds + D2_K + lrow * KSTR + sch * 16) = kq[j]; *(LAS u32x4*)(lds + D2_V + lrow * VSTR2 + sch * 16) = vq[j]; }
            __syncthreads();
            if (u + 1 < ntile) D2_LOAD(u + 1);
            const int nsub = pt == 0 ? 4 : 1;
#pragma unroll 1
            for (int sb = 0; sb < nsub; ++sb) {
                const int D0w = pt == 0 ? (T0 + 32 * wave) - (base0 + 128 * u + 32 * sb) : 32 * hf + 128 - 32 * u;
                if (D0w + 31 >= 0 && D0w <= 159) {
                    const int lsub = pt == 0 ? sb : rho;
                    f32x16 sc = wt32_qk(w, lds + D2_K + lsub * 32 * KSTR, lane);
                    const int D0 = D0w + r32; const float NEG = -__builtin_inff();
#pragma unroll
                    for (int r = 0; r < 16; ++r) { const unsigned dd = (unsigned)(D0 - crow32(r, hi)); if (dd > 128u) sc[r] = NEG; }
                    wt32_softmax_pv(w, sc, lds + D2_V + lsub * 32 * VSTR2, lane);
                }
            }
        }
#undef D2_LOAD
        float l = w.l; l += __shfl_xor(l, 32); const float inv = 1.0f / l, ls = w.m + __log2f(l);
        LAS unsigned char* orow = lds + D2_OACC + rowl * 256 + 8 * hi;
        if (pt == 0) {
#pragma unroll
            for (int db = 0; db < 4; ++db)
#pragma unroll
                for (int rq = 0; rq < 4; ++rq) { u32x2 o; o.x = pk2(w.o[db][4 * rq] * inv, w.o[db][4 * rq + 1] * inv); o.y = pk2(w.o[db][4 * rq + 2] * inv, w.o[db][4 * rq + 3] * inv); *(LAS u32x2*)(orow + 64 * db + 16 * rq) = o; }
            if (hi == 0) lse[rowl] = ls;
        } else {
            const float lo = lse[rowl], mxl = fmaxf(lo, ls); const float eo = __builtin_amdgcn_exp2f(lo - mxl), en = __builtin_amdgcn_exp2f(ls - mxl), den = eo + en;
            const float wo = eo / den, wn = en / den * inv;
#pragma unroll
            for (int db = 0; db < 4; ++db)
#pragma unroll
                for (int rq = 0; rq < 4; ++rq) { const u32x2 ov = *(const LAS u32x2*)(orow + 64 * db + 16 * rq);
                    u32x2 o; o.x = pk2(wo * bf_lo(ov.x) + wn * w.o[db][4 * rq], wo * bf_hi(ov.x) + wn * w.o[db][4 * rq + 1]); o.y = pk2(wo * bf_lo(ov.y) + wn * w.o[db][4 * rq + 2], wo * bf_hi(ov.y) + wn * w.o[db][4 * rq + 3]);
                    *(LAS u32x2*)(orow + 64 * db + 16 * rq) = o; }
            asm volatile("s_waitcnt lgkmcnt(0)" ::: "memory");
            if (hi == 0) lse[rowl] = mxl + __log2f(den);
        }
        __syncthreads();
    }
    {
        const int qi = lane & 15, g = lane >> 4; LAS unsigned char* Vw = lds + D2_K + wave * (32 * VSTR);
#pragma unroll 1
        for (int half = 0; half < 2; ++half) {
            const int wt = wave + 8 * half, t0 = T0 + wt, myq = t0 + 16 * qi;
            WTile w; wt_reset(w); wt_load_q(w, Q1 + (size_t)myq * 2048, lane);
            const int kp0 = t0 - 144 * 16;
            int s_lo = 0; while (kp0 + (32 * s_lo + 31) * 16 < 0) ++s_lo;
            bf16x8 kaA[2][4], kaB[2][4]; u32x4 vrA[8], vrB[8];
#define DL_LOAD(S, s_) do { const int kps_ = kp0 + 512 * (s_); \
                _Pragma("unroll") for (int a = 0; a < 2; ++a) { int pos = kps_ + (16 * a + qi) * 16; pos = pos < 0 ? 0 : pos; const bf16_t* kr = K1 + (size_t)pos * 2048 + 8 * g; \
                    _Pragma("unroll") for (int ks = 0; ks < 4; ++ks) ka##S[a][ks] = *(const bf16x8*)(kr + 32 * ks); } \
                _Pragma("unroll") for (int j = 0; j < 8; ++j) { const int c = lane + 64 * j, row = c >> 4, ch = c & 15; int pos = kps_ + row * 16; pos = pos < 0 ? 0 : pos; vr##S[j] = *(const u32x4*)(V1 + (size_t)pos * 2048 + 8 * ch); } } while (0)
#define DL_STEP(S, s_) do { const int kps_ = kp0 + 512 * (s_); \
                _Pragma("unroll") for (int j = 0; j < 8; ++j) { const int c = lane + 64 * j, row = c >> 4, ch = c & 15; *(LAS u32x4*)(Vw + row * VSTR + ch * 16) = vr##S[j]; } \
                f32x4 s0 = (f32x4){0.f, 0.f, 0.f, 0.f}, s1 = s0; \
                _Pragma("unroll") for (int ks = 0; ks < 4; ++ks) { s0 = MFMA16(ka##S[0][ks], w.qf[ks], s0); s1 = MFMA16(ka##S[1][ks], w.qf[ks], s1); } \
                const float NEG = -__builtin_inff(); \
                _Pragma("unroll") for (int e = 0; e < 4; ++e) { const int kk0 = 4 * g + e, kk1 = 16 + 4 * g + e; const int d0 = qi + 144 - 32 * (s_) - kk0, d1 = qi + 144 - 32 * (s_) - kk1; \
                    if (d0 < 0 || d0 > 128 || kps_ + kk0 * 16 < 0) s0[e] = NEG; if (d1 < 0 || d1 > 128 || kps_ + kk1 * 16 < 0) s1[e] = NEG; } \
                wt_softmax_pv(w, s0, s1, Vw, lane); } while (0)
            DL_LOAD(A, s_lo);
#pragma unroll 1
            for (int s = s_lo; s < 5; s += 2) {
                if (s + 1 < 5) DL_LOAD(B, s + 1);
                DL_STEP(A, s);
                if (s + 1 >= 5) break;
                if (s + 2 < 5) DL_LOAD(A, s + 2);
                DL_STEP(B, s + 1);
            }
#undef DL_LOAD
#undef DL_STEP
            float l = w.l; l += __shfl_xor(l, 16); l += __shfl_xor(l, 32); const float inv = 1.0f / l; const float ls = w.m + __log2f(l);
            const int row = myq - T0;
            const LAS unsigned char* orow = lds + D2_OACC + row * 256 + 8 * g;
            const float lo = lse[row], mxl = fmaxf(lo, ls); const float eo = __builtin_amdgcn_exp2f(lo - mxl), en = __builtin_amdgcn_exp2f(ls - mxl), den = eo + en;
            const float wo = eo / den, wn = en / den * inv;
            bf16_t* gout = Q1 + (size_t)myq * 2048 + 4 * g;
#pragma unroll
            for (int dt = 0; dt < 8; ++dt) { const u32x2 ov = *(const LAS u32x2*)(orow + 32 * dt);
                u32x2 o; o.x = pk2(wo * bf_lo(ov.x) + wn * w.o[dt][0], wo * bf_hi(ov.x) + wn * w.o[dt][1]); o.y = pk2(wo * bf_lo(ov.y) + wn * w.o[dt][2], wo * bf_hi(ov.y) + wn * w.o[dt][3]);
                *(u32x2*)(gout + 16 * dt) = o; }
        }
    }
    __syncthreads();
}

__global__ void __launch_bounds__(NTHREADS, 2) fwd_megakernel(Params P) {
    extern __shared__ __attribute__((aligned(16))) unsigned char lds_raw[];
    LAS unsigned char* lds = (LAS unsigned char*)lds_raw;
    cg::grid_group grid = cg::this_grid();
    const int G = gridDim.x, tid = threadIdx.x;
    unsigned char* ws = P.ws;
    LAS int* misc = (LAS int*)(lds + LDS_BYTES - 64);
    unsigned long long pr_t0 = 0, pr_acc = 0;
#define PH_BEGIN(k) do { if (PROBE_PHASE == (k)) pr_t0 = __builtin_amdgcn_s_memrealtime(); } while (0)
#define PH_END(k) do { if (PROBE_PHASE == (k)) pr_acc += __builtin_amdgcn_s_memrealtime() - pr_t0; } while (0)

    PH_BEGIN(0);
    if (PHASE_MASK & 1) phase_prep(P, lds, G);
    grid.sync();
    PH_END(0);
    PH_BEGIN(1);
    if (PHASE_MASK & 2) {
        pg8::Gemm g{(const bf16_t*)P.out, (const bf16_t*)(ws + WS_W0T), MTOK, N0, DM}; pg8::StaticOrder S; S.init(MTOK, N0, G, (int)blockIdx.x);
        EpiIn0 E{(bf16_t*)(ws + WS_Y0), (bf16_t*)(ws + WS_XBC), (bf16_t*)(ws + WS_Q0), (bf16_t*)(ws + WS_K0), (bf16_t*)(ws + WS_V0), (const float*)(ws + WS_RSTD0), (float*)(ws + WS_KPART)};
        pg8::gemm_phase<GEMM_ALIGN, GEMM_SP2>(lds, g, S, E, pg8::NoHook{});
    }
    grid.sync();
    PH_END(1);
    PH_BEGIN(2);
    PH_BEGIN(21);
    if (PHASE_MASK & 4) { conv_prepass(P, G); }
    grid.sync();
    PH_END(21);
    if (PHASE_MASK & 4) {
        if (PROBE_PHASE == 23 && blockIdx.x == 0) { PH_BEGIN(23); moba_item_m32(P, lds, 0, 0, 7, ws != nullptr); PH_END(23); }
        if (PROBE_PHASE == 24 && blockIdx.x == 0) { PH_BEGIN(24); moba_item_m32(P, lds, 0, 0, 0, ws != nullptr); PH_END(24); }
        PH_BEGIN(25);
        const int xcd = blockIdx.x & 7;
        unsigned* ctr = (unsigned*)(ws + WS_CTL) + 16 * xcd;
        for (;;) {
            __syncthreads();
            if (tid == 0) misc[0] = (int)atomicAdd(ctr, 1u);
            __syncthreads();
            const int it = misc[0];
#if MOBA_MFMA
#if MOBA_M32
            if (it >= 80) break;
            if (it >= 40 && it < 56) { const int item = (it - 40) * 8 + xcd; PH_BEGIN(20); ssd_item_mfma(P, lds, item >> 4, item & 15); PH_END(20); }
            else { const int r = it < 40 ? it : it - 16; const int qb = 7 - (r >> 3), bh = 8 * (r & 7) + xcd; PH_BEGIN(22); moba_item_m32(P, lds, bh >> 3, bh & 7, qb); PH_END(22); }
#else
            if (it >= 16 + 128) break;
            if (it < 16) { const int item = it * 8 + xcd; PH_BEGIN(20); if (SSD_MFMA) ssd_item_mfma(P, lds, item >> 4, item & 15); else ssd_item(P, lds, item >> 4, item & 15); PH_END(20); }
            else { const int r = it - 16; const int qt = 15 - (r & 15), bh = 8 * (r >> 4) + xcd; PH_BEGIN(22); moba_item_mfma(P, lds, bh >> 3, bh & 7, qt); PH_END(22); }
#endif
#else
            if (it >= 128 + 4096) break;
            if (it < 128) ssd_item(P, lds, it >> 4, it & 15);
            else { const int r = it - 128; const int qt = 63 - (r >> 6), bh = r & 63; moba_item(P, lds, bh >> 3, bh & 7, qt); }
#endif
        }
        PH_END(25);
    }
    grid.sync();
    PH_END(2);
    PH_BEGIN(3);
    if (PHASE_MASK & 8) {
        pg8::Gemm g{(const bf16_t*)(ws + WS_Y0), (const bf16_t*)(ws + WS_WO0T), MTOK, DM, 2048}; pg8::StaticOrder S; S.init(MTOK, DM, G, (int)blockIdx.x);
        EpiRes E{P.x, P.out, (bf16_t*)(ws + WS_X1B), (float*)(ws + WS_RSQ1)};
        HookSsdNorm H{(const float*)(ws + WS_SSQ)};
        pg8::gemm_phase<GEMM_ALIGN, GEMM_SP2>(lds, g, S, E, H);
    }
    grid.sync();
    PH_END(3);
    PH_BEGIN(4);
    if (PHASE_MASK & 16) {
        pg8::Gemm g{(const bf16_t*)(ws + WS_X1B), (const bf16_t*)(ws + WS_W1T), MTOK, 6144, DM}; pg8::StaticOrder S; S.init(MTOK, 6144, G, (int)blockIdx.x);
        EpiQkv1 E{(bf16_t*)(ws + WS_QO1), (size_t)(WS_K1 - WS_QO1) / 2, (const float*)(ws + WS_RSQ1)};
        pg8::gemm_phase<GEMM_ALIGN, GEMM_SP2>(lds, g, S, E, pg8::NoHook{});
    }
    grid.sync();
    PH_END(4);
    PH_BEGIN(5);
#if DIL_MFMA
    if (PHASE_MASK & 32) for (int it = (int)(blockIdx.x & 7) * (G >> 3) + (int)(blockIdx.x >> 3); it < 8 * 16 * 8; it += G) { const int blk = (it ^ (it >> 8)) & 7, bh = it >> 3; if (DIL_V2) dilated_item_v2(P, lds, bh >> 4, bh & 15, blk); else dilated_item_mfma(P, lds, bh >> 4, bh & 15, blk); }
#else
    if (PHASE_MASK & 32) for (int it = blockIdx.x; it < 8 * 16 * 64; it += G) { const int qt = it & 63, bh = it >> 6; dilated_item(P, lds, bh >> 4, bh & 15, qt); }
#endif
    grid.sync();
    PH_END(5);
    PH_BEGIN(6);
    if (PHASE_MASK & 64) {
        pg8::Gemm g{(const bf16_t*)(ws + WS_X1B), (const bf16_t*)(ws + WS_W1T) + (size_t)6144 * 1024, MTOK, 2048, DM}; pg8::StaticOrder S; S.init(MTOK, 2048, G, (int)blockIdx.x);
        EpiGate1 E{(bf16_t*)(ws + WS_QO1), (const float*)(ws + WS_RSQ1)};
        pg8::gemm_phase<GEMM_ALIGN, GEMM_SP2>(lds, g, S, E, pg8::NoHook{});
    }
    grid.sync();
    PH_END(6);
    PH_BEGIN(7);
    if (PHASE_MASK & 128) {
        pg8::Gemm g{(const bf16_t*)(ws + WS_QO1), (const bf16_t*)(ws + WS_WO1T), MTOK, DM, 2048}; pg8::StaticOrder S; S.init(MTOK, DM, G, (int)blockIdx.x);
        EpiRes E{P.out, P.out, nullptr, (float*)(ws + WS_RSQ2)};
        pg8::gemm_phase<GEMM_ALIGN, GEMM_SP2>(lds, g, S, E, pg8::NoHook{});
    }
    grid.sync();
    PH_END(7);
    PH_BEGIN(8);
    if (PHASE_MASK & 256) {
        const int lane = tid & 63, wave = tid >> 6; const float* rsq2 = (const float*)(ws + WS_RSQ2);
        for (int m = blockIdx.x * 8 + wave; m < MTOK; m += G * 8) {
            const float rs = rstd_from16(rsq2 + (size_t)m * 16);
            f32x4* xr = (f32x4*)(P.out + (size_t)m * DM) + lane; const f32x4* gr = (const f32x4*)P.final_norm + lane;
#pragma unroll
            for (int j = 0; j < 4; ++j) { const f32x4 v = xr[64 * j], gg = gr[64 * j]; xr[64 * j] = v * rs * gg; }
        }
    }
    if (PROBE_PHASE >= 0) { PH_END(8); if (blockIdx.x == PROBE_BLOCK && tid == 0) { const unsigned long long t0 = __builtin_amdgcn_s_memrealtime(), wait = pr_acc * PROBE_MULT;
        while (__builtin_amdgcn_s_memrealtime() - t0 < wait) __builtin_amdgcn_s_sleep(32); } }
}

extern "C" void kernel_launch(void* const* d_in, const int* in_sizes, int n_in, void* d_out, int out_size, void* d_ws, size_t ws_size, hipStream_t stream) {
    static int grid_blocks = 0;
    if (grid_blocks == 0) {
        if (n_in != 14 || ws_size < WS_END) { fprintf(stderr, "kernel_launch: unexpected n_in %d / ws_size %zu\n", n_in, ws_size); grid_blocks = -1; return; }
        int dev = 0, cus = 0, per_cu = 0;
        hipGetDevice(&dev);
        hipDeviceGetAttribute(&cus, hipDeviceAttributeMultiprocessorCount, dev);
        hipFuncSetAttribute((const void*)fwd_megakernel, hipFuncAttributeMaxDynamicSharedMemorySize, LDS_BYTES);
        hipOccupancyMaxActiveBlocksPerMultiprocessor(&per_cu, (const void*)fwd_megakernel, NTHREADS, LDS_BYTES);
        if (per_cu < 1) { fprintf(stderr, "kernel_launch: occupancy query says %d blocks per CU\n", per_cu); per_cu = 1; }
        grid_blocks = cus * 1;
        (void)hipGetLastError();
    }
    if (grid_blocks < 0) return;
    Params p{};
    p.x = (const float*)d_in[0]; p.even_norm = (const float*)d_in[1]; p.w_in0 = (const float*)d_in[2]; p.conv_w = (const float*)d_in[3]; p.conv_b = (const float*)d_in[4];
    p.dt_bias = (const float*)d_in[5]; p.a_log = (const float*)d_in[6]; p.d_skip = (const float*)d_in[7]; p.ssd_norm = (const float*)d_in[8]; p.w_out0 = (const float*)d_in[9];
    p.odd_norm = (const float*)d_in[10]; p.w_in1 = (const float*)d_in[11]; p.w_out1 = (const float*)d_in[12]; p.final_norm = (const float*)d_in[13];
    p.out = (float*)d_out; p.ws = (unsigned char*)d_ws;
    void* args[] = {&p};
    hipError_t e = hipLaunchCooperativeKernel((const void*)fwd_megakernel, dim3(grid_blocks), dim3(NTHREADS), args, LDS_BYTES, stream);
    if (e != hipSuccess) fprintf(stderr, "cooperative launch failed: %s (grid %d)\n", hipGetErrorString(e), grid_blocks);
}
```

```cpp
#include <hip/hip_runtime.h>
#include <hip/hip_cooperative_groups.h>
#include <cstdio>
#include <cstdint>
namespace cg = cooperative_groups;

#define LAS __attribute__((address_space(3)))
typedef unsigned short bf16_t;
typedef short bf16x8 __attribute__((ext_vector_type(8)));
typedef float f32x4 __attribute__((ext_vector_type(4)));
typedef float f32x2 __attribute__((ext_vector_type(2)));
typedef unsigned u32x4 __attribute__((ext_vector_type(4)));
typedef unsigned u32x2 __attribute__((ext_vector_type(2)));

constexpr int BATCH = 8, SEQ = 2048, DM = 1024, MTOK = BATCH * SEQ;
constexpr int EVEN_IN = 6672;
constexpr int N0 = 6656;
constexpr float NORM_EPS = 1e-5f;
constexpr float QSCALE = 0.08838834764831845f * 1.4426950408889634f;
#ifndef PHASE_MASK
#define PHASE_MASK 0x1ff
#endif
#ifndef PROBE_PHASE
#define PROBE_PHASE -1
#endif
#ifndef PROBE_BLOCK
#define PROBE_BLOCK 0
#endif
#ifndef PROBE_MULT
#define PROBE_MULT 4
#endif
#ifndef GEMM_SP2
#define GEMM_SP2 true
#endif
#ifndef GEMM_ALIGN
#define GEMM_ALIGN true
#endif
#ifndef DIL_V2
#define DIL_V2 1
#endif
#ifndef USE_XCD_BARRIER
#define USE_XCD_BARRIER 1
#endif
#ifndef MOBA_M32
#define MOBA_M32 1
#endif
#ifndef SSD_MFMA
#define SSD_MFMA 1
#endif
#ifndef MOBA_MFMA
#define MOBA_MFMA 1
#endif
#ifndef DIL_MFMA
#define DIL_MFMA 1
#endif
constexpr int NTHREADS = 512;
constexpr int LDS_BYTES = 155648;
constexpr int RING_BYTES = 131072;

constexpr size_t MiB = 1u << 20;
constexpr size_t WS_CTL = 0;
constexpr size_t WS_BAR = 16 * 1024;
constexpr size_t WS_RSTD0 = 64 * 1024;
constexpr size_t WS_KPART = 512 * 1024;
constexpr size_t WS_DT = 1 * MiB;
constexpr size_t WS_SSQ = 2 * MiB;
constexpr size_t WS_RSQ1 = 3 * MiB;
constexpr size_t WS_RSQ2 = 4 * MiB;
constexpr size_t WS_W1T = 5 * MiB;
constexpr size_t WS_WO1T = 21 * MiB;
constexpr size_t WS_W0T = 25 * MiB;
constexpr size_t WS_WO0T = 38 * MiB;
constexpr size_t WS_Y0 = 42 * MiB;
constexpr size_t WS_XBC = 106 * MiB;
constexpr size_t WS_Q0 = 154 * MiB;
constexpr size_t WS_K0 = 186 * MiB;
constexpr size_t WS_V0 = 218 * MiB;
constexpr size_t WS_X1B = 224 * MiB;
constexpr size_t WS_QO1 = 25 * MiB;
constexpr size_t WS_K1 = 89 * MiB;
constexpr size_t WS_V1 = 153 * MiB;
constexpr size_t WS_END = 256 * MiB;

struct Params {
    const float* x; const float* even_norm; const float* w_in0; const float* conv_w; const float* conv_b; const float* dt_bias; const float* a_log;
    const float* d_skip; const float* ssd_norm; const float* w_out0; const float* odd_norm; const float* w_in1; const float* w_out1; const float* final_norm;
    float* out; unsigned char* ws;
};

__device__ __forceinline__ unsigned f2bf(float f) { unsigned u = __builtin_bit_cast(unsigned, f); return (u + 0x7fffu + ((u >> 16) & 1u)) >> 16; }
typedef __bf16 bf16v2_t __attribute__((ext_vector_type(2)));
__device__ __forceinline__ unsigned pk2(float lo, float hi) { const bf16v2_t v = {(__bf16)lo, (__bf16)hi}; return __builtin_bit_cast(unsigned, v); }
__device__ __forceinline__ float bf_lo(unsigned w) { return __builtin_bit_cast(float, w << 16); }
__device__ __forceinline__ float bf_hi(unsigned w) { return __builtin_bit_cast(float, w & 0xffff0000u); }
__device__ __forceinline__ float bf2f(bf16_t h) { return __builtin_bit_cast(float, (unsigned)h << 16); }
__device__ __forceinline__ float silu_f(float v) { return v * __builtin_amdgcn_rcpf(1.0f + __builtin_amdgcn_exp2f(-1.4426950408889634f * v)); }
__device__ __forceinline__ float wave_sum(float v) {
#pragma unroll
    for (int o = 1; o < 64; o <<= 1) v += __shfl_xor(v, o);
    return v;
}

namespace pg8 {
constexpr int BM = 256, BK = 64, HALF = 128, HTB = HALF * BK * 2, NXCD = 8, WGM = 8;
__host__ __device__ __forceinline__ int lds_byte(int r, int c) { const int st = (r >> 4) * 2 + (c >> 5), rr = r & 15, cc = c & 31, ob = rr * 64 + cc * 2; return st * 1024 + (ob ^ (((ob >> 9) & 1) << 5)); }
__host__ __device__ __forceinline__ void stage_rc(int b, int& R, int& C) { const int st = b / 1024, sb = b % 1024, swz = sb ^ (((sb >> 9) & 1) << 5); R = (st >> 1) * 16 + swz / 64; C = (st & 1) * 32 + (swz % 64) / 2; }
__host__ __device__ __forceinline__ int perm32(int rho) { const int n = rho >> 4, i = rho & 15; return 8 * (i >> 2) + 4 * n + (i & 3); }

struct Unit { int pm, pn; };
struct Gemm { const bf16_t* A; const bf16_t* Bt; int M, N, K; };

struct StaticOrder {
    int nM, nN, nwg, G, c;
    __device__ void init(int M, int N, int G_, int c_) { nM = M / BM; nN = N / BM; nwg = nM * nN; G = G_; c = c_; }
    __device__ bool next(int i, Unit& u) const {
        const long L = (long)i * G + c; if (L >= nwg) return false;
        int wgid = (int)L; { const int q = nwg / NXCD, r = nwg % NXCD, xcd = wgid % NXCD, off = wgid / NXCD; wgid = (xcd < r ? xcd * (q + 1) : r * (q + 1) + (xcd - r) * q) + off; }
        const int nig = WGM * nN, gid = wgid / nig, fm = gid * WGM, gsz = (nM - fm) < WGM ? (nM - fm) : WGM;
        u.pm = fm + ((wgid % nig) % gsz); u.pn = (wgid % nig) / gsz; return true;
    }
};
struct NoHook {
    __device__ __forceinline__ void begin(const Unit&, LAS unsigned char*) const {}
    __device__ __forceinline__ void at(f32x4 (&)[2][2][4][2], int, int, int, LAS unsigned char*) const {}
};

template <bool ALIGN_EPI, bool SP2, class Epi, class Sched, class Hook>
__device__ __forceinline__ void gemm_phase(LAS unsigned char* lds, const Gemm g, const Sched& S, const Epi& E, const Hook& H) {
    int tid_ = threadIdx.x; asm volatile("" : "+v"(tid_));
    const int tid = tid_, wid = __builtin_amdgcn_readfirstlane(tid >> 6), lane = tid & 63, wr = wid >> 2, wc = wid & 3, fr = lane & 15, fq = lane >> 4;
    const int K = g.K, nt = K / BK;
    unsigned voffA[2], voffB[2];
#pragma unroll
    for (int i = 0; i < 2; ++i) { int R, C; stage_rc(tid * 16 + i * 8192, R, C); const int Rb = Epi::PERM ? ((R & ~31) + perm32(R & 31)) : R;
        voffA[i] = (unsigned)(R * K + C) * 2u; voffB[i] = (unsigned)(Rb * K + C) * 2u; }
    const size_t kstep = (size_t)(BK * 2);
    const size_t hstep = (size_t)HALF * K * 2;
    const size_t tstep = 2 * hstep;
    const unsigned ldsw = (unsigned)wid * 1024u;
    const int aoff = lds_byte(wr * 64 + fr, fq * 8), boff = lds_byte(wc * 32 + fr, fq * 8);
#define PG8_SA(b, h) (((b) * 2 + (h)) * HTB)
#define PG8_SB(b, h) ((4 + (b) * 2 + (h)) * HTB)
#define PG8_STAGE(bufoff, gbase, voff) do { _Pragma("unroll") for (int _i = 0; _i < 2; ++_i) \
        __builtin_amdgcn_global_load_lds((const unsigned*)((const char*)(gbase) + (voff)[_i]), (LAS unsigned*)(lds + (bufoff) + ldsw + _i * 8192), 16, 0, 0); } while (0)
#define PG8_LDA(dst, b, h) do { _Pragma("unroll") for (int m = 0; m < 4; ++m) _Pragma("unroll") for (int k = 0; k < 2; ++k) dst[m][k] = *(const LAS bf16x8*)(lds + PG8_SA(b, h) + aoff + m * 2048 + k * 1024); } while (0)
#define PG8_LDB(dst, b, h) do { _Pragma("unroll") for (int n = 0; n < 2; ++n) _Pragma("unroll") for (int k = 0; k < 2; ++k) dst[n][k] = *(const LAS bf16x8*)(lds + PG8_SB(b, h) + boff + n * 2048 + k * 1024); } while (0)
#define PG8_MMA(ai, bj, At, Bt) do { __builtin_amdgcn_s_setprio(1); _Pragma("unroll") for (int m = 0; m < 4; ++m) _Pragma("unroll") for (int n = 0; n < 2; ++n) _Pragma("unroll") for (int k = 0; k < 2; ++k) \
        acc[ai][bj][m][n] = __builtin_amdgcn_mfma_f32_16x16x32_bf16(Bt[n][k], At[m][k], acc[ai][bj][m][n], 0, 0, 0); __builtin_amdgcn_s_setprio(0); } while (0)
#define PG8_WAIT_V(n) asm volatile("s_waitcnt vmcnt(" #n ")" ::: "memory")
#define PG8_WAIT_L(n) asm volatile("s_waitcnt lgkmcnt(" #n ")" ::: "memory")
#define PG8_BAR __builtin_amdgcn_s_barrier()
#define PG8_SCHED __builtin_amdgcn_sched_barrier(0)
    Unit cur, nxt; int ui = 0;
    if (!S.next(0, cur)) return;
    f32x4 acc[2][2][4][2];
#pragma unroll
    for (int a = 0; a < 2; ++a)
#pragma unroll
        for (int b = 0; b < 2; ++b)
#pragma unroll
            for (int m = 0; m < 4; ++m)
#pragma unroll
                for (int n = 0; n < 2; ++n) acc[a][b][m][n] = (f32x4){0.f, 0.f, 0.f, 0.f};
    bf16x8 At[4][2], B0[2][2], B1[2][2];
    const char* cA = (const char*)g.A + (size_t)cur.pm * tstep; const char* cB = (const char*)g.Bt + (size_t)cur.pn * tstep;
    H.begin(cur, lds);
    if constexpr (SP2) {
        PG8_STAGE(PG8_SB(0, 0), cB, voffB); PG8_STAGE(PG8_SB(0, 1), cB + hstep, voffB); PG8_STAGE(PG8_SA(0, 0), cA, voffA); PG8_STAGE(PG8_SA(0, 1), cA + hstep, voffA);
        if (wr == 1) PG8_BAR;
        PG8_WAIT_V(2); PG8_BAR;
        PG8_STAGE(PG8_SB(1, 0), cB + kstep, voffB); PG8_STAGE(PG8_SA(1, 0), cA + kstep, voffA); PG8_STAGE(PG8_SB(1, 1), cB + hstep + kstep, voffB);
        PG8_WAIT_V(6); PG8_BAR;
    } else {
        PG8_STAGE(PG8_SB(0, 0), cB, voffB); PG8_STAGE(PG8_SA(0, 0), cA, voffA); PG8_STAGE(PG8_SB(0, 1), cB + hstep, voffB); PG8_STAGE(PG8_SA(0, 1), cA + hstep, voffA);
        if (wr == 1) PG8_BAR;
        PG8_WAIT_V(4); PG8_BAR;
        PG8_STAGE(PG8_SB(1, 0), cB + kstep, voffB); PG8_STAGE(PG8_SA(1, 0), cA + kstep, voffA); PG8_STAGE(PG8_SB(1, 1), cB + hstep + kstep, voffB);
        PG8_WAIT_V(6); PG8_BAR;
    }
    for (;;) {
        const bool has_next = S.next(ui + 1, nxt);
        const char* nA = has_next ? (const char*)g.A + (size_t)nxt.pm * tstep : cA; const char* nB = has_next ? (const char*)g.Bt + (size_t)nxt.pn * tstep : cB;
        for (int t = 0; t < nt; t += 2) {
            const bool last = (t == nt - 2);
            const char* a1 = cA + (size_t)(t + 1) * kstep;
            const char* a2 = last ? nA : cA + (size_t)(t + 2) * kstep; const char* b2 = last ? nB : cB + (size_t)(t + 2) * kstep;
            const char* a3 = a2 + kstep; const char* b3 = b2 + kstep;
            H.at(acc, t, wr, fr, lds);
            if constexpr (SP2) {
            PG8_LDB(B0, 0, 0); PG8_LDB(B1, 0, 1); PG8_SCHED; PG8_LDA(At, 0, 0); PG8_STAGE(PG8_SA(1, 1), a1 + hstep, voffA);
            PG8_WAIT_V(8); PG8_WAIT_L(0); PG8_BAR; PG8_MMA(0, 0, At, B0); PG8_MMA(0, 1, At, B1); PG8_BAR; PG8_SCHED;
            PG8_LDA(At, 0, 1); PG8_STAGE(PG8_SB(0, 0), b2, voffB); PG8_STAGE(PG8_SB(0, 1), b2 + hstep, voffB); PG8_STAGE(PG8_SA(0, 0), a2, voffA);
            PG8_WAIT_V(8); PG8_WAIT_L(0); PG8_BAR; PG8_MMA(1, 0, At, B0); PG8_MMA(1, 1, At, B1); PG8_BAR; PG8_SCHED;
            PG8_LDB(B0, 1, 0); PG8_LDB(B1, 1, 1); PG8_SCHED; PG8_LDA(At, 1, 0); PG8_STAGE(PG8_SA(0, 1), a2 + hstep, voffA);
            PG8_WAIT_V(8); PG8_WAIT_L(0); PG8_BAR; PG8_MMA(0, 0, At, B0); PG8_MMA(0, 1, At, B1); PG8_BAR; PG8_SCHED;
            PG8_LDA(At, 1, 1); PG8_STAGE(PG8_SB(1, 0), b3, voffB); PG8_STAGE(PG8_SB(1, 1), b3 + hstep, voffB); PG8_STAGE(PG8_SA(1, 0), a3, voffA);
            PG8_WAIT_V(8); PG8_WAIT_L(0); PG8_BAR; PG8_MMA(1, 0, At, B0); PG8_MMA(1, 1, At, B1); PG8_BAR; PG8_SCHED;
            } else {
            PG8_LDB(B0, 0, 0); PG8_SCHED; PG8_LDA(At, 0, 0); PG8_STAGE(PG8_SA(1, 1), a1 + hstep, voffA);
            PG8_WAIT_L(8); PG8_BAR; PG8_WAIT_L(0); PG8_MMA(0, 0, At, B0); PG8_BAR; PG8_SCHED;
            PG8_LDB(B1, 0, 1); PG8_STAGE(PG8_SB(0, 0), b2, voffB);
            PG8_BAR; PG8_WAIT_L(0); PG8_MMA(0, 1, At, B1); PG8_BAR;
            PG8_LDA(At, 0, 1); PG8_STAGE(PG8_SA(0, 0), a2, voffA);
            PG8_BAR; PG8_WAIT_L(0); PG8_MMA(1, 0, At, B0); PG8_BAR; PG8_SCHED;
            PG8_STAGE(PG8_SB(0, 1), b2 + hstep, voffB);
            PG8_WAIT_V(6); PG8_BAR; PG8_MMA(1, 1, At, B1); PG8_BAR;
            PG8_LDB(B0, 1, 0); PG8_SCHED; PG8_LDA(At, 1, 0); PG8_STAGE(PG8_SA(0, 1), a2 + hstep, voffA);
            PG8_WAIT_L(8); PG8_BAR; PG8_WAIT_L(0); PG8_MMA(0, 0, At, B0); PG8_BAR; PG8_SCHED;
            PG8_LDB(B1, 1, 1); PG8_STAGE(PG8_SB(1, 0), b3, voffB);
            PG8_BAR; PG8_WAIT_L(0); PG8_MMA(0, 1, At, B1); PG8_BAR;
            PG8_LDA(At, 1, 1); PG8_STAGE(PG8_SA(1, 0), a3, voffA);
            PG8_BAR; PG8_WAIT_L(0); PG8_MMA(1, 0, At, B0); PG8_BAR; PG8_SCHED;
            PG8_STAGE(PG8_SB(1, 1), b3 + hstep, voffB);
            PG8_WAIT_V(6); PG8_BAR; PG8_MMA(1, 1, At, B1); PG8_BAR;
            }
        }
        if constexpr (ALIGN_EPI) { if (wr == 0) PG8_BAR; }
        E(acc, cur, wr, wc, fr, fq);
        if (!has_next) break;
#pragma unroll
        for (int a = 0; a < 2; ++a)
#pragma unroll
            for (int b = 0; b < 2; ++b)
#pragma unroll
                for (int m = 0; m < 4; ++m)
#pragma unroll
                    for (int n = 0; n < 2; ++n) acc[a][b][m][n] = (f32x4){0.f, 0.f, 0.f, 0.f};
        cur = nxt; cA = nA; cB = nB; ++ui;
        H.begin(cur, lds);
        if constexpr (ALIGN_EPI) { if (wr == 1) PG8_BAR; }
    }
    PG8_WAIT_V(0);
    if constexpr (!ALIGN_EPI) { if (wr == 0) PG8_BAR; }
    PG8_BAR;
#undef PG8_SA
#undef PG8_SB
#undef PG8_STAGE
#undef PG8_LDA
#undef PG8_LDB
#undef PG8_MMA
#undef PG8_WAIT_V
#undef PG8_WAIT_L
#undef PG8_BAR
#undef PG8_SCHED
}
}

struct EpiIn0 {
    static constexpr bool PERM = true;
    bf16_t *Y0, *XBC, *Q0, *K0, *V0; const float* rstd; float* kpart;
    __device__ __forceinline__ void operator()(const f32x4 (&acc)[2][2][4][2], const pg8::Unit& u, int wr, int wc, int fr, int fq) const {
        const int pn = u.pn; bf16_t* base; int ld, colt, mode;
        if (pn < 8) { base = Y0; ld = 2048; colt = pn * 256; mode = 1; }
        else if (pn < 14) { base = XBC; ld = 1536; colt = (pn - 8) * 256; mode = 0; }
        else if (pn < 18) { base = Q0; ld = 1024; colt = (pn - 14) * 256; mode = 2; }
        else if (pn < 22) { base = K0; ld = 1024; colt = (pn - 18) * 256; mode = 3; }
        else { base = V0; ld = 1024; colt = (pn - 22) * 256; mode = 0; }
        const int row0 = u.pm * 256 + wr * 64 + fr, col0 = colt + wc * 32 + 8 * fq;
        float cs[2][8];
#pragma unroll
        for (int bj = 0; bj < 2; ++bj)
#pragma unroll
            for (int e = 0; e < 8; ++e) cs[bj][e] = 0.f;
#pragma unroll
        for (int ai = 0; ai < 2; ++ai)
#pragma unroll
            for (int m = 0; m < 4; ++m) {
                const int row = row0 + ai * 128 + m * 16; const float rs = rstd[row]; bf16_t* rowp = base + (size_t)row * ld + col0;
#pragma unroll
                for (int bj = 0; bj < 2; ++bj) {
                    float v[8];
#pragma unroll
                    for (int e = 0; e < 4; ++e) { v[e] = acc[ai][bj][m][0][e] * rs; v[4 + e] = acc[ai][bj][m][1][e] * rs; }
                    if (mode == 1) {
#pragma unroll
                        for (int e = 0; e < 8; ++e) v[e] = silu_f(v[e]);
                    } else if (mode == 2) {
#pragma unroll
                        for (int e = 0; e < 8; ++e) v[e] *= QSCALE;
                    } else if (mode == 3) {
#pragma unroll
                        for (int e = 0; e < 8; ++e) cs[bj][e] += v[e];
                    }
                    u32x4 w; w.x = pk2(v[0], v[1]); w.y = pk2(v[2], v[3]); w.z = pk2(v[4], v[5]); w.w = pk2(v[6], v[7]);
                    *(u32x4*)(rowp + bj * 128) = w;
                }
            }
        if (mode == 3) {
#pragma unroll
            for (int bj = 0; bj < 2; ++bj)
#pragma unroll
                for (int e = 0; e < 8; ++e) { float s = cs[bj][e]; s += __shfl_xor(s, 1); s += __shfl_xor(s, 2); s += __shfl_xor(s, 4); s += __shfl_xor(s, 8); cs[bj][e] = s; }
            if (fr == 0) {
                float* kp = kpart + ((size_t)u.pm * 2 + wr) * 1024 + col0;
#pragma unroll
                for (int bj = 0; bj < 2; ++bj) { *(f32x4*)(kp + bj * 128) = (f32x4){cs[bj][0], cs[bj][1], cs[bj][2], cs[bj][3]}; *(f32x4*)(kp + bj * 128 + 4) = (f32x4){cs[bj][4], cs[bj][5], cs[bj][6], cs[bj][7]}; }
            }
        }
    }
};
struct EpiRes {
    static constexpr bool PERM = false;
    const float* xi; float* xo; bf16_t* xb; float* rsq;
    __device__ __forceinline__ void operator()(const f32x4 (&acc)[2][2][4][2], const pg8::Unit& u, int wr, int wc, int fr, int fq) const {
        const int col0 = u.pn * 256 + wc * 32 + 4 * fq;
#pragma unroll
        for (int ai = 0; ai < 2; ++ai)
#pragma unroll
            for (int m = 0; m < 4; ++m) {
                const int row = u.pm * 256 + ai * 128 + wr * 64 + m * 16 + fr; const size_t off = (size_t)row * DM + col0; float ss = 0.f;
#pragma unroll
                for (int bj = 0; bj < 2; ++bj)
#pragma unroll
                    for (int n = 0; n < 2; ++n) {
                        const f32x4 b = *(const f32x4*)(xi + off + bj * 128 + n * 16); const f32x4 o = b + acc[ai][bj][m][n];
                        *(f32x4*)(xo + off + bj * 128 + n * 16) = o; ss += (o[0] * o[0] + o[1] * o[1]) + (o[2] * o[2] + o[3] * o[3]);
                        if (xb) { u32x2 w; w.x = pk2(o[0], o[1]); w.y = pk2(o[2], o[3]); *(u32x2*)(xb + off + bj * 128 + n * 16) = w; }
                    }
                ss += __shfl_xor(ss, 16); ss += __shfl_xor(ss, 32);
                if (fq == 0) rsq[(size_t)row * 16 + u.pn * 4 + wc] = ss;
            }
    }
};
__device__ __forceinline__ float rstd_from16(const float* p) {
    const f32x4 a = *(const f32x4*)p, b = *(const f32x4*)(p + 4), c = *(const f32x4*)(p + 8), d = *(const f32x4*)(p + 12);
    const float s = ((a[0] + a[1]) + (a[2] + a[3])) + ((b[0] + b[1]) + (b[2] + b[3])) + ((c[0] + c[1]) + (c[2] + c[3])) + ((d[0] + d[1]) + (d[2] + d[3]));
    return 1.0f / sqrtf(s * (1.0f / 1024.0f) + NORM_EPS);
}
struct EpiQkv1 {
    static constexpr bool PERM = true;
    bf16_t* O; size_t split_stride; const float* rsq;
    __device__ __forceinline__ void operator()(const f32x4 (&acc)[2][2][4][2], const pg8::Unit& u, int wr, int wc, int fr, int fq) const {
        const int t = u.pn >> 3; bf16_t* base = O + (size_t)t * split_stride; const int colt = (u.pn & 7) * 256; const float sc = (t == 0) ? QSCALE : 1.0f;
        const int row0 = u.pm * 256 + wr * 64 + fr, col0 = colt + wc * 32 + 8 * fq;
#pragma unroll
        for (int ai = 0; ai < 2; ++ai)
#pragma unroll
            for (int m = 0; m < 4; ++m) {
                const int row = row0 + ai * 128 + m * 16; const float rs = rstd_from16(rsq + (size_t)row * 16) * sc; bf16_t* rowp = base + (size_t)row * 2048 + col0;
#pragma unroll
                for (int bj = 0; bj < 2; ++bj) { const f32x4 v0 = acc[ai][bj][m][0] * rs, v1 = acc[ai][bj][m][1] * rs;
                    u32x4 w; w.x = pk2(v0[0], v0[1]); w.y = pk2(v0[2], v0[3]); w.z = pk2(v1[0], v1[1]); w.w = pk2(v1[2], v1[3]); *(u32x4*)(rowp + bj * 128) = w; }
            }
    }
};
struct EpiGate1 {
    static constexpr bool PERM = true;
    bf16_t* O; const float* rsq;
    __device__ __forceinline__ void operator()(const f32x4 (&acc)[2][2][4][2], const pg8::Unit& u, int wr, int wc, int fr, int fq) const {
        const int row0 = u.pm * 256 + wr * 64 + fr, col0 = u.pn * 256 + wc * 32 + 8 * fq;
#pragma unroll
        for (int ai = 0; ai < 2; ++ai)
#pragma unroll
            for (int m = 0; m < 4; ++m) {
                const int row = row0 + ai * 128 + m * 16; const float rs = rstd_from16(rsq + (size_t)row * 16); bf16_t* rowp = O + (size_t)row * 2048 + col0;
#pragma unroll
                for (int bj = 0; bj < 2; ++bj) { const f32x4 v0 = acc[ai][bj][m][0] * rs, v1 = acc[ai][bj][m][1] * rs; const u32x4 o = *(const u32x4*)(rowp + bj * 128);
                    u32x4 w; w.x = pk2(bf_lo(o.x) * silu_f(v0[0]), bf_hi(o.x) * silu_f(v0[1])); w.y = pk2(bf_lo(o.y) * silu_f(v0[2]), bf_hi(o.y) * silu_f(v0[3]));
                    w.z = pk2(bf_lo(o.z) * silu_f(v1[0]), bf_hi(o.z) * silu_f(v1[1])); w.w = pk2(bf_lo(o.w) * silu_f(v1[2]), bf_hi(o.w) * silu_f(v1[3])); *(u32x4*)(rowp + bj * 128) = w; }
            }
    }
};
struct HookSsdNorm {
    const float* ssq;
    __device__ __forceinline__ void begin(const pg8::Unit& u, LAS unsigned char* lds) const {
        LAS float* T = (LAS float*)(lds + RING_BYTES);
        const int t = threadIdx.x;
        if (t < 256) { const float* p = ssq + (size_t)(u.pm * 256 + t) * 16; const f32x4 a = *(const f32x4*)p, b = *(const f32x4*)(p + 4), c = *(const f32x4*)(p + 8), d = *(const f32x4*)(p + 12);
            const float g0 = ((a[0] + a[1]) + (a[2] + a[3])) + ((b[0] + b[1]) + (b[2] + b[3])), g1 = ((c[0] + c[1]) + (c[2] + c[3])) + ((d[0] + d[1]) + (d[2] + d[3]));
            const float r0 = 1.0f / sqrtf(g0 * (1.0f / 512.0f) + NORM_EPS), r1 = 1.0f / sqrtf(g1 * (1.0f / 512.0f) + NORM_EPS);
            T[2 * t] = r0 / r1; T[2 * t + 1] = r1; }
    }
    __device__ __forceinline__ void at(f32x4 (&acc)[2][2][4][2], int t, int wr, int fr, LAS unsigned char* lds) const {
        if (t == 8 || t == 16) {
            const LAS float* T = (const LAS float*)(lds + RING_BYTES); const int sel = (t == 16);
#pragma unroll
            for (int ai = 0; ai < 2; ++ai)
#pragma unroll
                for (int m = 0; m < 4; ++m) { const float f = T[2 * (ai * 128 + wr * 64 + m * 16 + fr) + sel];
#pragma unroll
                    for (int bj = 0; bj < 2; ++bj)
#pragma unroll
                        for (int n = 0; n < 2; ++n) acc[ai][bj][m][n] = acc[ai][bj][m][n] * f; }
        }
    }
};

__device__ __forceinline__ void transpose_item(const float* W, int K, int Nsrc, int src_col0, bf16_t* WT, int dst_row0, const float* gain, int gain_n, LAS float* scr, int kb, int nb, int lane) {
    const int k0 = 64 * kb, n0 = 32 * nb;
    float wv[32];
#pragma unroll
    for (int i = 0; i < 32; ++i) wv[i] = W[(size_t)(k0 + 2 * i + (lane >> 5)) * Nsrc + src_col0 + n0 + (lane & 31)];
#pragma unroll
    for (int i = 0; i < 32; ++i) { const int kk = 2 * i + (lane >> 5); const int k = k0 + kk; const float gsc = (gain && k < gain_n) ? gain[k] : 1.0f;
        scr[kk * 33 + (lane & 31)] = wv[i] * gsc; }
    asm volatile("s_waitcnt lgkmcnt(0)" ::: "memory");
    const int c = lane & 7;
#pragma unroll
    for (int j = 0; j < 4; ++j) { const int n = (lane >> 3) + 8 * j; const LAS float* s = scr + (8 * c) * 33 + n;
        u32x4 o; o.x = pk2(s[0 * 33], s[1 * 33]); o.y = pk2(s[2 * 33], s[3 * 33]); o.z = pk2(s[4 * 33], s[5 * 33]); o.w = pk2(s[6 * 33], s[7 * 33]);
        *(u32x4*)(WT + (size_t)(dst_row0 + n0 + n) * K + k0 + 8 * c) = o; }
    asm volatile("s_waitcnt lgkmcnt(0)" ::: "memory");
}
__device__ __forceinline__ float softplus_f(float v) { return v > 20.f ? v : log1pf(expf(v)); }

__device__ __forceinline__ void phase_prep(const Params& P, LAS unsigned char* lds, int G) {
    const int tid = threadIdx.x, lane = tid & 63, wave = tid >> 6;
    const int gw = blockIdx.x * 8 + wave, NGW = G * 8;
    unsigned char* ws = P.ws;
    if (blockIdx.x == 0 && tid < 256) ((unsigned*)(ws + WS_CTL))[tid] = 0u;
    {
        LAS float* scr = (LAS float*)(lds + wave * 16384);
        bf16_t* W0T = (bf16_t*)(ws + WS_W0T); bf16_t* WO0T = (bf16_t*)(ws + WS_WO0T); bf16_t* W1T = (bf16_t*)(ws + WS_W1T); bf16_t* WO1T = (bf16_t*)(ws + WS_WO1T);
        constexpr int I0 = 16 * 208, IO0 = 32 * 32, I1 = 16 * 256, IO1 = 32 * 32;
        for (int it = gw; it < I0 + IO0 + I1 + IO1; it += NGW) {
            int r = it;
            if (r < I0) { const int kb = r / 208, nb = r % 208; const int n0 = nb * 32;
                int src; if (n0 < 1024) src = n0; else if (n0 < 2048) src = n0 - 1024 + 5648; else if (n0 < 3584) src = n0 - 2048 + 1024; else src = n0 - 3584 + 2576;
                transpose_item(P.w_in0, 1024, EVEN_IN, src - n0, W0T, 0, P.even_norm, 1024, scr, kb, nb, lane); continue; }
            r -= I0;
            if (r < IO0) { transpose_item(P.w_out0, 2048, 1024, 0, WO0T, 0, P.ssd_norm, 1024, scr, r / 32, r % 32, lane); continue; }
            r -= IO0;
            if (r < I1) { transpose_item(P.w_in1, 1024, 8192, 0, W1T, 0, P.odd_norm, 1024, scr, r / 256, r % 256, lane); continue; }
            r -= I1;
            transpose_item(P.w_out1, 2048, 1024, 0, WO1T, 0, nullptr, 0, scr, r / 32, r % 32, lane);
        }
    }
    __syncthreads();
    {
        LAS float* Wd = (LAS float*)lds;
        for (int i = tid; i < 16 * 1024; i += NTHREADS) { const int k = i >> 4, h = i & 15; Wd[h * 1024 + k] = P.w_in0[(size_t)k * EVEN_IN + 2560 + h] * P.even_norm[k]; }
        __syncthreads();
        bf16_t* xb = (bf16_t*)P.out; float* rstd0 = (float*)(ws + WS_RSTD0); float* dt = (float*)(ws + WS_DT);
        for (int m = gw; m < MTOK; m += NGW) {
            const f32x4* xr = (const f32x4*)(P.x + (size_t)m * DM) + lane;
            f32x4 v[4]; float s = 0.f;
#pragma unroll
            for (int j = 0; j < 4; ++j) { v[j] = xr[64 * j]; s += (v[j][0] * v[j][0] + v[j][1] * v[j][1]) + (v[j][2] * v[j][2] + v[j][3] * v[j][3]); }
            const float rs = 1.0f / sqrtf(wave_sum(s) * (1.0f / DM) + NORM_EPS);
            unsigned long long* o8 = (unsigned long long*)(xb + (size_t)m * DM) + lane;
#pragma unroll
            for (int j = 0; j < 4; ++j) o8[64 * j] = (unsigned long long)pk2(v[j][0], v[j][1]) | ((unsigned long long)pk2(v[j][2], v[j][3]) << 32);
            float mine = 0.f;
#pragma unroll 1
            for (int h = 0; h < 16; ++h) { float a = 0.f;
#pragma unroll
                for (int j = 0; j < 4; ++j) { const f32x4 w = *(const LAS f32x4*)(Wd + h * 1024 + 256 * j + 4 * lane); a += (v[j][0] * w[0] + v[j][1] * w[1]) + (v[j][2] * w[2] + v[j][3] * w[3]); }
                a = wave_sum(a); if (lane == h) mine = a; }
            if (lane == 0) rstd0[m] = rs;
            if (lane < 16) dt[(size_t)m * 16 + lane] = softplus_f(mine * rs + P.dt_bias[lane]);
        }
    }
}

__device__ __forceinline__ void ssd_item(const Params& P, LAS unsigned char* lds, int b, int h) {
    constexpr int TT = 64;
    const int tid = threadIdx.x;
    unsigned char* ws = P.ws;
    const bf16_t* XBC = (const bf16_t*)(ws + WS_XBC); bf16_t* Y0 = (bf16_t*)(ws + WS_Y0); const float* dt = (const float*)(ws + WS_DT); float* ssq = (float*)(ws + WS_SSQ);
    LAS float* xc = (LAS float*)lds;
    LAS float* Bc = xc + TT * 64;
    LAS float* Cc = Bc + TT * 128;
    LAS float* zs = Cc + TT * 128;
    LAS float* uo = zs + TT * 64;
    LAS float* dtv = uo + TT * 64;
    LAS float* dec = dtv + TT;
    const int g = h >> 3;
    const float a = -expf(P.a_log[h]), Dh = P.d_skip[h];
    const int p = tid >> 3, ng = tid & 7;
    float st[16];
#pragma unroll
    for (int i = 0; i < 16; ++i) st[i] = 0.f;
    int ch = 0; float cw0 = 0.f, cw1 = 0.f, cw2 = 0.f, cw3 = 0.f, cb = 0.f;
    if (tid < 320) { ch = tid < 64 ? h * 64 + tid : (tid < 192 ? 1024 + g * 128 + (tid - 64) : 1280 + g * 128 + (tid - 192));
        cw0 = P.conv_w[ch]; cw1 = P.conv_w[1536 + ch]; cw2 = P.conv_w[2 * 1536 + ch]; cw3 = P.conv_w[3 * 1536 + ch]; cb = P.conv_b[ch]; }
    for (int t0 = 0; t0 < SEQ; t0 += TT) {
        const size_t tok0 = (size_t)b * SEQ + t0;
        if (tid < 320) {
            float w0 = 0.f, w1 = 0.f, w2 = 0.f;
            if (t0 > 0) { w0 = bf2f(XBC[(tok0 - 3) * 1536 + ch]); w1 = bf2f(XBC[(tok0 - 2) * 1536 + ch]); w2 = bf2f(XBC[(tok0 - 1) * 1536 + ch]); }
            LAS float* dst = tid < 64 ? xc + tid : (tid < 192 ? Bc + (tid - 64) : Cc + (tid - 192)); const int dstride = tid < 64 ? 64 : 128;
            for (int tt = 0; tt < TT; ++tt) { const float w3 = bf2f(XBC[(tok0 + tt) * 1536 + ch]);
                const float v = cb + cw0 * w0 + cw1 * w1 + cw2 * w2 + cw3 * w3; dst[tt * dstride] = silu_f(v); w0 = w1; w1 = w2; w2 = w3; }
        } else if (tid < 320 + TT) { const int tt = tid - 320; const float d = dt[(tok0 + tt) * 16 + h]; dtv[tt] = d; dec[tt] = expf(d * a); }
        for (int i = tid; i < TT * 64; i += NTHREADS) { const int tt = i >> 6, pp = i & 63; zs[i] = bf2f(Y0[(tok0 + tt) * 2048 + h * 64 + pp]); }
        __syncthreads();
        for (int tt = 0; tt < TT; ++tt) {
            const float xv = xc[tt * 64 + p], xdt = xv * dtv[tt], dc = dec[tt];
            const LAS float* Bp = Bc + tt * 128 + 16 * ng; const LAS float* Cp = Cc + tt * 128 + 16 * ng;
            float yp = 0.f;
#pragma unroll
            for (int i = 0; i < 16; ++i) { st[i] = st[i] * dc + xdt * Bp[i]; yp += st[i] * Cp[i]; }
            yp += __shfl_xor(yp, 1); yp += __shfl_xor(yp, 2); yp += __shfl_xor(yp, 4);
            if (ng == 0) uo[tt * 64 + p] = (yp + Dh * xv) * zs[tt * 64 + p];
        }
        __syncthreads();
        { const int tt = tid >> 3, part = tid & 7; const LAS float* up = uo + tt * 64 + part * 8; float v[8]; float ss = 0.f;
#pragma unroll
            for (int e = 0; e < 8; ++e) { v[e] = up[e]; ss += v[e] * v[e]; }
            u32x4 w; w.x = pk2(v[0], v[1]); w.y = pk2(v[2], v[3]); w.z = pk2(v[4], v[5]); w.w = pk2(v[6], v[7]);
            *(u32x4*)(Y0 + (tok0 + tt) * 2048 + h * 64 + part * 8) = w;
            ss += __shfl_xor(ss, 1); ss += __shfl_xor(ss, 2); ss += __shfl_xor(ss, 4);
            if (part == 0) ssq[(tok0 + tt) * 16 + h] = ss; }
        __syncthreads();
    }
}

struct KeysDilated {
    __device__ __forceinline__ int nkeys(int) const { return 387; }
    __device__ __forceinline__ int keypos(int qpos, int idx) const { const int pt = idx / 129, j = idx - pt * 129; return qpos - (j << (2 * pt)); }
};
struct KeysMoba {
    const LAS int* sel;
    int q0;
    __device__ __forceinline__ int nkeys(int qpos) const { return sel[(qpos - q0) * 4] * 256 + (qpos & 255) + 1; }
    __device__ __forceinline__ int keypos(int qpos, int idx) const { const LAS int* s = sel + (qpos - q0) * 4; const int ns = s[0];
        if (idx < ns * 256) return s[1 + (idx >> 8)] * 256 + (idx & 255);
        return (qpos & ~255) + (idx - ns * 256); }
};
template <class KS>
__device__ __forceinline__ void attn_simple_core(const KS& ks, LAS float* qs, LAS float* Ssc, const bf16_t* Kp, const bf16_t* Vp, int ld, int q0, float (&o)[8], float& lsum) {
    const int tid = threadIdx.x, qi = tid >> 4, part = tid & 15;
    const int qpos = q0 + qi, nk = ks.nkeys(qpos);
    LAS float* Sr = Ssc + qi * 1024; const LAS float* qr = qs + qi * 128;
    float mx = -3.0e38f;
    for (int idx = part; idx < nk; idx += 16) {
        const int pos = ks.keypos(qpos, idx); float s = -__builtin_inff();
        if (pos >= 0) { const u32x4* kr = (const u32x4*)(Kp + (size_t)pos * ld); float a = 0.f;
#pragma unroll
            for (int c = 0; c < 16; ++c) { const u32x4 w = kr[c]; const f32x4 q0v = *(const LAS f32x4*)(qr + 8 * c), q1v = *(const LAS f32x4*)(qr + 8 * c + 4);
                a += (bf_lo(w.x) * q0v[0] + bf_hi(w.x) * q0v[1]) + (bf_lo(w.y) * q0v[2] + bf_hi(w.y) * q0v[3]) + (bf_lo(w.z) * q1v[0] + bf_hi(w.z) * q1v[1]) + (bf_lo(w.w) * q1v[2] + bf_hi(w.w) * q1v[3]); }
            s = a; }
        Sr[idx] = s; mx = fmaxf(mx, s);
    }
    mx = fmaxf(mx, __shfl_xor(mx, 1)); mx = fmaxf(mx, __shfl_xor(mx, 2)); mx = fmaxf(mx, __shfl_xor(mx, 4)); mx = fmaxf(mx, __shfl_xor(mx, 8));
    float l = 0.f;
    for (int idx = part; idx < nk; idx += 16) { const float pv = exp2f(Sr[idx] - mx); Sr[idx] = pv; l += pv; }
    l += __shfl_xor(l, 1); l += __shfl_xor(l, 2); l += __shfl_xor(l, 4); l += __shfl_xor(l, 8);
    lsum = l;
    asm volatile("s_waitcnt lgkmcnt(0)" ::: "memory");
    __syncthreads();
#pragma unroll
    for (int e = 0; e < 8; ++e) o[e] = 0.f;
    for (int idx = 0; idx < nk; ++idx) {
        const float pv = Sr[idx];
        if (pv != 0.f) { const int pos = ks.keypos(qpos, idx); const u32x4 w = *(const u32x4*)(Vp + (size_t)pos * ld + 8 * part);
            o[0] += pv * bf_lo(w.x); o[1] += pv * bf_hi(w.x); o[2] += pv * bf_lo(w.y); o[3] += pv * bf_hi(w.y); o[4] += pv * bf_lo(w.z); o[5] += pv * bf_hi(w.z); o[6] += pv * bf_lo(w.w); o[7] += pv * bf_hi(w.w); }
    }
}
__device__ __forceinline__ void load_q_tile(LAS float* qs, const bf16_t* Qp, int ld) {
    const int tid = threadIdx.x, r = tid >> 4, c = tid & 15;
    const u32x4 w = *(const u32x4*)(Qp + (size_t)r * ld + 8 * c); LAS float* d = qs + r * 128 + 8 * c;
    d[0] = bf_lo(w.x); d[1] = bf_hi(w.x); d[2] = bf_lo(w.y); d[3] = bf_hi(w.y); d[4] = bf_lo(w.z); d[5] = bf_hi(w.z); d[6] = bf_lo(w.w); d[7] = bf_hi(w.w);
}
__device__ __forceinline__ void moba_item(const Params& P, LAS unsigned char* lds, int b, int h, int qt) {
    unsigned char* ws = P.ws; const int tid = threadIdx.x;
    LAS float* Ssc = (LAS float*)lds; LAS float* qs = (LAS float*)(lds + 131072); LAS float* gts = (LAS float*)(lds + 131072 + 16384); LAS int* sel = (LAS int*)(lds + 131072 + 16384 + 1024);
    const bf16_t* Q0 = (const bf16_t*)(ws + WS_Q0) + (size_t)b * SEQ * 1024 + h * 128; const bf16_t* K0 = (const bf16_t*)(ws + WS_K0) + (size_t)b * SEQ * 1024 + h * 128;
    const bf16_t* V0 = (const bf16_t*)(ws + WS_V0) + (size_t)b * SEQ * 1024 + h * 128; bf16_t* Y0 = (bf16_t*)(ws + WS_Y0) + (size_t)b * SEQ * 2048 + 1024 + h * 128;
    const float* kpart = (const float*)(ws + WS_KPART);
    const int q0 = qt * 32, qb = q0 >> 8;
    __syncthreads();
    load_q_tile(qs, Q0 + (size_t)q0 * 1024, 1024);
    __syncthreads();
    { const int qi = tid >> 4, n = tid & 15;
        if (n < qb) { const float* k0p = kpart + ((size_t)(b * 8 + n) * 2) * 1024 + h * 128; const float* k1p = k0p + 1024; float a = 0.f;
            for (int d = 0; d < 128; ++d) a += qs[qi * 128 + d] * (k0p[d] + k1p[d]);
            gts[qi * 8 + n] = a; } }
    __syncthreads();
    if (tid < 32) { const int ns = qb < 3 ? qb : 3; int s0 = -1, s1 = -1, s2 = -1; float g0 = -__builtin_inff(), g1 = g0, g2 = g0;
        for (int n = 0; n < qb; ++n) { const float gv = gts[tid * 8 + n];
            if (gv > g0) { g2 = g1; s2 = s1; g1 = g0; s1 = s0; g0 = gv; s0 = n; } else if (gv > g1) { g2 = g1; s2 = s1; g1 = gv; s1 = n; } else if (gv > g2) { g2 = gv; s2 = n; } }
        sel[tid * 4] = ns; sel[tid * 4 + 1] = s0 < 0 ? 0 : s0; sel[tid * 4 + 2] = s1 < 0 ? 0 : s1; sel[tid * 4 + 3] = s2 < 0 ? 0 : s2; }
    __syncthreads();
    KeysMoba ks{sel, q0}; float o[8]; float l;
    attn_simple_core(ks, qs, Ssc, K0, V0, 1024, q0, o, l);
    const int qi = tid >> 4, part = tid & 15; const float inv = 1.0f / l;
    bf16_t* yp = Y0 + (size_t)(q0 + qi) * 2048 + 8 * part; const u32x4 gw = *(const u32x4*)yp;
    u32x4 w; w.x = pk2(o[0] * inv * bf_lo(gw.x), o[1] * inv * bf_hi(gw.x)); w.y = pk2(o[2] * inv * bf_lo(gw.y), o[3] * inv * bf_hi(gw.y));
    w.z = pk2(o[4] * inv * bf_lo(gw.z), o[5] * inv * bf_hi(gw.z)); w.w = pk2(o[6] * inv * bf_lo(gw.w), o[7] * inv * bf_hi(gw.w));
    *(u32x4*)yp = w;
}
__device__ __forceinline__ void dilated_item(const Params& P, LAS unsigned char* lds, int b, int h, int qt) {
    unsigned char* ws = P.ws; const int tid = threadIdx.x;
    LAS float* Ssc = (LAS float*)lds; LAS float* qs = (LAS float*)(lds + 131072);
    bf16_t* Q1 = (bf16_t*)(ws + WS_QO1) + (size_t)b * SEQ * 2048 + h * 128; const bf16_t* K1 = (const bf16_t*)(ws + WS_K1) + (size_t)b * SEQ * 2048 + h * 128;
    const bf16_t* V1 = (const bf16_t*)(ws + WS_V1) + (size_t)b * SEQ * 2048 + h * 128;
    const int q0 = qt * 32;
    __syncthreads();
    load_q_tile(qs, Q1 + (size_t)q0 * 2048, 2048);
    __syncthreads();
    KeysDilated ks; float o[8]; float l;
    attn_simple_core(ks, qs, Ssc, K1, V1, 2048, q0, o, l);
    const int qi = tid >> 4, part = tid & 15; const float inv = 1.0f / l;
    u32x4 w; w.x = pk2(o[0] * inv, o[1] * inv); w.y = pk2(o[2] * inv, o[3] * inv); w.z = pk2(o[4] * inv, o[5] * inv); w.w = pk2(o[6] * inv, o[7] * inv);
    *(u32x4*)(Q1 + (size_t)(q0 + qi) * 2048 + 8 * part) = w;
}

typedef short s16x4 __attribute__((ext_vector_type(4)));
constexpr int KSTR = 272, VSTR = 288;
#define MFMA16(a, b, c) __builtin_amdgcn_mfma_f32_16x16x32_bf16((a), (b), (c), 0, 0, 0)
struct WTile { bf16x8 qf[4]; f32x4 o[8]; float m, l; };
__device__ __forceinline__ void wt_reset(WTile& w) {
#pragma unroll
    for (int d = 0; d < 8; ++d) w.o[d] = (f32x4){0.f, 0.f, 0.f, 0.f};
    w.m = -1.0e30f; w.l = 0.f;
}
__device__ __forceinline__ void wt_load_q(WTile& w, const bf16_t* qrow, int lane) {
    const int g = lane >> 4;
#pragma unroll
    for (int ks = 0; ks < 4; ++ks) w.qf[ks] = *(const bf16x8*)(qrow + 32 * ks + 8 * g);
}
__device__ __forceinline__ void wt_qk_lds(const WTile& w, const LAS unsigned char* Kb, int lane, f32x4& s0, f32x4& s1) {
    const LAS unsigned char* p = Kb + (lane & 15) * KSTR + (lane >> 4) * 16;
    s0 = (f32x4){0.f, 0.f, 0.f, 0.f}; s1 = s0;
#pragma unroll
    for (int ks = 0; ks < 4; ++ks) { const bf16x8 a0 = *(const LAS bf16x8*)(p + ks * 64), a1 = *(const LAS bf16x8*)(p + 16 * KSTR + ks * 64);
        s0 = MFMA16(a0, w.qf[ks], s0); s1 = MFMA16(a1, w.qf[ks], s1); }
}
__device__ __forceinline__ void wt_softmax_pv(WTile& w, f32x4 s0, f32x4 s1, const LAS unsigned char* Vb, int lane) {
    float mx = fmaxf(fmaxf(fmaxf(s0[0], s0[1]), fmaxf(s0[2], s0[3])), fmaxf(fmaxf(s1[0], s1[1]), fmaxf(s1[2], s1[3])));
    mx = fmaxf(mx, __shfl_xor(mx, 16)); mx = fmaxf(mx, __shfl_xor(mx, 32));
    const float mn = fmaxf(w.m, mx), alpha = __builtin_amdgcn_exp2f(w.m - mn);
    w.m = mn;
    float p[8];
#pragma unroll
    for (int r = 0; r < 4; ++r) { p[r] = __builtin_amdgcn_exp2f(s0[r] - mn); p[4 + r] = __builtin_amdgcn_exp2f(s1[r] - mn); }
    w.l = w.l * alpha + (((p[0] + p[1]) + (p[2] + p[3])) + ((p[4] + p[5]) + (p[6] + p[7])));
    u32x4 pw; pw.x = pk2(p[0], p[1]); pw.y = pk2(p[2], p[3]); pw.z = pk2(p[4], p[5]); pw.w = pk2(p[6], p[7]);
    const bf16x8 pf = __builtin_bit_cast(bf16x8, pw);
    const int i = lane & 15, g = lane >> 4;
    const LAS unsigned char* vp = Vb + (4 * g + (i >> 2)) * VSTR + (i & 3) * 8;
#pragma unroll
    for (int dt = 0; dt < 8; ++dt) {
        const s16x4 lo = __builtin_amdgcn_ds_read_tr16_b64_v4i16((LAS s16x4*)(vp + dt * 32));
        const s16x4 hi = __builtin_amdgcn_ds_read_tr16_b64_v4i16((LAS s16x4*)(vp + 16 * VSTR + dt * 32));
        const bf16x8 vf = __builtin_shufflevector(lo, hi, 0, 1, 2, 3, 4, 5, 6, 7);
        w.o[dt] = MFMA16(vf, pf, w.o[dt] * alpha);
    }
}

__device__ __forceinline__ void conv_prepass(const Params& P, int G) {
    const bf16_t* XBC = (const bf16_t*)(P.ws + WS_XBC); bf16_t* XC = (bf16_t*)P.out;
    const int ntask = 192 * 1024;
    for (int task = blockIdx.x * NTHREADS + threadIdx.x; task < ntask; task += G * NTHREADS) {
        const int cg8 = task % 192, run = task / 192, ch = 8 * cg8; const size_t tok0 = (size_t)run * 16; const bool first = (run & 127) == 0;
        u32x4 raw[19];
#pragma unroll
        for (int j = 0; j < 19; ++j) { raw[j] = (u32x4){0u, 0u, 0u, 0u}; if (j >= 3 || !first) raw[j] = *(const u32x4*)(XBC + (tok0 + j - 3) * 1536 + ch); }
        float cw[4][8], cb[8];
#pragma unroll
        for (int j = 0; j < 4; ++j) { const f32x4 a = *(const f32x4*)(P.conv_w + j * 1536 + ch), b2 = *(const f32x4*)(P.conv_w + j * 1536 + ch + 4);
#pragma unroll
            for (int e = 0; e < 4; ++e) { cw[j][e] = a[e]; cw[j][4 + e] = b2[e]; } }
        { const f32x4 a = *(const f32x4*)(P.conv_b + ch), b2 = *(const f32x4*)(P.conv_b + ch + 4);
#pragma unroll
            for (int e = 0; e < 4; ++e) { cb[e] = a[e]; cb[4 + e] = b2[e]; } }
#pragma unroll
        for (int tt = 0; tt < 16; ++tt) { float o[8];
#pragma unroll
            for (int e = 0; e < 8; ++e) { float acc = cb[e];
#pragma unroll
                for (int j = 0; j < 4; ++j) { const unsigned wq = (e < 2) ? raw[tt + j].x : (e < 4 ? raw[tt + j].y : (e < 6 ? raw[tt + j].z : raw[tt + j].w)); acc += cw[j][e] * ((e & 1) ? bf_hi(wq) : bf_lo(wq)); }
                o[e] = silu_f(acc); }
            u32x4 w; w.x = pk2(o[0], o[1]); w.y = pk2(o[2], o[3]); w.z = pk2(o[4], o[5]); w.w = pk2(o[6], o[7]);
            *(u32x4*)(XC + (tok0 + tt) * 1536 + ch) = w; }
    }
}

constexpr int SI_B = 0, SI_C = 34816, SI_XT = 69632, SI_PREV = 87040, SI_ARR = 121856, SI_STR = 272;
__device__ __forceinline__ void ssd_item_mfma(const Params& P, LAS unsigned char* lds, int b, int h) {
    int tid_ = threadIdx.x; asm volatile("" : "+v"(tid_));
    const int tid = tid_, lane = tid & 63, w = __builtin_amdgcn_readfirstlane(tid >> 6), i = lane & 15, g = lane >> 4;
    unsigned char* ws = P.ws;
    const bf16_t* XBC = (const bf16_t*)(ws + WS_XBC); bf16_t* Y0 = (bf16_t*)(ws + WS_Y0); const float* dtg = (const float*)(ws + WS_DT); float* ssq = (float*)(ws + WS_SSQ);
    LAS unsigned char* Bi = lds + SI_B; LAS unsigned char* Ci = lds + SI_C; LAS unsigned char* XT = lds + SI_XT;
    LAS float* A2 = (LAS float*)(lds + SI_ARR); LAS float* A3 = A2 + 128; LAS float* WL = A2 + 256; LAS float* EL = A2 + 384; LAS float* CD = A2 + 512;
    const int grp = h >> 3;
    const float a2 = -expf(P.a_log[h]) * 1.4426950408889634f, Dh = P.d_skip[h];
    const bf16_t* XC = (const bf16_t*)P.out;
    f32x4 carry[4];
#pragma unroll
    for (int pt = 0; pt < 4; ++pt) carry[pt] = (f32x4){0.f, 0.f, 0.f, 0.f};
    __syncthreads();
#pragma unroll 1
    for (int c = 0; c < 16; ++c) {
        const size_t tok0 = (size_t)b * SEQ + c * 128;
        {
            const int r0 = tid >> 4, c16 = tid & 15;
            u32x4 bq[4], cq[4], xq[2];
#pragma unroll
            for (int j = 0; j < 4; ++j) { const bf16_t* rp = XC + (tok0 + r0 + 32 * j) * 1536 + 1024 + grp * 128 + 8 * c16; bq[j] = *(const u32x4*)rp; cq[j] = *(const u32x4*)(rp + 256); }
            const int xr0 = tid >> 3, xc = tid & 7;
#pragma unroll
            for (int j = 0; j < 2; ++j) xq[j] = *(const u32x4*)(XC + (tok0 + xr0 + 64 * j) * 1536 + h * 64 + 8 * xc);
#pragma unroll
            for (int j = 0; j < 4; ++j) { *(LAS u32x4*)(Bi + (r0 + 32 * j) * SI_STR + c16 * 16) = bq[j]; *(LAS u32x4*)(Ci + (r0 + 32 * j) * SI_STR + c16 * 16) = cq[j]; }
#pragma unroll
            for (int j = 0; j < 2; ++j) { const int l = xr0 + 64 * j; LAS unsigned char* xp = XT + (8 * xc) * SI_STR + l * 2; const u32x4 v = xq[j];
                *(LAS bf16_t*)(xp) = (bf16_t)(v.x & 0xffffu); *(LAS bf16_t*)(xp + SI_STR) = (bf16_t)(v.x >> 16); *(LAS bf16_t*)(xp + 2 * SI_STR) = (bf16_t)(v.y & 0xffffu); *(LAS bf16_t*)(xp + 3 * SI_STR) = (bf16_t)(v.y >> 16);
                *(LAS bf16_t*)(xp + 4 * SI_STR) = (bf16_t)(v.z & 0xffffu); *(LAS bf16_t*)(xp + 5 * SI_STR) = (bf16_t)(v.z >> 16); *(LAS bf16_t*)(xp + 6 * SI_STR) = (bf16_t)(v.w & 0xffffu); *(LAS bf16_t*)(xp + 7 * SI_STR) = (bf16_t)(v.w >> 16); }
        }
        if (w == 7) {
            const float d0 = dtg[(tok0 + lane) * 16 + h], d1 = dtg[(tok0 + 64 + lane) * 16 + h];
            float v0 = d0 * a2, v1 = d1 * a2;
#pragma unroll
            for (int o = 1; o < 64; o <<= 1) { const float t0 = __shfl_up(v0, o), t1 = __shfl_up(v1, o); if (lane >= o) { v0 += t0; v1 += t1; } }
            v1 += __shfl(v0, 63);
            const float aend = __shfl(v1, 63);
            A2[lane] = v0; A2[64 + lane] = v1; A3[lane] = v0 - __log2f(d0); A3[64 + lane] = v1 - __log2f(d1);
            WL[lane] = d0 * __builtin_amdgcn_exp2f(aend - v0); WL[64 + lane] = d1 * __builtin_amdgcn_exp2f(aend - v1);
            EL[lane] = __builtin_amdgcn_exp2f(v0); EL[64 + lane] = __builtin_amdgcn_exp2f(v1);
            if (lane == 0) CD[0] = __builtin_amdgcn_exp2f(aend);
        }
        __syncthreads();
        const LAS unsigned char* PV = lds + SI_PREV + (c & 1) * 17408; LAS unsigned char* PN = lds + SI_PREV + ((c & 1) ^ 1) * 17408;
        const int lidx = 16 * w + i;
        bf16x8 cf[4];
#pragma unroll
        for (int ks = 0; ks < 4; ++ks) cf[ks] = *(const LAS bf16x8*)(Ci + lidx * SI_STR + (32 * ks + 8 * g) * 2);
        f32x4 yd[4], yo[4];
#pragma unroll
        for (int pt = 0; pt < 4; ++pt) { yd[pt] = (f32x4){0.f, 0.f, 0.f, 0.f}; yo[pt] = yd[pt]; }
        const float A2l = A2[lidx];
#pragma unroll
        for (int sp = 0; sp < 4; ++sp) {
            if (2 * sp <= w) {
                f32x4 g0 = (f32x4){0.f, 0.f, 0.f, 0.f}, g1 = g0;
#pragma unroll
                for (int ks = 0; ks < 4; ++ks) { const bf16x8 b0 = *(const LAS bf16x8*)(Bi + (32 * sp + i) * SI_STR + (32 * ks + 8 * g) * 2), b1 = *(const LAS bf16x8*)(Bi + (32 * sp + 16 + i) * SI_STR + (32 * ks + 8 * g) * 2);
                    g0 = MFMA16(b0, cf[ks], g0); g1 = MFMA16(b1, cf[ks], g1); }
                const f32x4 a30 = *(const LAS f32x4*)(A3 + 32 * sp + 4 * g), a31 = *(const LAS f32x4*)(A3 + 32 * sp + 16 + 4 * g);
                float m[8];
#pragma unroll
                for (int r = 0; r < 4; ++r) { const int s0i = 32 * sp + 4 * g + r, s1i = s0i + 16;
                    m[r] = (s0i <= lidx) ? g0[r] * __builtin_amdgcn_exp2f(A2l - a30[r]) : 0.f; m[4 + r] = (s1i <= lidx) ? g1[r] * __builtin_amdgcn_exp2f(A2l - a31[r]) : 0.f; }
                u32x4 mw; mw.x = pk2(m[0], m[1]); mw.y = pk2(m[2], m[3]); mw.z = pk2(m[4], m[5]); mw.w = pk2(m[6], m[7]);
                const bf16x8 mf = __builtin_bit_cast(bf16x8, mw);
#pragma unroll
                for (int pt = 0; pt < 4; ++pt) { const u32x2 lo = *(const LAS u32x2*)(XT + (16 * pt + i) * SI_STR + (32 * sp + 4 * g) * 2), hi = *(const LAS u32x2*)(XT + (16 * pt + i) * SI_STR + (32 * sp + 16 + 4 * g) * 2);
                    const u32x4 xw = (u32x4){lo.x, lo.y, hi.x, hi.y}; yd[pt] = MFMA16(__builtin_bit_cast(bf16x8, xw), mf, yd[pt]); }
            }
        }
        if (c > 0) {
#pragma unroll
            for (int ks = 0; ks < 4; ++ks)
#pragma unroll
                for (int pt = 0; pt < 4; ++pt) { const bf16x8 pf = *(const LAS bf16x8*)(PV + (16 * pt + i) * SI_STR + (32 * ks + 8 * g) * 2); yo[pt] = MFMA16(pf, cf[ks], yo[pt]); }
        }
        {
            const float el = EL[lidx]; float ss = 0.f; bf16_t* yrow = Y0 + (tok0 + lidx) * 2048 + h * 64 + 4 * g;
#pragma unroll
            for (int pt = 0; pt < 4; ++pt) {
                const s16x4 xs = __builtin_amdgcn_ds_read_tr16_b64_v4i16((LAS s16x4*)(XT + (16 * pt + 4 * g + (i >> 2)) * SI_STR + (16 * w + 4 * (i & 3)) * 2));
                const u32x2 zw = *(const u32x2*)(yrow + 16 * pt); const float zf[4] = {bf_lo(zw.x), bf_hi(zw.x), bf_lo(zw.y), bf_hi(zw.y)}; float u[4];
#pragma unroll
                for (int r = 0; r < 4; ++r) { u[r] = (yd[pt][r] + el * yo[pt][r] + Dh * bf2f((bf16_t)xs[r])) * zf[r]; ss += u[r] * u[r]; }
                u32x2 uw; uw.x = pk2(u[0], u[1]); uw.y = pk2(u[2], u[3]); *(u32x2*)(yrow + 16 * pt) = uw;
            }
            ss += __shfl_xor(ss, 16); ss += __shfl_xor(ss, 32);
            if (g == 0) ssq[(tok0 + lidx) * 16 + h] = ss;
        }
        {
            f32x4 st[4];
#pragma unroll
            for (int pt = 0; pt < 4; ++pt) st[pt] = (f32x4){0.f, 0.f, 0.f, 0.f};
#pragma unroll
            for (int ks = 0; ks < 4; ++ks) {
                const s16x4 lo = __builtin_amdgcn_ds_read_tr16_b64_v4i16((LAS s16x4*)(Bi + (32 * ks + 8 * g + (i >> 2)) * SI_STR + (16 * w + 4 * (i & 3)) * 2));
                const s16x4 hi = __builtin_amdgcn_ds_read_tr16_b64_v4i16((LAS s16x4*)(Bi + (32 * ks + 8 * g + 4 + (i >> 2)) * SI_STR + (16 * w + 4 * (i & 3)) * 2));
                const f32x4 w0 = *(const LAS f32x4*)(WL + 32 * ks + 8 * g), w1 = *(const LAS f32x4*)(WL + 32 * ks + 8 * g + 4);
                u32x4 bw; bw.x = pk2(bf2f((bf16_t)lo[0]) * w0[0], bf2f((bf16_t)lo[1]) * w0[1]); bw.y = pk2(bf2f((bf16_t)lo[2]) * w0[2], bf2f((bf16_t)lo[3]) * w0[3]);
                bw.z = pk2(bf2f((bf16_t)hi[0]) * w1[0], bf2f((bf16_t)hi[1]) * w1[1]); bw.w = pk2(bf2f((bf16_t)hi[2]) * w1[2], bf2f((bf16_t)hi[3]) * w1[3]);
                const bf16x8 btf = __builtin_bit_cast(bf16x8, bw);
#pragma unroll
                for (int pt = 0; pt < 4; ++pt) { const bf16x8 xb = *(const LAS bf16x8*)(XT + (16 * pt + i) * SI_STR + (32 * ks + 8 * g) * 2); st[pt] = MFMA16(btf, xb, st[pt]); }
            }
            const float cd = CD[0];
#pragma unroll
            for (int pt = 0; pt < 4; ++pt) { carry[pt] = carry[pt] * cd + st[pt];
                u32x2 cwv; cwv.x = pk2(carry[pt][0], carry[pt][1]); cwv.y = pk2(carry[pt][2], carry[pt][3]); *(LAS u32x2*)(PN + (16 * pt + i) * SI_STR + (16 * w + 4 * g) * 2) = cwv; }
        }
        __syncthreads();
    }
}

__device__ __forceinline__ void wt_qk_lds64(const WTile& w, const LAS unsigned char* Kb, int lane, f32x4 (&s)[4]) {
    const LAS unsigned char* p = Kb + (lane & 15) * KSTR + (lane >> 4) * 16;
#pragma unroll
    for (int t = 0; t < 4; ++t) s[t] = (f32x4){0.f, 0.f, 0.f, 0.f};
#pragma unroll
    for (int ks = 0; ks < 4; ++ks)
#pragma unroll
        for (int t = 0; t < 4; ++t) { const bf16x8 a = *(const LAS bf16x8*)(p + t * 16 * KSTR + ks * 64); s[t] = MFMA16(a, w.qf[ks], s[t]); }
}
__device__ __forceinline__ void wt_softmax_pv64(WTile& w, const f32x4 (&s)[4], const LAS unsigned char* Vb, int lane) {
    float mx = fmaxf(fmaxf(s[0][0], s[0][1]), fmaxf(s[0][2], s[0][3]));
#pragma unroll
    for (int t = 1; t < 4; ++t) mx = fmaxf(mx, fmaxf(fmaxf(s[t][0], s[t][1]), fmaxf(s[t][2], s[t][3])));
    mx = fmaxf(mx, __shfl_xor(mx, 16)); mx = fmaxf(mx, __shfl_xor(mx, 32));
    const float mn = fmaxf(w.m, mx), alpha = __builtin_amdgcn_exp2f(w.m - mn);
    w.m = mn;
    float p[16]; float ps = 0.f;
#pragma unroll
    for (int t = 0; t < 4; ++t)
#pragma unroll
        for (int r = 0; r < 4; ++r) { p[4 * t + r] = __builtin_amdgcn_exp2f(s[t][r] - mn); ps += p[4 * t + r]; }
    w.l = w.l * alpha + ps;
    u32x4 pw0, pw1; pw0.x = pk2(p[0], p[1]); pw0.y = pk2(p[2], p[3]); pw0.z = pk2(p[4], p[5]); pw0.w = pk2(p[6], p[7]);
    pw1.x = pk2(p[8], p[9]); pw1.y = pk2(p[10], p[11]); pw1.z = pk2(p[12], p[13]); pw1.w = pk2(p[14], p[15]);
    const bf16x8 pf0 = __builtin_bit_cast(bf16x8, pw0), pf1 = __builtin_bit_cast(bf16x8, pw1);
    const int i = lane & 15, g = lane >> 4;
    const LAS unsigned char* vp = Vb + (4 * g + (i >> 2)) * VSTR + (i & 3) * 8;
#pragma unroll
    for (int dt = 0; dt < 8; ++dt) {
        const s16x4 l0 = __builtin_amdgcn_ds_read_tr16_b64_v4i16((LAS s16x4*)(vp + dt * 32));
        const s16x4 h0 = __builtin_amdgcn_ds_read_tr16_b64_v4i16((LAS s16x4*)(vp + 16 * VSTR + dt * 32));
        const s16x4 l1 = __builtin_amdgcn_ds_read_tr16_b64_v4i16((LAS s16x4*)(vp + 32 * VSTR + dt * 32));
        const s16x4 h1 = __builtin_amdgcn_ds_read_tr16_b64_v4i16((LAS s16x4*)(vp + 48 * VSTR + dt * 32));
        f32x4 acc = MFMA16(__builtin_shufflevector(l0, h0, 0, 1, 2, 3, 4, 5, 6, 7), pf0, w.o[dt] * alpha);
        w.o[dt] = MFMA16(__builtin_shufflevector(l1, h1, 0, 1, 2, 3, 4, 5, 6, 7), pf1, acc);
    }
}
constexpr int MB_TILE = 64 * KSTR + 64 * VSTR;
constexpr int MB_MISC = 3 * MB_TILE;
__device__ __forceinline__ void moba_item_mfma(const Params& P, LAS unsigned char* lds, int b, int h, int qt) {
    unsigned char* ws = P.ws; int tid_ = threadIdx.x; asm volatile("" : "+v"(tid_)); const int tid = tid_, lane = tid & 63, wave = __builtin_amdgcn_readfirstlane(tid >> 6);
    const bf16_t* Q0 = (const bf16_t*)(ws + WS_Q0) + (size_t)b * SEQ * 1024 + h * 128; const bf16_t* K0 = (const bf16_t*)(ws + WS_K0) + (size_t)b * SEQ * 1024 + h * 128;
    const bf16_t* V0 = (const bf16_t*)(ws + WS_V0) + (size_t)b * SEQ * 1024 + h * 128; bf16_t* Y0 = (bf16_t*)(ws + WS_Y0) + (size_t)b * SEQ * 2048 + 1024 + h * 128;
    const float* kpart = (const float*)(ws + WS_KPART);
    LAS float* ksum = (LAS float*)(lds + MB_MISC);
    LAS float* gts = ksum + 8 * 128;
    LAS int* selm = (LAS int*)(gts + 128 * 8);
    LAS int* tiles = selm + 128;
    LAS int* bmask = tiles + 48;
    const int q0 = qt * 128, qb = q0 >> 8;
    __syncthreads();
    for (int i = tid; i < qb * 128; i += NTHREADS) { const int n = i >> 7, d = i & 127; const float* kp = kpart + ((size_t)(b * 8 + n) * 2) * 1024 + h * 128 + d; ksum[i] = kp[0] + kp[1024]; }
    if (tid == 0) bmask[0] = 0;
    __syncthreads();
    { const int q = tid >> 2, nn = tid & 3; const u32x4* qr = (const u32x4*)(Q0 + (size_t)(q0 + q) * 1024);
        float a0 = 0.f, a1 = 0.f; const LAS float* k0p = ksum + nn * 128; const LAS float* k1p = ksum + (nn + 4) * 128;
        const bool d0 = nn < qb, d1 = nn + 4 < qb;
        if (d0) {
#pragma unroll 4
            for (int c = 0; c < 16; ++c) { const u32x4 w = qr[c]; const float qv[8] = {bf_lo(w.x), bf_hi(w.x), bf_lo(w.y), bf_hi(w.y), bf_lo(w.z), bf_hi(w.z), bf_lo(w.w), bf_hi(w.w)};
#pragma unroll
                for (int e = 0; e < 8; ++e) { a0 += qv[e] * k0p[8 * c + e]; if (d1) a1 += qv[e] * k1p[8 * c + e]; } }
            gts[q * 8 + nn] = a0; if (d1) gts[q * 8 + nn + 4] = a1; }
    }
    __syncthreads();
    if (tid < 128) { int s0 = -1, s1 = -1, s2 = -1; float g0 = -__builtin_inff(), g1 = g0, g2 = g0;
        for (int n = 0; n < qb; ++n) { const float gv = gts[tid * 8 + n];
            if (gv > g0) { g2 = g1; s2 = s1; g1 = g0; s1 = s0; g0 = gv; s0 = n; } else if (gv > g1) { g2 = g1; s2 = s1; g1 = gv; s1 = n; } else if (gv > g2) { g2 = gv; s2 = n; } }
        int mk = 0; if (s0 >= 0) mk |= 1 << s0; if (s1 >= 0) mk |= 1 << s1; if (s2 >= 0) mk |= 1 << s2;
        selm[tid] = mk; atomicOr((int*)bmask, mk); }
    __syncthreads();
    if (tid == 0) { const int bm = bmask[0]; int c = 0;
        for (int n = 0; n < qb; ++n) if ((bm >> n) & 1) for (int j = 0; j < 4; ++j) tiles[c++] = n * 256 + 64 * j;
        for (int kb = qb * 256; kb < q0 + 128; kb += 64) tiles[c++] = kb;
        tiles[40] = c; }
    __syncthreads();
    const int ntiles = tiles[40];
    const int qi = lane & 15, g = lane >> 4, myq = q0 + wave * 16 + qi, mymask = selm[wave * 16 + qi];
    WTile w; wt_reset(w); wt_load_q(w, Q0 + (size_t)myq * 1024, lane);
    const int srow = tid >> 4, sch = tid & 15;
    u32x4 kA0, kA1, vA0, vA1, kB0, kB1, vB0, vB1;
#define MB_LOAD(S, kb_) do { const bf16_t* kp_ = K0 + (size_t)((kb_) + srow) * 1024 + 8 * sch; const bf16_t* vp_ = V0 + (size_t)((kb_) + srow) * 1024 + 8 * sch; \
        k##S##0 = *(const u32x4*)kp_; k##S##1 = *(const u32x4*)(kp_ + 32 * 1024); v##S##0 = *(const u32x4*)vp_; v##S##1 = *(const u32x4*)(vp_ + 32 * 1024); } while (0)
#define MB_WRITE(S, buf_) do { LAS unsigned char* kb_ = lds + (buf_) * MB_TILE; LAS unsigned char* vb_ = kb_ + 64 * KSTR; \
        *(LAS u32x4*)(kb_ + srow * KSTR + sch * 16) = k##S##0; *(LAS u32x4*)(kb_ + (srow + 32) * KSTR + sch * 16) = k##S##1; \
        *(LAS u32x4*)(vb_ + srow * VSTR + sch * 16) = v##S##0; *(LAS u32x4*)(vb_ + (srow + 32) * VSTR + sch * 16) = v##S##1; } while (0)
#define MB_COMPUTE(t_) do { const int kb = tiles[t_]; const int n = kb >> 8; const LAS unsigned char* kbuf = lds + ((t_) % 3) * MB_TILE; bool active; \
        if (n < qb) active = __ballot((mymask >> n) & 1) != 0ull; else active = kb <= q0 + wave * 16 + 15; \
        if (active) { f32x4 sc[4]; wt_qk_lds64(w, kbuf, lane, sc); const float NEG = -__builtin_inff(); \
            if (n < qb) { if (!((mymask >> n) & 1)) { _Pragma("unroll") for (int t2 = 0; t2 < 4; ++t2) sc[t2] = (f32x4){NEG, NEG, NEG, NEG}; } } \
            else { _Pragma("unroll") for (int t2 = 0; t2 < 4; ++t2) _Pragma("unroll") for (int r = 0; r < 4; ++r) if (kb + 16 * t2 + 4 * g + r > myq) sc[t2][r] = NEG; } \
            wt_softmax_pv64(w, sc, kbuf + 64 * KSTR, lane); } } while (0)
    MB_LOAD(A, tiles[0]);
    if (ntiles > 1) MB_LOAD(B, tiles[1]);
    MB_WRITE(A, 0);
    __syncthreads();
    for (int t = 0; t < ntiles; t += 2) {
        if (t + 2 < ntiles) MB_LOAD(A, tiles[t + 2]);
        MB_COMPUTE(t);
        if (t + 1 < ntiles) MB_WRITE(B, (t + 1) % 3);
        __syncthreads();
        if (t + 1 >= ntiles) break;
        if (t + 3 < ntiles) MB_LOAD(B, tiles[t + 3]);
        MB_COMPUTE(t + 1);
        if (t + 2 < ntiles) MB_WRITE(A, (t + 2) % 3);
        __syncthreads();
    }
#undef MB_LOAD
#undef MB_WRITE
#undef MB_COMPUTE
    float l = w.l; l += __shfl_xor(l, 16); l += __shfl_xor(l, 32); const float inv = 1.0f / l;
    bf16_t* yp = Y0 + (size_t)myq * 2048 + 4 * g;
#pragma unroll
    for (int dt = 0; dt < 8; ++dt) { const u32x2 gw = *(const u32x2*)(yp + 16 * dt);
        u32x2 o; o.x = pk2(w.o[dt][0] * inv * bf_lo(gw.x), w.o[dt][1] * inv * bf_hi(gw.x)); o.y = pk2(w.o[dt][2] * inv * bf_lo(gw.y), w.o[dt][3] * inv * bf_hi(gw.y));
        *(u32x2*)(yp + 16 * dt) = o; }
}

typedef float f32x16 __attribute__((ext_vector_type(16)));
constexpr int VSTR2 = 320;
#define MFMA32(a, b, c) __builtin_amdgcn_mfma_f32_32x32x16_bf16((a), (b), (c), 0, 0, 0)
struct WT32 { bf16x8 qf[8]; f32x16 o[4]; float m, l; };
__device__ __forceinline__ void wt32_reset(WT32& w) {
#pragma unroll
    for (int d = 0; d < 4; ++d)
#pragma unroll
        for (int r = 0; r < 16; ++r) w.o[d][r] = 0.f;
    w.m = -1.0e30f; w.l = 0.f;
}
__device__ __forceinline__ void wt32_load_q(WT32& w, const bf16_t* qrow, int lane) {
    const int hi = lane >> 5;
#pragma unroll
    for (int d0 = 0; d0 < 8; ++d0) w.qf[d0] = *(const bf16x8*)(qrow + 16 * d0 + 8 * hi);
}
__device__ __forceinline__ f32x16 wt32_qk(const WT32& w, const LAS unsigned char* Kb, int lane) {
    const LAS unsigned char* p = Kb + (lane & 31) * KSTR + (lane >> 5) * 16;
    f32x16 s;
#pragma unroll
    for (int r = 0; r < 16; ++r) s[r] = 0.f;
#pragma unroll
    for (int d0 = 0; d0 < 8; ++d0) { const bf16x8 a = *(const LAS bf16x8*)(p + d0 * 32); s = MFMA32(a, w.qf[d0], s); }
    return s;
}
__device__ __forceinline__ void wt32_softmax_pv(WT32& w, const f32x16& s, const LAS unsigned char* Vb, int lane) {
    float mx = s[0];
#pragma unroll
    for (int r = 1; r < 16; ++r) mx = fmaxf(mx, s[r]);
    mx = fmaxf(mx, __shfl_xor(mx, 32));
    const float mn = fmaxf(w.m, mx);
    if (__any(mn > w.m)) { const float alpha = __builtin_amdgcn_exp2f(w.m - mn); w.m = mn; w.l *= alpha;
#pragma unroll
        for (int d = 0; d < 4; ++d) w.o[d] = w.o[d] * alpha; }
    float e[16]; float ps = 0.f;
#pragma unroll
    for (int r = 0; r < 16; ++r) { e[r] = __builtin_amdgcn_exp2f(s[r] - w.m); ps += e[r]; }
    w.l += ps;
    u32x4 pw0, pw1; pw0.x = pk2(e[0], e[1]); pw0.y = pk2(e[2], e[3]); pw0.z = pk2(e[4], e[5]); pw0.w = pk2(e[6], e[7]);
    pw1.x = pk2(e[8], e[9]); pw1.y = pk2(e[10], e[11]); pw1.z = pk2(e[12], e[13]); pw1.w = pk2(e[14], e[15]);
    const bf16x8 pf0 = __builtin_bit_cast(bf16x8, pw0), pf1 = __builtin_bit_cast(bf16x8, pw1);
    const int i = lane & 15, gg = (lane >> 4) & 1, hi = lane >> 5;
    const LAS unsigned char* vp = Vb + (4 * hi + (i >> 2)) * VSTR2 + 32 * gg + 8 * (i & 3);
#pragma unroll
    for (int db = 0; db < 4; ++db) {
        const s16x4 l0 = __builtin_amdgcn_ds_read_tr16_b64_v4i16((LAS s16x4*)(vp + db * 64));
        const s16x4 h0 = __builtin_amdgcn_ds_read_tr16_b64_v4i16((LAS s16x4*)(vp + 8 * VSTR2 + db * 64));
        const s16x4 l1 = __builtin_amdgcn_ds_read_tr16_b64_v4i16((LAS s16x4*)(vp + 16 * VSTR2 + db * 64));
        const s16x4 h1 = __builtin_amdgcn_ds_read_tr16_b64_v4i16((LAS s16x4*)(vp + 24 * VSTR2 + db * 64));
        w.o[db] = MFMA32(__builtin_shufflevector(l0, h0, 0, 1, 2, 3, 4, 5, 6, 7), pf0, w.o[db]);
        w.o[db] = MFMA32(__builtin_shufflevector(l1, h1, 0, 1, 2, 3, 4, 5, 6, 7), pf1, w.o[db]);
    }
}
__device__ __forceinline__ int crow32(int r, int hi) { return (r & 3) + 8 * (r >> 2) + 4 * hi; }

constexpr int M3_TILE = 64 * KSTR + 64 * VSTR2;
constexpr int M3_MISC = 3 * M3_TILE;
__device__ __forceinline__ void moba_item_m32(const Params& P, LAS unsigned char* lds, int b, int h, int qb, bool dry = false) {
    unsigned char* ws = P.ws; int tid_ = threadIdx.x; asm volatile("" : "+v"(tid_)); const int tid = tid_, lane = tid & 63, wave = __builtin_amdgcn_readfirstlane(tid >> 6);
    const bf16_t* Q0 = (const bf16_t*)(ws + WS_Q0) + (size_t)b * SEQ * 1024 + h * 128; const bf16_t* K0 = (const bf16_t*)(ws + WS_K0) + (size_t)b * SEQ * 1024 + h * 128;
    const bf16_t* V0 = (const bf16_t*)(ws + WS_V0) + (size_t)b * SEQ * 1024 + h * 128; bf16_t* Y0 = (bf16_t*)(ws + WS_Y0) + (size_t)b * SEQ * 2048 + 1024 + h * 128;
    const float* kpart = (const float*)(ws + WS_KPART);
    LAS float* ksum = (LAS float*)(lds + M3_MISC);
    LAS int* selm = (LAS int*)(ksum + 8 * 128);
    LAS int* tiles = selm + 256;
    LAS int* bmask = tiles + 48;
    const int q0 = qb * 256;
    __syncthreads();
    for (int i = tid; i < qb * 128; i += NTHREADS) { const int n = i >> 7, d = i & 127; const float* kp = kpart + ((size_t)(b * 8 + n) * 2) * 1024 + h * 128 + d; ksum[i] = kp[0] + kp[1024]; }
    if (tid == 0) bmask[0] = 0;
    __syncthreads();
    {
        const int q = tid >> 1, hf = tid & 1; const u32x4* qr = (const u32x4*)(Q0 + (size_t)(q0 + q) * 1024 + 64 * hf);
        float gsum[8];
#pragma unroll
        for (int n = 0; n < 8; ++n) gsum[n] = 0.f;
#pragma unroll 2
        for (int c = 0; c < 8; ++c) { const u32x4 wq = qr[c]; const float qv[8] = {bf_lo(wq.x), bf_hi(wq.x), bf_lo(wq.y), bf_hi(wq.y), bf_lo(wq.z), bf_hi(wq.z), bf_lo(wq.w), bf_hi(wq.w)};
#pragma unroll
            for (int n = 0; n < 8; ++n) if (n < qb) { const LAS float* kp = ksum + n * 128 + 64 * hf + 8 * c;
#pragma unroll
                for (int e = 0; e < 8; ++e) gsum[n] += qv[e] * kp[e]; } }
        int s0 = -1, s1 = -1, s2 = -1; float g0 = -__builtin_inff(), g1 = g0, g2 = g0;
#pragma unroll
        for (int n = 0; n < 8; ++n) { float gv = gsum[n] + __shfl_xor(gsum[n], 1);
            if (n < qb) { if (gv > g0) { g2 = g1; s2 = s1; g1 = g0; s1 = s0; g0 = gv; s0 = n; } else if (gv > g1) { g2 = g1; s2 = s1; g1 = gv; s1 = n; } else if (gv > g2) { g2 = gv; s2 = n; } } }
        int mk = 0; if (s0 >= 0) mk |= 1 << s0; if (s1 >= 0) mk |= 1 << s1; if (s2 >= 0) mk |= 1 << s2;
        if (hf == 0) { selm[q] = mk; atomicOr((int*)bmask, mk); }
    }
    __syncthreads();
    if (tid == 0) { const int bm = bmask[0]; int c = 0;
        for (int n = 0; n < qb; ++n) if ((bm >> n) & 1) for (int j = 0; j < 4; ++j) tiles[c++] = n * 256 + 64 * j;
        for (int j = 0; j < 4; ++j) tiles[c++] = q0 + 64 * j;
        tiles[40] = c; }
    __syncthreads();
    const int ntiles = tiles[40];
    const int r32 = lane & 31, hi = lane >> 5, myq = q0 + wave * 32 + r32, mymask = selm[wave * 32 + r32];
    WT32 w; wt32_reset(w); wt32_load_q(w, Q0 + (size_t)myq * 1024, lane);
    const int srow = tid >> 4, sch = tid & 15;
    u32x4 kA0, kA1, vA0, vA1, kB0, kB1, vB0, vB1;
#define M3_LOAD(S, kb_) do { const bf16_t* kp_ = K0 + (size_t)((kb_) + srow) * 1024 + 8 * sch; const bf16_t* vp_ = V0 + (size_t)((kb_) + srow) * 1024 + 8 * sch; \
        k##S##0 = *(const u32x4*)kp_; k##S##1 = *(const u32x4*)(kp_ + 32 * 1024); v##S##0 = *(const u32x4*)vp_; v##S##1 = *(const u32x4*)(vp_ + 32 * 1024); } while (0)
#define M3_WRITE(S, buf_) do { LAS unsigned char* kb_ = lds + (buf_) * M3_TILE; LAS unsigned char* vb_ = kb_ + 64 * KSTR; \
        *(LAS u32x4*)(kb_ + srow * KSTR + sch * 16) = k##S##0; *(LAS u32x4*)(kb_ + (srow + 32) * KSTR + sch * 16) = k##S##1; \
        *(LAS u32x4*)(vb_ + srow * VSTR2 + sch * 16) = v##S##0; *(LAS u32x4*)(vb_ + (srow + 32) * VSTR2 + sch * 16) = v##S##1; } while (0)
#define M3_COMPUTE(t_) do { const int kb = tiles[t_]; const int n = kb >> 8; const LAS unsigned char* kbuf = lds + ((t_) % 3) * M3_TILE; const float NEG = -__builtin_inff(); \
        const bool past = n < qb; const bool mine = (mymask >> n) & 1; const bool anyw = past ? (__ballot(mine) != 0ull) : true; \
        _Pragma("unroll 1") for (int sub = 0; sub < 2; ++sub) { const int kb2 = kb + 32 * sub; \
            if (past ? anyw : (kb2 <= q0 + wave * 32 + 31)) { f32x16 sc = wt32_qk(w, kbuf + sub * 32 * KSTR, lane); \
                _Pragma("unroll") for (int r = 0; r < 16; ++r) { const bool ok = past ? mine : (kb2 + crow32(r, hi) <= myq); if (!ok) sc[r] = NEG; } \
                wt32_softmax_pv(w, sc, kbuf + 64 * KSTR + sub * 32 * VSTR2, lane); } } } while (0)
    M3_LOAD(A, tiles[0]);
    if (ntiles > 1) M3_LOAD(B, tiles[1]);
    M3_WRITE(A, 0);
    __syncthreads();
    for (int t = 0; t < ntiles; t += 2) {
        if (t + 2 < ntiles) M3_LOAD(A, tiles[t + 2]);
        M3_COMPUTE(t);
        if (t + 1 < ntiles) M3_WRITE(B, (t + 1) % 3);
        __syncthreads();
        if (t + 1 >= ntiles) break;
        if (t + 3 < ntiles) M3_LOAD(B, tiles[t + 3]);
        M3_COMPUTE(t + 1);
        if (t + 2 < ntiles) M3_WRITE(A, (t + 2) % 3);
        __syncthreads();
    }
#undef M3_LOAD
#undef M3_WRITE
#undef M3_COMPUTE
    float l = w.l; l += __shfl_xor(l, 32); const float inv = 1.0f / l;
    bf16_t* yp = Y0 + (size_t)myq * 2048 + 4 * hi;
#pragma unroll
    for (int db = 0; db < 4; ++db)
#pragma unroll
        for (int rq = 0; rq < 4; ++rq) { bf16_t* pp = yp + 32 * db + 8 * rq; const u32x2 gw = *(const u32x2*)pp;
            u32x2 o; o.x = pk2(w.o[db][4 * rq] * inv * bf_lo(gw.x), w.o[db][4 * rq + 1] * inv * bf_hi(gw.x)); o.y = pk2(w.o[db][4 * rq + 2] * inv * bf_lo(gw.y), w.o[db][4 * rq + 3] * inv * bf_hi(gw.y));
            if (!dry) *(u32x2*)pp = o; }
}

constexpr int DL_OACC = 0, DL_LSE = 65536, DL_V = 66560;
__device__ __forceinline__ void dilated_item_mfma(const Params& P, LAS unsigned char* lds, int b, int h, int blk) {
    unsigned char* ws = P.ws; int tid_ = threadIdx.x; asm volatile("" : "+v"(tid_)); const int tid = tid_, lane = tid & 63, wave = __builtin_amdgcn_readfirstlane(tid >> 6);
    bf16_t* Q1 = (bf16_t*)(ws + WS_QO1) + (size_t)b * SEQ * 2048 + h * 128; const bf16_t* K1 = (const bf16_t*)(ws + WS_K1) + (size_t)b * SEQ * 2048 + h * 128;
    const bf16_t* V1 = (const bf16_t*)(ws + WS_V1) + (size_t)b * SEQ * 2048 + h * 128;
    LAS unsigned char* Vw = lds + DL_V + wave * (32 * VSTR); LAS float* lse = (LAS float*)(lds + DL_LSE);
    const int T0 = blk * 256, qi = lane & 15, g = lane >> 4;
    __syncthreads();
#pragma unroll 1
    for (int pt = 0; pt < 3; ++pt) {
        const int r = 1 << (2 * pt);
#pragma unroll 1
        for (int half = 0; half < 2; ++half) {
            const int wt = wave + 8 * half;
            const int t0 = T0 + (pt == 0 ? 16 * wt : (pt == 1 ? (wt & 3) + 64 * (wt >> 2) : wt));
            const int myq = t0 + r * qi;
            WTile w; wt_reset(w); wt_load_q(w, Q1 + (size_t)myq * 2048, lane);
            const int kp0 = t0 - 144 * r;
            int s_lo = 0; while (kp0 + (32 * s_lo + 31) * r < 0) ++s_lo;
            bf16x8 kaA[2][4], kaB[2][4]; u32x4 vrA[8], vrB[8];
#define DL_LOAD(S, s_) do { const int kps_ = kp0 + 32 * (s_) * r; \
                _Pragma("unroll") for (int a = 0; a < 2; ++a) { int pos = kps_ + (16 * a + qi) * r; pos = pos < 0 ? 0 : pos; const bf16_t* kr = K1 + (size_t)pos * 2048 + 8 * g; \
                    _Pragma("unroll") for (int ks = 0; ks < 4; ++ks) ka##S[a][ks] = *(const bf16x8*)(kr + 32 * ks); } \
                _Pragma("unroll") for (int j = 0; j < 8; ++j) { const int c = lane + 64 * j, row = c >> 4, ch = c & 15; int pos = kps_ + row * r; pos = pos < 0 ? 0 : pos; vr##S[j] = *(const u32x4*)(V1 + (size_t)pos * 2048 + 8 * ch); } } while (0)
#define DL_STEP(S, s_) do { const int kps_ = kp0 + 32 * (s_) * r; \
                _Pragma("unroll") for (int j = 0; j < 8; ++j) { const int c = lane + 64 * j, row = c >> 4, ch = c & 15; *(LAS u32x4*)(Vw + row * VSTR + ch * 16) = vr##S[j]; } \
                f32x4 s0 = (f32x4){0.f, 0.f, 0.f, 0.f}, s1 = s0; \
                _Pragma("unroll") for (int ks = 0; ks < 4; ++ks) { s0 = MFMA16(ka##S[0][ks], w.qf[ks], s0); s1 = MFMA16(ka##S[1][ks], w.qf[ks], s1); } \
                const float NEG = -__builtin_inff(); \
                _Pragma("unroll") for (int e = 0; e < 4; ++e) { const int kk0 = 4 * g + e, kk1 = 16 + 4 * g + e; const int d0 = qi + 144 - 32 * (s_) - kk0, d1 = qi + 144 - 32 * (s_) - kk1; \
                    if (d0 < 0 || d0 > 128 || kps_ + kk0 * r < 0) s0[e] = NEG; if (d1 < 0 || d1 > 128 || kps_ + kk1 * r < 0) s1[e] = NEG; } \
                wt_softmax_pv(w, s0, s1, Vw, lane); } while (0)
            DL_LOAD(A, s_lo);
#pragma unroll 1
            for (int s = s_lo; s < 5; s += 2) {
                if (s + 1 < 5) DL_LOAD(B, s + 1);
                DL_STEP(A, s);
                if (s + 1 >= 5) break;
                if (s + 2 < 5) DL_LOAD(A, s + 2);
                DL_STEP(B, s + 1);
            }
#undef DL_LOAD
#undef DL_STEP
            float l = w.l; l += __shfl_xor(l, 16); l += __shfl_xor(l, 32); const float inv = 1.0f / l; const float ls = w.m + __log2f(l);
            const int row = myq - T0;
            LAS unsigned char* orow = lds + DL_OACC + row * 256 + 8 * g;
            if (pt == 0) {
#pragma unroll
                for (int dt = 0; dt < 8; ++dt) { u32x2 o; o.x = pk2(w.o[dt][0] * inv, w.o[dt][1] * inv); o.y = pk2(w.o[dt][2] * inv, w.o[dt][3] * inv); *(LAS u32x2*)(orow + 32 * dt) = o; }
                if (g == 0) lse[row] = ls;
            } else {
                const float lo = lse[row], mxl = fmaxf(lo, ls); const float eo = __builtin_amdgcn_exp2f(lo - mxl), en = __builtin_amdgcn_exp2f(ls - mxl), den = eo + en;
                const float wo = eo / den, wn = en / den * inv;
                bf16_t* gout = Q1 + (size_t)myq * 2048 + 4 * g;
#pragma unroll
                for (int dt = 0; dt < 8; ++dt) { const u32x2 ov = *(const LAS u32x2*)(orow + 32 * dt);
                    u32x2 o; o.x = pk2(wo * bf_lo(ov.x) + wn * w.o[dt][0], wo * bf_hi(ov.x) + wn * w.o[dt][1]); o.y = pk2(wo * bf_lo(ov.y) + wn * w.o[dt][2], wo * bf_hi(ov.y) + wn * w.o[dt][3]);
                    if (pt == 1) *(LAS u32x2*)(orow + 32 * dt) = o; else *(u32x2*)(gout + 16 * dt) = o; }
                if (pt == 1) { asm volatile("s_waitcnt lgkmcnt(0)" ::: "memory"); if (g == 0) lse[row] = mxl + __log2f(den); }
            }
        }
        __syncthreads();
    }
}

constexpr int D2_OACC = 0, D2_LSE = 65536, D2_K = 66560, D2_V = D2_K + 128 * KSTR;
__device__ __forceinline__ void dilated_item_v2(const Params& P, LAS unsigned char* lds, int b, int h, int blk, unsigned long long& pr_t0, unsigned long long& pr_acc) {
    unsigned char* ws = P.ws; int tid_ = threadIdx.x; asm volatile("" : "+v"(tid_)); const int tid = tid_, lane = tid & 63, wave = __builtin_amdgcn_readfirstlane(tid >> 6);
    bf16_t* Q1 = (bf16_t*)(ws + WS_QO1) + (size_t)b * SEQ * 2048 + h * 128; const bf16_t* K1 = (const bf16_t*)(ws + WS_K1) + (size_t)b * SEQ * 2048 + h * 128;
    const bf16_t* V1 = (const bf16_t*)(ws + WS_V1) + (size_t)b * SEQ * 2048 + h * 128;
    LAS float* lse = (LAS float*)(lds + D2_LSE);
    const int T0 = blk * 256;
    __syncthreads();
    if (PROBE_PHASE == 51) pr_t0 = __builtin_amdgcn_s_memrealtime();
#pragma unroll 1
    for (int pt = 0; pt < 2; ++pt) {
        const int r32 = lane & 31, hi = lane >> 5, rho = wave >> 1, hf = wave & 1;
        const int rowl = pt == 0 ? 32 * wave + r32 : rho + 4 * (32 * hf + r32);
        const int myq = T0 + rowl;
        WT32 w; wt32_reset(w); wt32_load_q(w, Q1 + (size_t)myq * 2048, lane);
        const int ntile = pt == 0 ? 3 : 6, base0 = pt == 0 ? T0 - 128 : T0 - 512;
        int u0 = 0; while (base0 + 128 * u0 < 0) ++u0;
        const int srow = tid >> 4, sch = tid & 15;
        u32x4 kq[4], vq[4];
#define D2_LOAD(u_) do { const size_t p0_ = (size_t)(base0 + 128 * (u_) + srow); \
            _Pragma("unroll") for (int j = 0; j < 4; ++j) { kq[j] = *(const u32x4*)(K1 + (p0_ + 32 * j) * 2048 + 8 * sch); vq[j] = *(const u32x4*)(V1 + (p0_ + 32 * j) * 2048 + 8 * sch); } } while (0)
        D2_LOAD(u0);
#pragma unroll 1
        for (int u = u0; u < ntile; ++u) {
            __syncthreads();
#pragma unroll
            for (int j = 0; j < 4; ++j) { const int po = srow + 32 * j; const int lrow = pt == 0 ? po : 32 * (po & 3) + (po >> 2);
                *(LAS u32x4*)(lds + D2_K + lrow * KSTR + sch * 16) = kq[j]; *(LAS u32x4*)(lds + D2_V + lrow * VSTR2 + sch * 16) = vq[j]; }
            __syncthreads();
            if (u + 1 < ntile) D2_LOAD(u + 1);
            const int nsub = pt == 0 ? 4 : 1;
#pragma unroll 1
            for (int sb = 0; sb < nsub; ++sb) {
                const int D0w = pt == 0 ? (T0 + 32 * wave) - (base0 + 128 * u + 32 * sb) : 32 * hf + 128 - 32 * u;
                if (D0w + 31 >= 0 && D0w <= 159) {
                    const int lsub = pt == 0 ? sb : rho;
                    f32x16 sc = wt32_qk(w, lds + D2_K + lsub * 32 * KSTR, lane);
                    const int D0 = D0w + r32; const float NEG = -__builtin_inff();
#pragma unroll
                    for (int r = 0; r < 16; ++r) { const unsigned dd = (unsigned)(D0 - crow32(r, hi)); if (dd > 128u) sc[r] = NEG; }
                    wt32_softmax_pv(w, sc, lds + D2_V + lsub * 32 * VSTR2, lane);
                }
            }
        }
#undef D2_LOAD
        float l = w.l; l += __shfl_xor(l, 32); const float inv = 1.0f / l, ls = w.m + __log2f(l);
        LAS unsigned char* orow = lds + D2_OACC + rowl * 256 + 8 * hi;
        if (pt == 0) {
#pragma unroll
            for (int db = 0; db < 4; ++db)
#pragma unroll
                for (int rq = 0; rq < 4; ++rq) { u32x2 o; o.x = pk2(w.o[db][4 * rq] * inv, w.o[db][4 * rq + 1] * inv); o.y = pk2(w.o[db][4 * rq + 2] * inv, w.o[db][4 * rq + 3] * inv); *(LAS u32x2*)(orow + 64 * db + 16 * rq) = o; }
            if (hi == 0) lse[rowl] = ls;
        } else {
            const float lo = lse[rowl], mxl = fmaxf(lo, ls); const float eo = __builtin_amdgcn_exp2f(lo - mxl), en = __builtin_amdgcn_exp2f(ls - mxl), den = eo + en;
            const float wo = eo / den, wn = en / den * inv;
#pragma unroll
            for (int db = 0; db < 4; ++db)
#pragma unroll
                for (int rq = 0; rq < 4; ++rq) { const u32x2 ov = *(const LAS u32x2*)(orow + 64 * db + 16 * rq);
                    u32x2 o; o.x = pk2(wo * bf_lo(ov.x) + wn * w.o[db][4 * rq], wo * bf_hi(ov.x) + wn * w.o[db][4 * rq + 1]); o.y = pk2(wo * bf_lo(ov.y) + wn * w.o[db][4 * rq + 2], wo * bf_hi(ov.y) + wn * w.o[db][4 * rq + 3]);
                    *(LAS u32x2*)(orow + 64 * db + 16 * rq) = o; }
            asm volatile("s_waitcnt lgkmcnt(0)" ::: "memory");
            if (hi == 0) lse[rowl] = mxl + __log2f(den);
        }
        __syncthreads();
    }
    if (PROBE_PHASE == 51) pr_acc += __builtin_amdgcn_s_memrealtime() - pr_t0;
    if (PROBE_PHASE == 52) pr_t0 = __builtin_amdgcn_s_memrealtime();
    {
        const int qi = lane & 15, g = lane >> 4; LAS unsigned char* Vw = lds + D2_K + wave * (32 * VSTR);
#pragma unroll 1
        for (int half = 0; half < 2; ++half) {
            const int wt = wave + 8 * half, t0 = T0 + wt, myq = t0 + 16 * qi;
            WTile w; wt_reset(w); wt_load_q(w, Q1 + (size_t)myq * 2048, lane);
            const int kp0 = t0 - 144 * 16;
            int s_lo = 0; while (kp0 + (32 * s_lo + 31) * 16 < 0) ++s_lo;
            bf16x8 kaA[2][4], kaB[2][4]; u32x4 vrA[8], vrB[8];
#define DL_LOAD(S, s_) do { const int kps_ = kp0 + 512 * (s_); \
                _Pragma("unroll") for (int a = 0; a < 2; ++a) { int pos = kps_ + (16 * a + qi) * 16; pos = pos < 0 ? 0 : pos; const bf16_t* kr = K1 + (size_t)pos * 2048 + 8 * g; \
                    _Pragma("unroll") for (int ks = 0; ks < 4; ++ks) ka##S[a][ks] = *(const bf16x8*)(kr + 32 * ks); } \
                _Pragma("unroll") for (int j = 0; j < 8; ++j) { const int c = lane + 64 * j, row = c >> 4, ch = c & 15; int pos = kps_ + row * 16; pos = pos < 0 ? 0 : pos; vr##S[j] = *(const u32x4*)(V1 + (size_t)pos * 2048 + 8 * ch); } } while (0)
#define DL_STEP(S, s_) do { const int kps_ = kp0 + 512 * (s_); \
                _Pragma("unroll") for (int j = 0; j < 8; ++j) { const int c = lane + 64 * j, row = c >> 4, ch = c & 15; *(LAS u32x4*)(Vw + row * VSTR + ch * 16) = vr##S[j]; } \
                f32x4 s0 = (f32x4){0.f, 0.f, 0.f, 0.f}, s1 = s0; \
                _Pragma("unroll") for (int ks = 0; ks < 4; ++ks) { s0 = MFMA16(ka##S[0][ks], w.qf[ks], s0); s1 = MFMA16(ka##S[1][ks], w.qf[ks], s1); } \
                const float NEG = -__builtin_inff(); \
                _Pragma("unroll") for (int e = 0; e < 4; ++e) { const int kk0 = 4 * g + e, kk1 = 16 + 4 * g + e; const int d0 = qi + 144 - 32 * (s_) - kk0, d1 = qi + 144 - 32 * (s_) - kk1; \
                    if (d0 < 0 || d0 > 128 || kps_ + kk0 * 16 < 0) s0[e] = NEG; if (d1 < 0 || d1 > 128 || kps_ + kk1 * 16 < 0) s1[e] = NEG; } \
                wt_softmax_pv(w, s0, s1, Vw, lane); } while (0)
            DL_LOAD(A, s_lo);
#pragma unroll 1
            for (int s = s_lo; s < 5; s += 2) {
                if (s + 1 < 5) DL_LOAD(B, s + 1);
                DL_STEP(A, s);
                if (s + 1 >= 5) break;
                if (s + 2 < 5) DL_LOAD(A, s + 2);
                DL_STEP(B, s + 1);
            }
#undef DL_LOAD
#undef DL_STEP
            float l = w.l; l += __shfl_xor(l, 16); l += __shfl_xor(l, 32); const float inv = 1.0f / l; const float ls = w.m + __log2f(l);
            const int row = myq - T0;
            const LAS unsigned char* orow = lds + D2_OACC + row * 256 + 8 * g;
            const float lo = lse[row], mxl = fmaxf(lo, ls); const float eo = __builtin_amdgcn_exp2f(lo - mxl), en = __builtin_amdgcn_exp2f(ls - mxl), den = eo + en;
            const float wo = eo / den, wn = en / den * inv;
            bf16_t* gout = Q1 + (size_t)myq * 2048 + 4 * g;
#pragma unroll
            for (int dt = 0; dt < 8; ++dt) { const u32x2 ov = *(const LAS u32x2*)(orow + 32 * dt);
                u32x2 o; o.x = pk2(wo * bf_lo(ov.x) + wn * w.o[dt][0], wo * bf_hi(ov.x) + wn * w.o[dt][1]); o.y = pk2(wo * bf_lo(ov.y) + wn * w.o[dt][2], wo * bf_hi(ov.y) + wn * w.o[dt][3]);
                *(u32x2*)(gout + 16 * dt) = o; }
        }
    }
    __syncthreads();
    if (PROBE_PHASE == 52) pr_acc += __builtin_amdgcn_s_memrealtime() - pr_t0;
}

#define XB_TMO      128
#define XB_XCNT(j)  (256  + 64 * (j))
#define XB_XSUB(j)  (1280 + 64 * (j))
#define XB_XGEN(j)  (2304 + 64 * (j))
#define XB_TOP      3328
#define XB_TOPGEN   3392
#define XCD_BAR_WORDS 3456
#define XB_SPIN_CAP (1u << 20)
__device__ __forceinline__ unsigned xb_ld(unsigned* p)              { return __hip_atomic_load(p, __ATOMIC_RELAXED, __HIP_MEMORY_SCOPE_AGENT); }
__device__ __forceinline__ unsigned xb_add(unsigned* p, unsigned v) { return __hip_atomic_fetch_add(p, v, __ATOMIC_RELAXED, __HIP_MEMORY_SCOPE_AGENT); }
__device__ __forceinline__ unsigned xb_xcc_id() { return (unsigned)__builtin_amdgcn_s_getreg((3 << 11) | 20) & 0xFu; }
#define XB_SPIN(cond, bar) do { unsigned _sp = 0; while (cond) { __builtin_amdgcn_s_sleep(1); \
    if ((++_sp & 255u) == 0u) { if (xb_ld(&(bar)[XB_TMO])) break; if (_sp > XB_SPIN_CAP) { atomicAdd(&(bar)[XB_TMO], 1u); break; } } } } while (0)
struct XcdBarrier { unsigned* bar; unsigned x; volatile LAS unsigned* st; };
__device__ __forceinline__ XcdBarrier xcd_barrier_post(unsigned* bar, volatile LAS unsigned* st) {
    XcdBarrier b; b.bar = bar; b.x = xb_xcc_id(); b.st = st;
    if (threadIdx.x == 0) (void)xb_add(&bar[XB_XCNT(b.x)], 1u);
    return b;
}
__device__ __forceinline__ void xcd_barrier_complete(unsigned* bar, unsigned x, unsigned& nloc, unsigned& nx) {
    const unsigned G = gridDim.x * gridDim.y * gridDim.z;
    unsigned sum, cnt, mine, sp = 0u;
    for (;;) {
        sum = 0u; cnt = 0u; mine = 0u;
#pragma unroll
        for (unsigned j = 0; j < 16; ++j) { const unsigned c = xb_ld(&bar[XB_XCNT(j)]); sum += c; cnt += (c > 0u) ? 1u : 0u; mine = (j == x) ? c : mine; }
        if (sum == G) break;
        __builtin_amdgcn_s_sleep(1);
        if ((++sp & 255u) == 0u) { if (xb_ld(&bar[XB_TMO])) break; if (sp > XB_SPIN_CAP) { atomicAdd(&bar[XB_TMO], 1u); break; } }
    }
    nloc = mine > 0u ? mine : 1u; nx = cnt > 0u ? cnt : 1u;
}
__device__ __forceinline__ void xcd_barrier(const XcdBarrier& b) {
    asm volatile("s_waitcnt vmcnt(0)" ::: "memory");
    __syncthreads();
    if (threadIdx.x == 0) {
        unsigned* bar = b.bar;
        __builtin_amdgcn_s_waitcnt(0);
        unsigned nloc = b.st[0], nx = b.st[1];
        if (nloc == 0u) { xcd_barrier_complete(bar, b.x, nloc, nx); b.st[0] = nloc; b.st[1] = nx; }
        const unsigned old = xb_add(&bar[XB_XSUB(b.x)], 1u);
        const unsigned gen = old / nloc;
        if (old + 1u == (gen + 1u) * nloc) {
            __builtin_amdgcn_fence(__ATOMIC_RELEASE, "agent");
            asm volatile("s_waitcnt vmcnt(0)" ::: "memory");
            const unsigned og = xb_add(&bar[XB_TOP], 1u);
            const unsigned tg = og / nx;
            if (og + 1u == (tg + 1u) * nx) xb_add(&bar[XB_TOPGEN], 1u);
            else XB_SPIN(xb_ld(&bar[XB_TOPGEN]) == tg, bar);
            __builtin_amdgcn_fence(__ATOMIC_ACQUIRE, "agent");
            xb_add(&bar[XB_XGEN(b.x)], 1u);
            asm volatile("s_waitcnt vmcnt(0)" ::: "memory");
        } else {
            XB_SPIN(xb_ld(&bar[XB_XGEN(b.x)]) == gen, bar);
            __builtin_amdgcn_fence(__ATOMIC_ACQUIRE, "agent");
            asm volatile("s_waitcnt vmcnt(0)" ::: "memory");
        }
    }
    __syncthreads();
}

__global__ void __launch_bounds__(NTHREADS, 2) fwd_megakernel(Params P) {
    extern __shared__ __attribute__((aligned(16))) unsigned char lds_raw[];
    LAS unsigned char* lds = (LAS unsigned char*)lds_raw;
    cg::grid_group grid = cg::this_grid();
    const int G = gridDim.x, tid = threadIdx.x;
    unsigned char* ws = P.ws;
    LAS int* misc = (LAS int*)(lds + LDS_BYTES - 64);
    if (tid < 16) misc[tid] = 0;
    __syncthreads();
    XcdBarrier xbar = xcd_barrier_post((unsigned*)(ws + WS_BAR), (volatile LAS unsigned*)(misc + 8));
#if USE_XCD_BARRIER
#define GSYNC() xcd_barrier(xbar)
#else
#define GSYNC() grid.sync()
#endif
    unsigned long long pr_t0 = 0, pr_acc = 0;
#define PH_BEGIN(k) do { if (PROBE_PHASE == (k)) pr_t0 = __builtin_amdgcn_s_memrealtime(); } while (0)
#define PH_END(k) do { if (PROBE_PHASE == (k)) pr_acc += __builtin_amdgcn_s_memrealtime() - pr_t0; } while (0)

    PH_BEGIN(0);
    if (PHASE_MASK & 1) phase_prep(P, lds, G);
    grid.sync();
    PH_END(0);
    PH_BEGIN(1);
    if (PHASE_MASK & 2) {
        pg8::Gemm g{(const bf16_t*)P.out, (const bf16_t*)(ws + WS_W0T), MTOK, N0, DM}; pg8::StaticOrder S; S.init(MTOK, N0, G, (int)blockIdx.x);
        EpiIn0 E{(bf16_t*)(ws + WS_Y0), (bf16_t*)(ws + WS_XBC), (bf16_t*)(ws + WS_Q0), (bf16_t*)(ws + WS_K0), (bf16_t*)(ws + WS_V0), (const float*)(ws + WS_RSTD0), (float*)(ws + WS_KPART)};
        pg8::gemm_phase<GEMM_ALIGN, GEMM_SP2>(lds, g, S, E, pg8::NoHook{});
    }
    GSYNC();
    PH_END(1);
    PH_BEGIN(2);
    PH_BEGIN(21);
    if (PHASE_MASK & 4) { conv_prepass(P, G); }
    GSYNC();
    PH_END(21);
    if (PHASE_MASK & 4) {
        if (PROBE_PHASE == 23 && blockIdx.x == 0) { PH_BEGIN(23); moba_item_m32(P, lds, 0, 0, 7, ws != nullptr); PH_END(23); }
        if (PROBE_PHASE == 24 && blockIdx.x == 0) { PH_BEGIN(24); moba_item_m32(P, lds, 0, 0, 0, ws != nullptr); PH_END(24); }
        PH_BEGIN(25);
        const int xcd = blockIdx.x & 7;
        unsigned* ctr = (unsigned*)(ws + WS_CTL) + 16 * xcd;
        for (;;) {
            __syncthreads();
            if (tid == 0) misc[0] = (int)atomicAdd(ctr, 1u);
            __syncthreads();
            const int it = misc[0];
#if MOBA_MFMA
#if MOBA_M32
            if (it >= 80) break;
            if (it >= 40 && it < 56) { const int item = (it - 40) * 8 + xcd; PH_BEGIN(20); ssd_item_mfma(P, lds, item >> 4, item & 15); PH_END(20); }
            else { const int r = it < 40 ? it : it - 16; const int qb = 7 - (r >> 3), bh = 8 * (r & 7) + xcd; PH_BEGIN(22); moba_item_m32(P, lds, bh >> 3, bh & 7, qb); PH_END(22); }
#else
            if (it >= 16 + 128) break;
            if (it < 16) { const int item = it * 8 + xcd; PH_BEGIN(20); if (SSD_MFMA) ssd_item_mfma(P, lds, item >> 4, item & 15); else ssd_item(P, lds, item >> 4, item & 15); PH_END(20); }
            else { const int r = it - 16; const int qt = 15 - (r & 15), bh = 8 * (r >> 4) + xcd; PH_BEGIN(22); moba_item_mfma(P, lds, bh >> 3, bh & 7, qt); PH_END(22); }
#endif
#else
            if (it >= 128 + 4096) break;
            if (it < 128) ssd_item(P, lds, it >> 4, it & 15);
            else { const int r = it - 128; const int qt = 63 - (r >> 6), bh = r & 63; moba_item(P, lds, bh >> 3, bh & 7, qt); }
#endif
        }
        PH_END(25);
    }
    GSYNC();
    PH_END(2);
    PH_BEGIN(3);
    if (PHASE_MASK & 8) {
        pg8::Gemm g{(const bf16_t*)(ws + WS_Y0), (const bf16_t*)(ws + WS_WO0T), MTOK, DM, 2048}; pg8::StaticOrder S; S.init(MTOK, DM, G, (int)blockIdx.x);
        EpiRes E{P.x, P.out, (bf16_t*)(ws + WS_X1B), (float*)(ws + WS_RSQ1)};
        HookSsdNorm H{(const float*)(ws + WS_SSQ)};
        pg8::gemm_phase<GEMM_ALIGN, GEMM_SP2>(lds, g, S, E, H);
    }
    GSYNC();
    PH_END(3);
    PH_BEGIN(4);
    if (PHASE_MASK & 16) {
        pg8::Gemm g{(const bf16_t*)(ws + WS_X1B), (const bf16_t*)(ws + WS_W1T), MTOK, 6144, DM}; pg8::StaticOrder S; S.init(MTOK, 6144, G, (int)blockIdx.x);
        EpiQkv1 E{(bf16_t*)(ws + WS_QO1), (size_t)(WS_K1 - WS_QO1) / 2, (const float*)(ws + WS_RSQ1)};
        pg8::gemm_phase<GEMM_ALIGN, GEMM_SP2>(lds, g, S, E, pg8::NoHook{});
    }
    GSYNC();
    PH_END(4);
    PH_BEGIN(5);
#if DIL_MFMA
    if (PHASE_MASK & 32) for (int it = (int)(blockIdx.x & 7) * (G >> 3) + (int)(blockIdx.x >> 3); it < 8 * 16 * 8; it += G) { const int c_ = it & 7, j_ = it >> 8, c2_ = (j_ & 2) ? (c_ ^ 4) : c_; const int blk = (j_ & 1) ? 7 - c2_ : c2_, bh = it >> 3; if (DIL_V2) dilated_item_v2(P, lds, bh >> 4, bh & 15, blk, pr_t0, pr_acc); else dilated_item_mfma(P, lds, bh >> 4, bh & 15, blk); }
#else
    if (PHASE_MASK & 32) for (int it = blockIdx.x; it < 8 * 16 * 64; it += G) { const int qt = it & 63, bh = it >> 6; dilated_item(P, lds, bh >> 4, bh & 15, qt); }
#endif
    GSYNC();
    PH_END(5);
    PH_BEGIN(6);
    if (PHASE_MASK & 64) {
        pg8::Gemm g{(const bf16_t*)(ws + WS_X1B), (const bf16_t*)(ws + WS_W1T) + (size_t)6144 * 1024, MTOK, 2048, DM}; pg8::StaticOrder S; S.init(MTOK, 2048, G, (int)blockIdx.x);
        EpiGate1 E{(bf16_t*)(ws + WS_QO1), (const float*)(ws + WS_RSQ1)};
        pg8::gemm_phase<GEMM_ALIGN, GEMM_SP2>(lds, g, S, E, pg8::NoHook{});
    }
    GSYNC();
    PH_END(6);
    PH_BEGIN(7);
    if (PHASE_MASK & 128) {
        pg8::Gemm g{(const bf16_t*)(ws + WS_QO1), (const bf16_t*)(ws + WS_WO1T), MTOK, DM, 2048}; pg8::StaticOrder S; S.init(MTOK, DM, G, (int)blockIdx.x);
        EpiRes E{P.out, P.out, nullptr, (float*)(ws + WS_RSQ2)};
        pg8::gemm_phase<GEMM_ALIGN, GEMM_SP2>(lds, g, S, E, pg8::NoHook{});
    }
    GSYNC();
    PH_END(7);
    PH_BEGIN(8);
    if (PHASE_MASK & 256) {
        const int lane = tid & 63, wave = tid >> 6; const float* rsq2 = (const float*)(ws + WS_RSQ2);
        for (int m = blockIdx.x * 8 + wave; m < MTOK; m += G * 8) {
            const float rs = rstd_from16(rsq2 + (size_t)m * 16);
            f32x4* xr = (f32x4*)(P.out + (size_t)m * DM) + lane; const f32x4* gr = (const f32x4*)P.final_norm + lane;
#pragma unroll
            for (int j = 0; j < 4; ++j) { const f32x4 v = xr[64 * j], gg = gr[64 * j]; xr[64 * j] = v * rs * gg; }
        }
    }
    if (PROBE_PHASE >= 0) { PH_END(8); if (blockIdx.x == PROBE_BLOCK && tid == 0) { const unsigned long long t0 = __builtin_amdgcn_s_memrealtime(), wait = pr_acc * PROBE_MULT;
        while (__builtin_amdgcn_s_memrealtime() - t0 < wait) __builtin_amdgcn_s_sleep(32); } }
}

extern "C" void kernel_launch(void* const* d_in, const int* in_sizes, int n_in, void* d_out, int out_size, void* d_ws, size_t ws_size, hipStream_t stream) {
    static int grid_blocks = 0;
    if (grid_blocks == 0) {
        if (n_in != 14 || ws_size < WS_END) { fprintf(stderr, "kernel_launch: unexpected n_in %d / ws_size %zu\n", n_in, ws_size); grid_blocks = -1; return; }
        int dev = 0, cus = 0, per_cu = 0;
        hipGetDevice(&dev);
        hipDeviceGetAttribute(&cus, hipDeviceAttributeMultiprocessorCount, dev);
        hipFuncSetAttribute((const void*)fwd_megakernel, hipFuncAttributeMaxDynamicSharedMemorySize, LDS_BYTES);
        hipOccupancyMaxActiveBlocksPerMultiprocessor(&per_cu, (const void*)fwd_megakernel, NTHREADS, LDS_BYTES);
        if (per_cu < 1) { fprintf(stderr, "kernel_launch: occupancy query says %d blocks per CU\n", per_cu); per_cu = 1; }
        grid_blocks = cus * 1;
        (void)hipGetLastError();
    }
    if (grid_blocks < 0) return;
    if (hipMemsetAsync((char*)d_ws + WS_CTL, 0, 64 * 1024, stream) != hipSuccess) { fprintf(stderr, "kernel_launch: hipMemsetAsync failed\n"); return; }
    Params p{};
    p.x = (const float*)d_in[0]; p.even_norm = (const float*)d_in[1]; p.w_in0 = (const float*)d_in[2]; p.conv_w = (const float*)d_in[3]; p.conv_b = (const float*)d_in[4];
    p.dt_bias = (const float*)d_in[5]; p.a_log = (const float*)d_in[6]; p.d_skip = (const float*)d_in[7]; p.ssd_norm = (const float*)d_in[8]; p.w_out0 = (const float*)d_in[9];
    p.odd_norm = (const float*)d_in[10]; p.w_in1 = (const float*)d_in[11]; p.w_out1 = (const float*)d_in[12]; p.final_norm = (const float*)d_in[13];
    p.out = (float*)d_out; p.ws = (unsigned char*)d_ws;
    void* args[] = {&p};
    hipError_t e = hipLaunchCooperativeKernel((const void*)fwd_megakernel, dim3(grid_blocks), dim3(NTHREADS), args, LDS_BYTES, stream);
    if (e != hipSuccess) fprintf(stderr, "cooperative launch failed: %s (grid %d)\n", hipGetErrorString(e), grid_blocks);
}
```
